# Optimizing an MI355X kernel written in HIP

```python
import math
import jax
import jax.numpy as jnp
from jax import lax
import numpy as np

D_MODEL = 2048
BATCH = 4
SEQ = 4096
DEPTH = 2

CHUNK = 64
N_MIXERS = 2
GMLP_BLOCK = 128
GMLP_HEADS = 16
GMLP_DIM = D_MODEL
GMLP_HEAD_DIM = GMLP_DIM // GMLP_HEADS
HGRN_HEAD_DIM = 128
HGRN_HEADS = D_MODEL // HGRN_HEAD_DIM
HGRN_DIM = HGRN_HEADS * HGRN_HEAD_DIM
N_EXPERTS = 64
TOP_K = 8
N_GROUPS = 8
TOPK_GROUPS = 4
EXPERT_DIM = D_MODEL // 4
SHARED_DIM = EXPERT_DIM
ROUTED_SCALE = 2.5
EXPERT_BLOCK = 128
LN_EPS = 1e-5
DEEPNORM_ALPHA = (2 * DEPTH) ** 0.25
DEEPNORM_BETA = (8 * DEPTH) ** -0.25

kernel_name = 'hybrid_gmlp_hgrn2_moe_deepnorm'


def layer_norm(x, g, b):
    xf = x.astype(jnp.float32)
    mu = jnp.mean(xf, axis=-1, keepdims=True)
    xc = xf - mu
    var = jnp.mean(xc * xc, axis=-1, keepdims=True)
    return (xc * lax.rsqrt(var + LN_EPS) * g.astype(jnp.float32) + b.astype(jnp.float32)).astype(x.dtype)


def gmlp_mixer(x, w_in, v_ln_g, v_ln_b, w_sp, b_sp, w_out):
    bsz, seq, _ = x.shape
    z = jax.nn.gelu(x @ w_in, approximate=False)
    u, v = jnp.split(z, 2, axis=-1)
    v = layer_norm(v, v_ln_g, v_ln_b)
    nblk = seq // GMLP_BLOCK
    v = v.reshape(bsz, nblk, GMLP_BLOCK, GMLP_HEADS, GMLP_HEAD_DIM)
    chunk_id = jnp.arange(GMLP_BLOCK) // CHUNK
    mask = chunk_id[:, None] >= chunk_id[None, :]
    w = jnp.where(mask[None], w_sp, 0.0)
    sv = jnp.einsum('hij,bnjhc->bnihc', w, v) + b_sp.T[None, None, :, :, None]
    y = u * sv.reshape(bsz, seq, GMLP_DIM)
    return y @ w_out


def chunk_gated_recurrence(q, k, v, log_f):
    bsz, seq, nh, dk = q.shape
    dv = v.shape[-1]
    n_chunks = seq // CHUNK

    def to_chunks(t):
        return t.reshape(bsz, n_chunks, CHUNK, nh, t.shape[-1]).transpose(1, 0, 3, 2, 4)

    causal = jnp.tril(jnp.ones((CHUNK, CHUNK), dtype=bool))[:, :, None]

    def step(state, inp):
        qc, kc, vc, lfc = inp
        b = jnp.cumsum(lfc, axis=2)
        b_last = b[:, :, -1]
        o_inter = jnp.einsum('bhtk,bhkv->bhtv', qc * jnp.exp(b), state)
        rel = jnp.where(causal, b[:, :, :, None, :] - b[:, :, None, :, :], -jnp.inf)
        scores = jnp.einsum('bhtk,bhtsk,bhsk->bhts', qc, jnp.exp(rel), kc)
        o_intra = jnp.einsum('bhts,bhsv->bhtv', scores, vc)
        k_dec = kc * jnp.exp(b_last[:, :, None, :] - b)
        new_state = jnp.exp(b_last)[..., None] * state + jnp.einsum('bhsk,bhsv->bhkv', k_dec, vc)
        return new_state, o_inter + o_intra

    state0 = jnp.zeros((bsz, nh, dk, dv), jnp.float32)
    _, o = lax.scan(step, state0, (to_chunks(q), to_chunks(k), to_chunks(v), to_chunks(log_f)))
    return o.transpose(1, 0, 3, 2, 4).reshape(bsz, seq, nh, dv)


def hgrn2_mixer(x, w_in, o_norm_g, w_out, lower_bound):
    bsz, seq, _ = x.shape
    q, f, i, g = jnp.split(x @ w_in, 4, axis=-1)
    hs = (bsz, seq, HGRN_HEADS, HGRN_HEAD_DIM)
    q = jax.nn.silu(q.astype(jnp.float32)).reshape(hs)
    fz = f.astype(jnp.float32).reshape(hs)
    lb = lower_bound.reshape(HGRN_HEADS, HGRN_HEAD_DIM)
    log_f = jnp.logaddexp(jnp.log(lb), jnp.log1p(-lb) + jax.nn.log_sigmoid(fz))
    k = (1.0 - lb) * jax.nn.sigmoid(-fz)
    o = chunk_gated_recurrence(q, k, i.astype(jnp.float32).reshape(hs), log_f)
    o = o * lax.rsqrt(jnp.mean(o * o, axis=-1, keepdims=True) + LN_EPS) * o_norm_g.astype(jnp.float32)
    o = o.reshape(bsz, seq, HGRN_DIM) * jax.nn.silu(g.astype(jnp.float32))
    return o.astype(x.dtype) @ w_out


def swiglu(x, w_gate, w_up, w_down):
    return (jax.nn.silu(x @ w_gate) * (x @ w_up)) @ w_down


def route(xt, w_router, e_bias):
    n_tok = xt.shape[0]
    scores = jax.nn.sigmoid((xt @ w_router).astype(jnp.float32))
    choice = scores + e_bias.astype(jnp.float32)
    grp = choice.reshape(n_tok, N_GROUPS, N_EXPERTS // N_GROUPS)
    grp_score = lax.top_k(grp, 2)[0].sum(-1)
    _, grp_idx = lax.top_k(grp_score, TOPK_GROUPS)
    grp_mask = jnp.any(grp_idx[:, :, None] == jnp.arange(N_GROUPS)[None, None, :], axis=1)
    allowed = jnp.repeat(grp_mask, N_EXPERTS // N_GROUPS, axis=1)
    _, eidx = lax.top_k(jnp.where(allowed, choice, -jnp.inf), TOP_K)
    gw = jnp.take_along_axis(scores, eidx, axis=1)
    gw = gw / jnp.sum(gw, axis=-1, keepdims=True) * ROUTED_SCALE
    return eidx, gw


def moe_ffn(x, w_router, e_bias, w_gate, w_up, w_down, ws_gate, ws_up, ws_down):
    bsz, seq, d = x.shape
    xt = x.reshape(-1, d)
    n_tok = xt.shape[0]
    eidx, gw = route(xt, w_router, e_bias)
    n_assign = n_tok * TOP_K
    e_flat = eidx.reshape(-1)
    tok_flat = jnp.arange(n_assign, dtype=jnp.int32) // TOP_K
    order = jnp.argsort(e_flat)
    e_sorted = e_flat[order]
    counts = jnp.bincount(e_flat, length=N_EXPERTS)
    padded = (counts + EXPERT_BLOCK - 1) // EXPERT_BLOCK * EXPERT_BLOCK
    pad_end = jnp.cumsum(padded)
    pad_start = pad_end - padded
    sort_start = jnp.cumsum(counts) - counts
    dest = pad_start[e_sorted] + jnp.arange(n_assign, dtype=jnp.int32) - sort_start[e_sorted]
    n_blocks = -(-n_assign // EXPERT_BLOCK) + N_EXPERTS
    n_rows = n_blocks * EXPERT_BLOCK
    row_tok = jnp.full((n_rows,), n_tok, jnp.int32).at[dest].set(tok_flat[order])
    row_w = jnp.zeros((n_rows,), jnp.float32).at[dest].set(gw.reshape(-1)[order])
    blk_start = jnp.arange(n_blocks, dtype=jnp.int32) * EXPERT_BLOCK
    blk_expert = jnp.minimum(jnp.searchsorted(pad_end, blk_start, side='right'), N_EXPERTS - 1)
    x_ext = jnp.concatenate([xt, jnp.zeros((1, d), xt.dtype)], axis=0)

    def expert_block(args):
        tok, wt, e = args
        xb = x_ext[tok]
        return swiglu(xb, w_gate[e], w_up[e], w_down[e]) * wt[:, None].astype(xb.dtype)

    rows = lax.map(expert_block, (row_tok.reshape(n_blocks, EXPERT_BLOCK),
                                  row_w.reshape(n_blocks, EXPERT_BLOCK), blk_expert))
    routed = jax.ops.segment_sum(rows.reshape(n_rows, d), row_tok, num_segments=n_tok + 1)[:n_tok]
    return (routed + swiglu(xt, ws_gate, ws_up, ws_down)).reshape(bsz, seq, d)


def setup_inputs(seed: int = 0) -> dict:
    key = jax.random.key(seed)
    ks = jax.random.split(key, 24)
    n_a = len(range(0, DEPTH, N_MIXERS))
    n_b = len(range(1, DEPTH, N_MIXERS))
    beta = DEEPNORM_BETA

    def nrm(k, shape, scale):
        return jax.random.normal(k, shape, jnp.float32) * scale

    return {
        'x': nrm(ks[0], (BATCH, SEQ, D_MODEL), 1.0),
        'ln_mix_g': 1.0 + nrm(ks[1], (DEPTH, D_MODEL), 0.02),
        'ln_mix_b': nrm(ks[2], (DEPTH, D_MODEL), 0.02),
        'ln_ffn_g': 1.0 + nrm(ks[3], (DEPTH, D_MODEL), 0.02),
        'ln_ffn_b': nrm(ks[4], (DEPTH, D_MODEL), 0.02),
        'gmlp_w_in': nrm(ks[5], (n_a, D_MODEL, 2 * GMLP_DIM), D_MODEL ** -0.5),
        'gmlp_v_ln_g': 1.0 + nrm(ks[6], (n_a, GMLP_DIM), 0.02),
        'gmlp_v_ln_b': nrm(ks[7], (n_a, GMLP_DIM), 0.02),
        'gmlp_w_sp': nrm(ks[8], (n_a, GMLP_HEADS, GMLP_BLOCK, GMLP_BLOCK), GMLP_BLOCK ** -0.5),
        'gmlp_b_sp': 1.0 + nrm(ks[9], (n_a, GMLP_HEADS, GMLP_BLOCK), 0.02),
        'gmlp_w_out': nrm(ks[10], (n_a, GMLP_DIM, D_MODEL), beta * GMLP_DIM ** -0.5),
        'hgrn_w_in': nrm(ks[11], (n_b, D_MODEL, 4 * HGRN_DIM), D_MODEL ** -0.5),
        'hgrn_o_norm_g': 1.0 + nrm(ks[12], (n_b, HGRN_HEAD_DIM), 0.02),
        'hgrn_w_out': nrm(ks[13], (n_b, HGRN_DIM, D_MODEL), beta * HGRN_DIM ** -0.5),
        'hgrn_lower_bounds': 1.0 + nrm(ks[14], (DEPTH, HGRN_DIM), 0.5),
        'moe_w_router': nrm(ks[15], (DEPTH, D_MODEL, N_EXPERTS), D_MODEL ** -0.5),
        'moe_e_bias': nrm(ks[16], (DEPTH, N_EXPERTS), 0.01),
        'moe_w_gate': nrm(ks[17], (DEPTH, N_EXPERTS, D_MODEL, EXPERT_DIM), D_MODEL ** -0.5),
        'moe_w_up': nrm(ks[18], (DEPTH, N_EXPERTS, D_MODEL, EXPERT_DIM), D_MODEL ** -0.5),
        'moe_w_down': nrm(ks[19], (DEPTH, N_EXPERTS, EXPERT_DIM, D_MODEL), beta * EXPERT_DIM ** -0.5),
        'moe_ws_gate': nrm(ks[20], (DEPTH, D_MODEL, SHARED_DIM), D_MODEL ** -0.5),
        'moe_ws_up': nrm(ks[21], (DEPTH, D_MODEL, SHARED_DIM), D_MODEL ** -0.5),
        'moe_ws_down': nrm(ks[22], (DEPTH, SHARED_DIM, D_MODEL), beta * SHARED_DIM ** -0.5),
    }


def reference(x, ln_mix_g, ln_mix_b, ln_ffn_g, ln_ffn_b,
              gmlp_w_in, gmlp_v_ln_g, gmlp_v_ln_b, gmlp_w_sp, gmlp_b_sp, gmlp_w_out,
              hgrn_w_in, hgrn_o_norm_g, hgrn_w_out, hgrn_lower_bounds,
              moe_w_router, moe_e_bias, moe_w_gate, moe_w_up, moe_w_down,
              moe_ws_gate, moe_ws_up, moe_ws_down):
    lb_soft = jax.nn.softmax(hgrn_lower_bounds.astype(jnp.float32), axis=0)
    lb_all = jnp.cumsum(lb_soft, axis=0) - lb_soft[0]
    for layer in range(DEPTH):
        j = layer // N_MIXERS
        if layer % N_MIXERS == 0:
            h = gmlp_mixer(x, gmlp_w_in[j], gmlp_v_ln_g[j], gmlp_v_ln_b[j],
                           gmlp_w_sp[j], gmlp_b_sp[j], gmlp_w_out[j])
        else:
            h = hgrn2_mixer(x, hgrn_w_in[j], hgrn_o_norm_g[j], hgrn_w_out[j], lb_all[layer])
        x = layer_norm(DEEPNORM_ALPHA * x + h, ln_mix_g[layer], ln_mix_b[layer])
        h = moe_ffn(x, moe_w_router[layer], moe_e_bias[layer], moe_w_gate[layer],
                    moe_w_up[layer], moe_w_down[layer], moe_ws_gate[layer],
                    moe_ws_up[layer], moe_ws_down[layer])
        x = layer_norm(DEEPNORM_ALPHA * x + h, ln_ffn_g[layer], ln_ffn_b[layer])
    return x
```

```cpp
#include <hip/hip_runtime.h>
#include <cstdio>
#include <cstdint>

#ifndef MK_N_LAUNCHES
#define MK_N_LAUNCHES 1
#endif

namespace pg8 {
#define PG8_LAS __attribute__((address_space(3)))
typedef unsigned short bf16_t;
typedef short bf16x8 __attribute__((ext_vector_type(8)));
typedef float f32x4 __attribute__((ext_vector_type(4)));
typedef float f32x2 __attribute__((ext_vector_type(2)));
typedef unsigned u32x4 __attribute__((ext_vector_type(4)));
constexpr int BM = 256, BK = 64, HALF = 128, HTB = HALF * BK * 2  , STAGE_BYTES = 8 * HTB, NXCD = 8, WGM = 8;

__host__ __device__ __forceinline__ int lds_byte(int r, int c) { const int st = (r >> 4) * 2 + (c >> 5), rr = r & 15, cc = c & 31, ob = rr * 64 + cc * 2; return st * 1024 + (ob ^ (((ob >> 9) & 1) << 5)); }
__host__ __device__ __forceinline__ void stage_rc(int b, int& R, int& C) { const int st = b / 1024, sb = b % 1024, swz = sb ^ (((sb >> 9) & 1) << 5); R = (st >> 1) * 16 + swz / 64; C = (st & 1) * 32 + (swz % 64) / 2; }
__host__ __device__ __forceinline__ int perm32(int rho) { const int n = rho >> 4, i = rho & 15; return 8 * (i >> 2) + 4 * n + (i & 3); }

struct Unit { int pm, pn, e, rows, orow; };

struct DenseOrder {
    static constexpr bool GATHER = false;
    const char* A; const char* Bt; int K, nM, nN, nwg, G, c;
    __device__ void init(const void* A_, const void* Bt_, int M, int N, int K_, int G_, int c_) { A = (const char*)A_; Bt = (const char*)Bt_; K = K_; nM = M / BM; nN = N / BM; nwg = nM * nN; G = G_; c = c_; }
    __device__ bool next(int i, Unit& u) const {
        const long L = (long)i * G + c; if (L >= nwg) return false;
        int wgid = (int)L; { const int q = nwg / NXCD, r = nwg % NXCD, xcd = wgid % NXCD, off = wgid / NXCD; wgid = (xcd < r ? xcd * (q + 1) : r * (q + 1) + (xcd - r) * q) + off; }
        const int nig = WGM * nN, gid = wgid / nig, fm = gid * WGM, gsz = (nM - fm) < WGM ? (nM - fm) : WGM;
        u.pm = fm + ((wgid % nig) % gsz); u.pn = (wgid % nig) / gsz; u.e = 0; u.rows = BM; u.orow = u.pm * BM; return true;
    }
    __device__ __forceinline__ const char* a_ptr(const Unit& u) const { return A + (size_t)u.pm * BM * K * 2; }
    __device__ __forceinline__ const char* b_ptr(const Unit& u) const { return Bt + (size_t)u.pn * BM * K * 2; }
    __device__ __forceinline__ int tok(const Unit&, int) const { return 0; }
};
template <bool GATHER_> struct MoeOrder {
    static constexpr bool GATHER = GATHER_;
    const PG8_LAS int* tab; int n;
    const char* A; const char* Bt; size_t b_estride; int K; const unsigned* list;
    __device__ bool next(int i, Unit& u) const { if (i >= n) return false; const PG8_LAS int* t = tab + 5 * i; u.e = t[0]; u.pm = t[1]; u.pn = t[2]; u.rows = t[3]; u.orow = t[4]; return true; }
    __device__ __forceinline__ const char* a_ptr(const Unit& u) const { return GATHER ? A : A + (size_t)u.orow * K * 2; }
    __device__ __forceinline__ const char* b_ptr(const Unit& u) const { return Bt + (size_t)u.e * b_estride + (size_t)u.pn * BM * K * 2; }
    __device__ __forceinline__ int tok(const Unit& u, int row) const { if (u.e >= 64) return u.pm * BM + row; return row < u.rows ? (int)list[(size_t)u.e * 16384 + u.pm * BM + row] : 0; }
};

__device__ __forceinline__ unsigned cvt_pk_bf16(float lo, float hi) { unsigned r; asm volatile("v_cvt_pk_bf16_f32 %0, %1, %2" : "=v"(r) : "v"(lo), "v"(hi)); return r; }
__device__ __forceinline__ f32x2 gelu_pk(f32x2 v) {
    const f32x2 av = __builtin_elementwise_abs(v), d = av * 0.2316418882f + 1.0f;
    f32x2 t; t.x = __builtin_amdgcn_rcpf(d.x); t.y = __builtin_amdgcn_rcpf(d.y);
    f32x2 q = t * 0.5307027145f + (-0.7265760135f); q = q * t + 0.7107068705f; q = q * t + (-0.142248368f); q = q * t + 0.127414796f; q = q * t;
    const f32x2 s = (v * v) * (-0.72134752044f);
    f32x2 e; e.x = __builtin_amdgcn_exp2f(s.x); e.y = __builtin_amdgcn_exp2f(s.y);
    const f32x2 m = v * (q * e), r = v - m;
    f32x2 o; o.x = v.x < 0.f ? m.x : r.x; o.y = v.y < 0.f ? m.y : r.y; return o;
}
__device__ __forceinline__ float sigmoidf_(float x) { return __builtin_amdgcn_rcpf(1.0f + __expf(-x)); }

struct EpiGelu {
    static constexpr bool PERM = true;
    bf16_t* O; int ldc;
    __device__ __forceinline__ void operator()(const f32x4 (&acc)[2][2][4][2], const Unit& u, int wr, int wc, int fr, int fq) const {
        const int row0 = u.pm * BM + wr * 64 + fr, col0 = u.pn * BM + wc * 32 + 8 * fq;
#pragma unroll
        for (int ai = 0; ai < 2; ++ai)
#pragma unroll
            for (int m = 0; m < 4; ++m) { bf16_t* rowp = O + (size_t)(row0 + ai * HALF + m * 16) * ldc + col0;
#pragma unroll
                for (int bj = 0; bj < 2; ++bj) { const f32x4 v0 = acc[ai][bj][m][0], v1 = acc[ai][bj][m][1];
                    const f32x2 a = gelu_pk((f32x2){v0[0], v0[1]}), b = gelu_pk((f32x2){v0[2], v0[3]}), c = gelu_pk((f32x2){v1[0], v1[1]}), d = gelu_pk((f32x2){v1[2], v1[3]});
                    u32x4 w; w.x = cvt_pk_bf16(a.x, a.y); w.y = cvt_pk_bf16(b.x, b.y); w.z = cvt_pk_bf16(c.x, c.y); w.w = cvt_pk_bf16(d.x, d.y);
                    *(u32x4*)(rowp + bj * HALF) = w; } }
    }
};
struct EpiRes {
    static constexpr bool PERM = false;
    const float* res; float* out; int ldc; float alpha;
    __device__ __forceinline__ void operator()(const f32x4 (&acc)[2][2][4][2], const Unit& u, int wr, int wc, int fr, int fq) const {
        const int row0 = u.pm * BM + wr * 64 + fr, col0 = u.pn * BM + wc * 32 + 4 * fq;
#pragma unroll
        for (int ai = 0; ai < 2; ++ai)
#pragma unroll
            for (int m = 0; m < 4; ++m) { const size_t off = (size_t)(row0 + ai * HALF + m * 16) * ldc + col0;
#pragma unroll
                for (int bj = 0; bj < 2; ++bj)
#pragma unroll
                    for (int n = 0; n < 2; ++n) { const f32x4 r = *(const f32x4*)(res + off + bj * HALF + n * 16); *(f32x4*)(out + off + bj * HALF + n * 16) = r * alpha + acc[ai][bj][m][n]; }
                if (m & 1) asm volatile("" ::: "memory"); }
    }
};
struct EpiHgrn {
    static constexpr bool PERM = true;
    bf16_t* Q; bf16_t* Kk; bf16_t* V; bf16_t* G; float* F; const float* lb; int D;
    __device__ __forceinline__ void operator()(const f32x4 (&acc)[2][2][4][2], const Unit& u, int wr, int wc, int fr, int fq) const {
        const int kind = u.pn / (D / BM);
        const int row0 = u.pm * BM + wr * 64 + fr, col0 = (u.pn % (D / BM)) * BM + wc * 32 + 8 * fq;
        if (kind == 1) {
#pragma unroll
            for (int bj = 0; bj < 2; ++bj) {
                const f32x4 l0 = *(const f32x4*)(lb + col0 + bj * HALF), l1 = *(const f32x4*)(lb + col0 + bj * HALF + 4);
#pragma unroll
                for (int ai = 0; ai < 2; ++ai)
#pragma unroll
                    for (int m = 0; m < 4; ++m) { const size_t off = (size_t)(row0 + ai * HALF + m * 16) * D + col0 + bj * HALF;
                        f32x4 fo[2], ko[2];
#pragma unroll
                        for (int j = 0; j < 4; ++j) { const float s0 = sigmoidf_(acc[ai][bj][m][0][j]), s1 = sigmoidf_(acc[ai][bj][m][1][j]);
                            fo[0][j] = l0[j] + (1.0f - l0[j]) * s0; ko[0][j] = (1.0f - l0[j]) * (1.0f - s0); fo[1][j] = l1[j] + (1.0f - l1[j]) * s1; ko[1][j] = (1.0f - l1[j]) * (1.0f - s1); }
                        *(f32x4*)(F + off) = fo[0]; *(f32x4*)(F + off + 4) = fo[1];
                        u32x4 w; w.x = cvt_pk_bf16(ko[0][0], ko[0][1]); w.y = cvt_pk_bf16(ko[0][2], ko[0][3]); w.z = cvt_pk_bf16(ko[1][0], ko[1][1]); w.w = cvt_pk_bf16(ko[1][2], ko[1][3]);
                        *(u32x4*)(Kk + off) = w;
                        asm volatile("" ::: "memory"); } }
        } else {
            bf16_t* O = kind == 0 ? Q : (kind == 2 ? V : G);
            const bool act = kind != 2;
#pragma unroll
            for (int ai = 0; ai < 2; ++ai)
#pragma unroll
                for (int m = 0; m < 4; ++m) { const size_t off = (size_t)(row0 + ai * HALF + m * 16) * D + col0;
#pragma unroll
                    for (int bj = 0; bj < 2; ++bj) { f32x4 o[2];
#pragma unroll
                        for (int n = 0; n < 2; ++n)
#pragma unroll
                            for (int j = 0; j < 4; ++j) { const float x = acc[ai][bj][m][n][j]; o[n][j] = act ? x * sigmoidf_(x) : x; }
                        u32x4 w; w.x = cvt_pk_bf16(o[0][0], o[0][1]); w.y = cvt_pk_bf16(o[0][2], o[0][3]); w.z = cvt_pk_bf16(o[1][0], o[1][1]); w.w = cvt_pk_bf16(o[1][2], o[1][3]);
                        *(u32x4*)(O + off + bj * HALF) = w; } }
        }
    }
};
struct EpiMoe1 {
    static constexpr bool PERM = true;
    bf16_t* H;
    __device__ __forceinline__ void operator()(const f32x4 (&acc)[2][2][4][2], const Unit& u, int wr, int wc, int fr, int fq) const {
        const int col0 = u.pn * HALF + wc * 32 + 8 * fq;
#pragma unroll
        for (int ai = 0; ai < 2; ++ai)
#pragma unroll
            for (int m = 0; m < 4; ++m) { const int r = ai * HALF + wr * 64 + m * 16 + fr;
                f32x4 o[2];
#pragma unroll
                for (int n = 0; n < 2; ++n)
#pragma unroll
                    for (int j = 0; j < 4; ++j) { const float g = acc[ai][0][m][n][j]; o[n][j] = g * sigmoidf_(g) * acc[ai][1][m][n][j]; }
                u32x4 w; w.x = cvt_pk_bf16(o[0][0], o[0][1]); w.y = cvt_pk_bf16(o[0][2], o[0][3]); w.z = cvt_pk_bf16(o[1][0], o[1][1]); w.w = cvt_pk_bf16(o[1][2], o[1][3]);
                if (r < u.rows) *(u32x4*)(H + (size_t)(u.orow + r) * 512 + col0) = w; }
    }
};
struct EpiMoe2 {
    static constexpr bool PERM = true;
    bf16_t* Y; int ldc;
    __device__ __forceinline__ void operator()(const f32x4 (&acc)[2][2][4][2], const Unit& u, int wr, int wc, int fr, int fq) const {
        const int col0 = u.pn * BM + wc * 32 + 8 * fq;
#pragma unroll
        for (int ai = 0; ai < 2; ++ai)
#pragma unroll
            for (int m = 0; m < 4; ++m) { const int r = ai * HALF + wr * 64 + m * 16 + fr;
#pragma unroll
                for (int bj = 0; bj < 2; ++bj) { const f32x4 v0 = acc[ai][bj][m][0], v1 = acc[ai][bj][m][1];
                    u32x4 w; w.x = cvt_pk_bf16(v0[0], v0[1]); w.y = cvt_pk_bf16(v0[2], v0[3]); w.z = cvt_pk_bf16(v1[0], v1[1]); w.w = cvt_pk_bf16(v1[2], v1[3]);
                    if (r < u.rows) *(u32x4*)(Y + (size_t)(u.orow + r) * ldc + col0 + bj * HALF) = w; } }
    }
};

template <class Epi, class Sched, bool ALIGN_EPI, bool SP2>
__device__ __forceinline__ void gemm_phase(PG8_LAS unsigned char* lds, const int K, const Sched& S, const Epi& E) {
    constexpr bool GATHER = Sched::GATHER;
    const int tid = threadIdx.x, wid = __builtin_amdgcn_readfirstlane(tid >> 6), lane = tid & 63, wr = wid >> 2, wc = wid & 3, fr = lane & 15, fq = lane >> 4;
    const int nt = K / BK;
    unsigned voffA[2][2], voffN[2][2], voffB[2]; int sR[2], sC[2];
#pragma unroll
    for (int i = 0; i < 2; ++i) { int R, C; stage_rc(tid * 16 + i * 8192, R, C); sR[i] = R; sC[i] = C; const int Rb = Epi::PERM ? ((R & ~31) + perm32(R & 31)) : R;
        voffA[0][i] = (unsigned)(R * K + C) * 2u; voffA[1][i] = voffA[0][i]; voffN[0][i] = voffA[0][i]; voffN[1][i] = voffA[0][i]; voffB[i] = (unsigned)(Rb * K + C) * 2u; }
    const size_t kstep = (size_t)(BK * 2);
    const size_t hstep = (size_t)HALF * K * 2;
    const unsigned ldsw = (unsigned)wid * 1024u;
    const int aoff = lds_byte(wr * 64 + fr, fq * 8), boff = lds_byte(wc * 32 + fr, fq * 8);
#define PG8_SA(b, h) (((b) * 2 + (h)) * HTB)
#define PG8_SB(b, h) ((4 + (b) * 2 + (h)) * HTB)
#define PG8_GLDS(gptr, ldsoff) __builtin_amdgcn_global_load_lds((const unsigned*)(gptr), (PG8_LAS unsigned*)(lds + (ldsoff)), 16, 0, 0)
#define PG8_STAGE_B(b, h, kptr) do { _Pragma("unroll") for (int _i = 0; _i < 2; ++_i) PG8_GLDS((kptr) + (size_t)(h) * hstep + voffB[_i], PG8_SB(b, h) + ldsw + _i * 8192); } while (0)
#define PG8_STAGE_A(b, h, kptr) do { _Pragma("unroll") for (int _i = 0; _i < 2; ++_i) { if constexpr (GATHER) PG8_GLDS((kptr) + voffA[h][_i], PG8_SA(b, h) + ldsw + _i * 8192); else PG8_GLDS((kptr) + (size_t)(h) * hstep + voffA[0][_i], PG8_SA(b, h) + ldsw + _i * 8192); } } while (0)
#define PG8_LDA(dst, b, h) do { _Pragma("unroll") for (int m = 0; m < 4; ++m) _Pragma("unroll") for (int k = 0; k < 2; ++k) dst[m][k] = *(const PG8_LAS bf16x8*)(lds + PG8_SA(b, h) + aoff + m * 2048 + k * 1024); } while (0)
#define PG8_LDB(dst, b, h) do { _Pragma("unroll") for (int n = 0; n < 2; ++n) _Pragma("unroll") for (int k = 0; k < 2; ++k) dst[n][k] = *(const PG8_LAS bf16x8*)(lds + PG8_SB(b, h) + boff + n * 2048 + k * 1024); } while (0)
#define PG8_MMA(ai, bj, At, Bt) do { __builtin_amdgcn_s_setprio(1); _Pragma("unroll") for (int m = 0; m < 4; ++m) _Pragma("unroll") for (int n = 0; n < 2; ++n) _Pragma("unroll") for (int k = 0; k < 2; ++k) \
        acc[ai][bj][m][n] = __builtin_amdgcn_mfma_f32_16x16x32_bf16(Bt[n][k], At[m][k], acc[ai][bj][m][n], 0, 0, 0); __builtin_amdgcn_s_setprio(0); } while (0)
#define PG8_WAIT_V(n) asm volatile("s_waitcnt vmcnt(" #n ")" ::: "memory")
#define PG8_WAIT_L(n) asm volatile("s_waitcnt lgkmcnt(" #n ")" ::: "memory")
#define PG8_BAR __builtin_amdgcn_s_barrier()
#define PG8_SCHED __builtin_amdgcn_sched_barrier(0)
#define PG8_LOAD_OFFS(dst, unit) do { _Pragma("unroll") for (int _h = 0; _h < 2; ++_h) _Pragma("unroll") for (int _i = 0; _i < 2; ++_i) dst[_h][_i] = (unsigned)S.tok(unit, _h * HALF + sR[_i]) * (unsigned)(K * 2) + (unsigned)(sC[_i] * 2); \
        asm volatile("s_waitcnt vmcnt(0)" ::: "memory"); } while (0)
    Unit cur, nxt; int ui = 0;
    if (!S.next(0, cur)) return;
    f32x4 acc[2][2][4][2];
#pragma unroll
    for (int a = 0; a < 2; ++a)
#pragma unroll
        for (int b = 0; b < 2; ++b)
#pragma unroll
            for (int m = 0; m < 4; ++m)
#pragma unroll
                for (int n = 0; n < 2; ++n) acc[a][b][m][n] = (f32x4){0.f, 0.f, 0.f, 0.f};
    bf16x8 At[4][2], B0[2][2], B1[2][2];
    const char* cA = S.a_ptr(cur); const char* cB = S.b_ptr(cur);
    if constexpr (GATHER) { PG8_LOAD_OFFS(voffA, cur);
#pragma unroll
        for (int h = 0; h < 2; ++h)
#pragma unroll
            for (int i = 0; i < 2; ++i) voffN[h][i] = voffA[h][i]; }
    if constexpr (SP2) {
        PG8_STAGE_B(0, 0, cB); PG8_STAGE_B(0, 1, cB); PG8_STAGE_A(0, 0, cA); PG8_STAGE_A(0, 1, cA);
        if (wr == 1) PG8_BAR;
        PG8_WAIT_V(2); PG8_BAR;
        PG8_STAGE_B(1, 0, cB + kstep); PG8_STAGE_A(1, 0, cA + kstep); PG8_STAGE_B(1, 1, cB + kstep);
        PG8_WAIT_V(6); PG8_BAR;
    } else {
        PG8_STAGE_B(0, 0, cB); PG8_STAGE_A(0, 0, cA); PG8_STAGE_B(0, 1, cB); PG8_STAGE_A(0, 1, cA);
        if (wr == 1) PG8_BAR;
        PG8_WAIT_V(4); PG8_BAR;
        PG8_STAGE_B(1, 0, cB + kstep); PG8_STAGE_A(1, 0, cA + kstep); PG8_STAGE_B(1, 1, cB + kstep);
        PG8_WAIT_V(6); PG8_BAR;
    }
    for (;;) {
        const bool has_next = S.next(ui + 1, nxt);
        const char* nA = has_next ? S.a_ptr(nxt) : cA; const char* nB = has_next ? S.b_ptr(nxt) : cB;
        for (int t = 0; t < nt; t += 2) {
            const bool last = (t == nt - 2);
            const char* a1 = cA + (size_t)(t + 1) * kstep;
            const char* a2 = last ? nA : cA + (size_t)(t + 2) * kstep; const char* b2 = last ? nB : cB + (size_t)(t + 2) * kstep;
            const char* a3 = a2 + kstep; const char* b3 = b2 + kstep;
            if constexpr (GATHER) { if (last && has_next) { PG8_LOAD_OFFS(voffN, nxt); } }
            if constexpr (SP2) {
            PG8_LDB(B0, 0, 0); PG8_LDB(B1, 0, 1); PG8_SCHED; PG8_LDA(At, 0, 0); PG8_STAGE_A(1, 1, a1);
            if constexpr (GATHER) { if (last) {
#pragma unroll
                for (int h = 0; h < 2; ++h)
#pragma unroll
                    for (int i = 0; i < 2; ++i) voffA[h][i] = voffN[h][i]; } }
            PG8_WAIT_V(8); PG8_WAIT_L(0); PG8_BAR; PG8_MMA(0, 0, At, B0); PG8_MMA(0, 1, At, B1); PG8_BAR; PG8_SCHED;
            PG8_LDA(At, 0, 1); PG8_STAGE_B(0, 0, b2); PG8_STAGE_B(0, 1, b2); PG8_STAGE_A(0, 0, a2);
            PG8_WAIT_V(8); PG8_WAIT_L(0); PG8_BAR; PG8_MMA(1, 0, At, B0); PG8_MMA(1, 1, At, B1); PG8_BAR; PG8_SCHED;
            PG8_LDB(B0, 1, 0); PG8_LDB(B1, 1, 1); PG8_SCHED; PG8_LDA(At, 1, 0); PG8_STAGE_A(0, 1, a2);
            PG8_WAIT_V(8); PG8_WAIT_L(0); PG8_BAR; PG8_MMA(0, 0, At, B0); PG8_MMA(0, 1, At, B1); PG8_BAR; PG8_SCHED;
            PG8_LDA(At, 1, 1); PG8_STAGE_B(1, 0, b3); PG8_STAGE_B(1, 1, b3); PG8_STAGE_A(1, 0, a3);
            PG8_WAIT_V(8); PG8_WAIT_L(0); PG8_BAR; PG8_MMA(1, 0, At, B0); PG8_MMA(1, 1, At, B1); PG8_BAR; PG8_SCHED;
            } else {
            PG8_LDB(B0, 0, 0); PG8_SCHED; PG8_LDA(At, 0, 0); PG8_STAGE_A(1, 1, a1);
            if constexpr (GATHER) { if (last) {
#pragma unroll
                for (int h = 0; h < 2; ++h)
#pragma unroll
                    for (int i = 0; i < 2; ++i) voffA[h][i] = voffN[h][i]; } }
            PG8_WAIT_L(8); PG8_BAR; PG8_WAIT_L(0); PG8_MMA(0, 0, At, B0); PG8_BAR; PG8_SCHED;
            PG8_LDB(B1, 0, 1); PG8_STAGE_B(0, 0, b2);
            PG8_BAR; PG8_WAIT_L(0); PG8_MMA(0, 1, At, B1); PG8_BAR;
            PG8_LDA(At, 0, 1); PG8_STAGE_A(0, 0, a2);
            PG8_BAR; PG8_WAIT_L(0); PG8_MMA(1, 0, At, B0); PG8_BAR; PG8_SCHED;
            PG8_STAGE_B(0, 1, b2);
            PG8_WAIT_V(6); PG8_BAR; PG8_MMA(1, 1, At, B1); PG8_BAR;
            PG8_LDB(B0, 1, 0); PG8_SCHED; PG8_LDA(At, 1, 0); PG8_STAGE_A(0, 1, a2);
            PG8_WAIT_L(8); PG8_BAR; PG8_WAIT_L(0); PG8_MMA(0, 0, At, B0); PG8_BAR; PG8_SCHED;
            PG8_LDB(B1, 1, 1); PG8_STAGE_B(1, 0, b3);
            PG8_BAR; PG8_WAIT_L(0); PG8_MMA(0, 1, At, B1); PG8_BAR;
            PG8_LDA(At, 1, 1); PG8_STAGE_A(1, 0, a3);
            PG8_BAR; PG8_WAIT_L(0); PG8_MMA(1, 0, At, B0); PG8_BAR; PG8_SCHED;
            PG8_STAGE_B(1, 1, b3);
            PG8_WAIT_V(6); PG8_BAR; PG8_MMA(1, 1, At, B1); PG8_BAR;
            }
        }
        if constexpr (ALIGN_EPI) { if (wr == 0) PG8_BAR; }
        E(acc, cur, wr, wc, fr, fq);
        if (!has_next) break;
#pragma unroll
        for (int a = 0; a < 2; ++a)
#pragma unroll
            for (int b = 0; b < 2; ++b)
#pragma unroll
                for (int m = 0; m < 4; ++m)
#pragma unroll
                    for (int n = 0; n < 2; ++n) acc[a][b][m][n] = (f32x4){0.f, 0.f, 0.f, 0.f};
        cur = nxt; cA = nA; cB = nB; ++ui;
        if constexpr (ALIGN_EPI) { if (wr == 1) PG8_BAR; }
    }
    PG8_WAIT_V(0);
    if constexpr (!ALIGN_EPI) { if (wr == 0) PG8_BAR; }
    PG8_BAR;
#undef PG8_SA
#undef PG8_SB
#undef PG8_GLDS
#undef PG8_STAGE_A
#undef PG8_STAGE_B
#undef PG8_LDA
#undef PG8_LDB
#undef PG8_MMA
#undef PG8_WAIT_V
#undef PG8_WAIT_L
#undef PG8_BAR
#undef PG8_SCHED
#undef PG8_LOAD_OFFS
}
}

constexpr int NWAVES = 8;
constexpr int N_LAUNCHES = MK_N_LAUNCHES;
constexpr int N_PHASES = 16;
constexpr int T = 16384, D = 2048, SEQ = 4096, NB = 4;
constexpr int NE = 64, NEA = 65, TOPK = 8, EXD = 512;
constexpr int NH = 16, HD = 128;
constexpr float LN_EPS = 1e-5f;
constexpr float ALPHA = 1.4142135623730951f;
constexpr float ROUTED_SCALE = 2.5f;
constexpr int NROWS = T * TOPK + T;

constexpr size_t MiB = 1u << 20;
constexpr size_t WS_CTL = 0, CTL_ZERO_BYTES = 1 * MiB;
constexpr size_t WS_LB = 1 * MiB;
constexpr size_t WS_VST = WS_LB + 64 * 1024;
constexpr size_t WS_WSP = 2 * MiB;
constexpr size_t WS_WR = 3 * MiB;
constexpr size_t WS_AES = 4 * MiB;
constexpr size_t WS_AW = 5 * MiB;
constexpr size_t WS_LIST = 6 * MiB;
constexpr size_t WS_GIN = 16 * MiB;
constexpr size_t WS_GOUT = WS_GIN + 16 * MiB;
constexpr size_t WS_HIN = WS_GOUT + 8 * MiB;
constexpr size_t WS_HOUT = WS_HIN + 32 * MiB;
constexpr size_t WS_W1 = WS_HOUT + 8 * MiB;
constexpr size_t W1_E = (size_t)1024 * 2048 * 2, W1_L = NEA * W1_E;
constexpr size_t WS_W2 = WS_W1 + 2 * W1_L;
constexpr size_t W2_E = (size_t)2048 * 512 * 2, W2_L = NEA * W2_E;
constexpr size_t WS_XA = WS_W2 + 2 * W2_L;
constexpr size_t WS_XR = WS_XA + 128 * MiB;
constexpr size_t WS_XB = WS_XR + 128 * MiB;
constexpr size_t WS_HM = WS_XB + 64 * MiB;
constexpr size_t WS_RA = WS_HM + 145 * MiB;
constexpr size_t WS_END = WS_RA + 576 * MiB;
constexpr size_t WS_XINB = WS_RA;
constexpr size_t WS_Z = WS_RA + 64 * MiB;
constexpr size_t WS_YG = WS_RA + 192 * MiB;
constexpr size_t WS_HQ = WS_RA, WS_HK = WS_RA + 64 * MiB, WS_HV = WS_RA + 128 * MiB, WS_HG = WS_RA + 192 * MiB;
constexpr size_t WS_HF = WS_RA + 256 * MiB;
constexpr size_t WS_HO = WS_RA + 384 * MiB;
static_assert((size_t)(NROWS + 256) * 512 * 2 <= 145 * MiB && (size_t)NROWS * D * 2 <= 576 * MiB && WS_END <= 2040 * MiB, "d_ws map");
constexpr int CW_BAR = 4096;
constexpr int CW_CNT = 16384;
constexpr int CNT_STRIDE = 16;

constexpr int RING_OFF = 0, RING_BYTES = 131072;
constexpr int LDSCTL_OFF = RING_BYTES;
constexpr int MISC_OFF = LDSCTL_OFF;
constexpr int LT_RB = LDSCTL_OFF + 256;
constexpr int LT_CNT = LDSCTL_OFF + 576;
constexpr int LT_NUNITS = LDSCTL_OFF + 896;
constexpr int LT_UNITS = LDSCTL_OFF + 1024;
constexpr int LDS_BYTES = 147456;

#define GAS __attribute__((address_space(1)))
#define LAS __attribute__((address_space(3)))
typedef unsigned short bf16;
typedef unsigned v4u __attribute__((ext_vector_type(4)));
typedef unsigned v2u __attribute__((ext_vector_type(2)));
typedef float f32x4 __attribute__((ext_vector_type(4)));
typedef short bf16x8 __attribute__((ext_vector_type(8)));
#define LDS_WAIT() asm volatile("s_waitcnt lgkmcnt(0)" ::: "memory")
#define VM_WAIT() asm volatile("s_waitcnt vmcnt(0)" ::: "memory")
__device__ __forceinline__ unsigned f2bf(float f) { unsigned u = __builtin_bit_cast(unsigned, f); return (u + 0x7fffu + ((u >> 16) & 1u)) >> 16; }
__device__ __forceinline__ unsigned pk2(float lo, float hi) { return f2bf(lo) | (f2bf(hi) << 16); }
__device__ __forceinline__ float bflo(unsigned w) { return __builtin_bit_cast(float, w << 16); }
__device__ __forceinline__ float bfhi(unsigned w) { return __builtin_bit_cast(float, w & 0xffff0000u); }
__device__ __forceinline__ float bf2f(unsigned short h) { return __builtin_bit_cast(float, (unsigned)h << 16); }

#define XB_TMO      128
#define XB_XCNT(j)  (256  + 64 * (j))
#define XB_XSUB(j)  (1280 + 64 * (j))
#define XB_XGEN(j)  (2304 + 64 * (j))
#define XB_TOP      3328
#define XB_TOPGEN   3392
#define XCD_BAR_WORDS 3456
#define XB_SPIN_CAP (1u << 18)
__device__ __forceinline__ unsigned xb_ld(unsigned* p)              { return __hip_atomic_load(p, __ATOMIC_RELAXED, __HIP_MEMORY_SCOPE_AGENT); }
__device__ __forceinline__ unsigned xb_add(unsigned* p, unsigned v) { return __hip_atomic_fetch_add(p, v, __ATOMIC_RELAXED, __HIP_MEMORY_SCOPE_AGENT); }
__device__ __forceinline__ unsigned xb_xcc_id() { return (unsigned)__builtin_amdgcn_s_getreg((3 << 11) | 20) & 0xFu; }
#define XB_SPIN(cond, bar) do { unsigned _sp = 0; while (cond) { __builtin_amdgcn_s_sleep(1); \
    if ((++_sp & 255u) == 0u) { if (xb_ld(&(bar)[XB_TMO])) break; if (_sp > XB_SPIN_CAP) { atomicAdd(&(bar)[XB_TMO], 1u); break; } } } } while (0)
struct XcdBarrier { unsigned* bar; unsigned x; volatile LAS unsigned* st; };
__device__ __forceinline__ XcdBarrier xcd_barrier_post(unsigned* bar, volatile LAS unsigned* st) {
    XcdBarrier b; b.bar = bar; b.x = xb_xcc_id(); b.st = st;
    if (threadIdx.x == 0) (void)xb_add(&bar[XB_XCNT(b.x)], 1u);
    return b;
}
__device__ __forceinline__ void xcd_barrier_complete(unsigned* bar, unsigned x, unsigned& nloc, unsigned& nx) {
    const unsigned G = gridDim.x * gridDim.y * gridDim.z;
    unsigned sum, cnt, mine, sp = 0u;
    for (;;) {
        sum = 0u; cnt = 0u; mine = 0u;
#pragma unroll
        for (unsigned j = 0; j < 16; ++j) { const unsigned c = xb_ld(&bar[XB_XCNT(j)]); sum += c; cnt += (c > 0u) ? 1u : 0u; mine = (j == x) ? c : mine; }
        if (sum == G) break;
        __builtin_amdgcn_s_sleep(1);
        if ((++sp & 255u) == 0u) { if (xb_ld(&bar[XB_TMO])) break; if (sp > XB_SPIN_CAP) { atomicAdd(&bar[XB_TMO], 1u); break; } }
    }
    nloc = mine > 0u ? mine : 1u; nx = cnt > 0u ? cnt : 1u;
}
__device__ __forceinline__ void xcd_barrier(const XcdBarrier& b) {
    asm volatile("s_waitcnt vmcnt(0)" ::: "memory");
    __syncthreads();
    if (threadIdx.x == 0) {
        unsigned* bar = b.bar;
        __builtin_amdgcn_s_waitcnt(0);
        unsigned nloc = b.st[0], nx = b.st[1];
        if (nloc == 0u) { xcd_barrier_complete(bar, b.x, nloc, nx); b.st[0] = nloc; b.st[1] = nx; }
        const unsigned old = xb_add(&bar[XB_XSUB(b.x)], 1u);
        const unsigned gen = old / nloc;
        if (old + 1u == (gen + 1u) * nloc) {
            __builtin_amdgcn_fence(__ATOMIC_RELEASE, "agent");
            asm volatile("s_waitcnt vmcnt(0)" ::: "memory");
            const unsigned og = xb_add(&bar[XB_TOP], 1u);
            const unsigned tg = og / nx;
            if (og + 1u == (tg + 1u) * nx) xb_add(&bar[XB_TOPGEN], 1u);
            else XB_SPIN(xb_ld(&bar[XB_TOPGEN]) == tg, bar);
            __builtin_amdgcn_fence(__ATOMIC_ACQUIRE, "agent");
            xb_add(&bar[XB_XGEN(b.x)], 1u);
            asm volatile("s_waitcnt vmcnt(0)" ::: "memory");
        } else {
            XB_SPIN(xb_ld(&bar[XB_XGEN(b.x)]) == gen, bar);
            __builtin_amdgcn_fence(__ATOMIC_ACQUIRE, "agent");
            asm volatile("s_waitcnt vmcnt(0)" ::: "memory");
        }
    }
    __syncthreads();
}

struct Args { const float* in[23]; float* out; unsigned char* ws; int ph_lo, ph_hi; };
struct Frame {
    LAS unsigned char* lds;
    unsigned* ctl;
    unsigned char* ws;
    int tid, lane, wave, vcu, G;
    __device__ __forceinline__ void refresh() { int t = threadIdx.x; asm volatile("" : "+v"(t)); tid = t; lane = t & 63; wave = __builtin_amdgcn_readfirstlane(t >> 6); }
};
#define DPP_F(v, ctrl) __builtin_bit_cast(float, __builtin_amdgcn_update_dpp(0, __builtin_bit_cast(int, (v)), (ctrl), 0xf, 0xf, true))
__device__ __forceinline__ float wave_sum(float v) {
    v += DPP_F(v, 0xB1); v += DPP_F(v, 0x4E); v += DPP_F(v, 0x141); v += DPP_F(v, 0x140);
    const int iv = __builtin_bit_cast(int, v);
    return (__builtin_bit_cast(float, __builtin_amdgcn_readlane(iv, 0)) + __builtin_bit_cast(float, __builtin_amdgcn_readlane(iv, 16))) + (__builtin_bit_cast(float, __builtin_amdgcn_readlane(iv, 32)) + __builtin_bit_cast(float, __builtin_amdgcn_readlane(iv, 48)));
}
#define OPAQUE(x) asm volatile("" : "+v"(x))

__device__ __forceinline__ void p0_transpose_item(const float* W, int N, int K, bf16* WT, int k0, int n0, int dst_row0, LAS float* scr, int lane) {
#pragma unroll
    for (int i = 0; i < 8; ++i) { const int kk = 8 * i + (lane >> 3), n4 = (lane & 7) * 4; const f32x4 v = *(const f32x4*)(W + (size_t)(k0 + kk) * N + n0 + n4);
        LAS float* d = scr + kk * 33 + n4; d[0] = v.x; d[1] = v.y; d[2] = v.z; d[3] = v.w; }
    LDS_WAIT(); asm volatile("" ::: "memory");
    const int c = lane & 7;
#pragma unroll
    for (int j = 0; j < 4; ++j) { const int n = (lane >> 3) + 8 * j; const LAS float* s = scr + (8 * c) * 33 + n;
        v4u o; o.x = pk2(s[0 * 33], s[1 * 33]); o.y = pk2(s[2 * 33], s[3 * 33]); o.z = pk2(s[4 * 33], s[5 * 33]); o.w = pk2(s[6 * 33], s[7 * 33]);
        *(v4u*)(WT + (size_t)(dst_row0 + n) * K + k0 + 8 * c) = o; }
    LDS_WAIT(); asm volatile("" ::: "memory");
}
__device__ __forceinline__ void p0_prologue(Frame& F, const Args& A) {
    LAS float* scr = (LAS float*)(F.lds + RING_OFF + F.wave * 16384);
    const int gw = F.vcu * NWAVES + F.wave, NGW = F.G * NWAVES;
    constexpr int I0 = 32 * 128, I1 = 32 * 64, I2 = 32 * 256, I3 = 32 * 64, IM = 2 * NEA * 1536;
    constexpr int NITEMS = I0 + I1 + I2 + I3 + IM;
    for (int it = gw; it < NITEMS; it += NGW) {
        int r = it;
        if (r < I0) { p0_transpose_item(A.in[5], 4096, 2048, (bf16*)(F.ws + WS_GIN), 64 * (r / 128), 32 * (r % 128), 32 * (r % 128), scr, F.lane); continue; } r -= I0;
        if (r < I1) { p0_transpose_item(A.in[10], 2048, 2048, (bf16*)(F.ws + WS_GOUT), 64 * (r / 64), 32 * (r % 64), 32 * (r % 64), scr, F.lane); continue; } r -= I1;
        if (r < I2) { p0_transpose_item(A.in[11], 8192, 2048, (bf16*)(F.ws + WS_HIN), 64 * (r / 256), 32 * (r % 256), 32 * (r % 256), scr, F.lane); continue; } r -= I2;
        if (r < I3) { p0_transpose_item(A.in[13], 2048, 2048, (bf16*)(F.ws + WS_HOUT), 64 * (r / 64), 32 * (r % 64), 32 * (r % 64), scr, F.lane); continue; } r -= I3;
        const int le = r / 1536, sub = r % 1536, l = le / NEA, e = le % NEA, part = sub / 512, idx = sub % 512;
        if (part < 2) {
            const float* W = e < NE ? (part == 0 ? A.in[17] : A.in[18]) + (size_t)(l * NE + e) * 2048 * 512 : (part == 0 ? A.in[20] : A.in[21]) + (size_t)l * 2048 * 512;
            const int kb = idx / 16, nb = idx % 16, n0 = 32 * nb;
            p0_transpose_item(W, 512, 2048, (bf16*)(F.ws + WS_W1 + l * W1_L + e * W1_E), 64 * kb, n0, (n0 / 128) * 256 + part * 128 + (n0 % 128), scr, F.lane);
        } else {
            const float* W = e < NE ? A.in[19] + (size_t)(l * NE + e) * 512 * 2048 : A.in[22] + (size_t)l * 512 * 2048;
            const int kb = idx / 64, nb = idx % 64;
            p0_transpose_item(W, 2048, 512, (bf16*)(F.ws + WS_W2 + l * W2_L + e * W2_E), 64 * kb, 32 * nb, 32 * nb, scr, F.lane);
        }
    }
    const size_t gt = (size_t)F.vcu * (NWAVES * 64) + F.tid, NT = (size_t)F.G * NWAVES * 64;
    { const f32x4* x4 = (const f32x4*)A.in[0]; v4u* o = (v4u*)(F.ws + WS_XINB);
      for (size_t i = gt; i < (size_t)T * D / 8; i += NT) { const f32x4 a = x4[2 * i], b = x4[2 * i + 1]; v4u w; w.x = pk2(a.x, a.y); w.y = pk2(a.z, a.w); w.z = pk2(b.x, b.y); w.w = pk2(b.z, b.w); o[i] = w; } }
    { float* lb = (float*)(F.ws + WS_LB); const float* hb = A.in[14];
      for (size_t i = gt; i < (size_t)D; i += NT) { const float a = hb[i], b = hb[D + i]; lb[i] = 1.0f / (1.0f + __expf(a - b)); } }
    { bf16* wo = (bf16*)(F.ws + WS_WSP); const float* wi = A.in[8];
      for (size_t i = gt; i < (size_t)NH * 128 * 128; i += NT) { const int ii = (int)((i >> 7) & 127), jj = (int)(i & 127); const float v = ((ii >> 6) >= (jj >> 6)) ? wi[i] : 0.0f; wo[i] = (bf16)f2bf(v); } }
    { bf16* wr = (bf16*)(F.ws + WS_WR); const float* wi = A.in[15];
      for (size_t i = gt; i < (size_t)2 * NE * D; i += NT) { const int l = (int)(i / (NE * D)), n = (int)((i / D) % NE), k = (int)(i % D);
          const float w = wi[(size_t)l * D * NE + (size_t)k * NE + n]; const unsigned hi = f2bf(w); const float lo = w - bf2f((unsigned short)hi);
          wr[((size_t)(l * 2 + 0) * NE + n) * D + k] = (bf16)hi; wr[((size_t)(l * 2 + 1) * NE + n) * D + k] = (bf16)f2bf(lo); } }
}

__device__ __forceinline__ void p_vstats(Frame& F) {
    const int gw = F.vcu * NWAVES + F.wave, NGW = F.G * NWAVES;
    const bf16* Z = (const bf16*)(F.ws + WS_Z); float* vst = (float*)(F.ws + WS_VST);
    for (int t = gw; t < T; t += NGW) {
        const v4u* p = (const v4u*)(Z + (size_t)t * 4096 + 2048) + F.lane;
        float v[32]; float s = 0.f;
#pragma unroll
        for (int j = 0; j < 4; ++j) { const v4u w = p[64 * j];
            v[8 * j + 0] = bflo(w.x); v[8 * j + 1] = bfhi(w.x); v[8 * j + 2] = bflo(w.y); v[8 * j + 3] = bfhi(w.y); v[8 * j + 4] = bflo(w.z); v[8 * j + 5] = bfhi(w.z); v[8 * j + 6] = bflo(w.w); v[8 * j + 7] = bfhi(w.w); }
#pragma unroll
        for (int i = 0; i < 32; ++i) s += v[i];
        const float mean = wave_sum(s) * (1.0f / 2048.0f); float q = 0.f;
#pragma unroll
        for (int i = 0; i < 32; ++i) { const float d = v[i] - mean; q += d * d; }
        const float rstd = 1.0f / sqrtf(wave_sum(q) * (1.0f / 2048.0f) + LN_EPS);
        if (F.lane == 0) { vst[2 * t] = mean; vst[2 * t + 1] = rstd; }
    }
}

__device__ __forceinline__ void p_spatial(Frame& F, const Args& A) {
    constexpr int PITCH = 272;
    const bf16* Z = (const bf16*)(F.ws + WS_Z); const float* vst = (const float*)(F.ws + WS_VST); const bf16* WSP = (const bf16*)(F.ws + WS_WSP); bf16* YG = (bf16*)(F.ws + WS_YG);
    const float* vg = A.in[6]; const float* vb = A.in[7]; const float* bsp = A.in[9];
    LAS unsigned char* img = F.lds + RING_OFF;
    const int r = F.lane & 15, q = F.lane >> 4, w = F.wave;
    for (int unit = F.vcu; unit < (T / 128) * NH; unit += F.G) {
        const int n = unit / NH, h = unit % NH, t0 = n * 128;
        __syncthreads();
#pragma unroll
        for (int it = 0; it < 4; ++it) { const int idx = F.tid + 512 * it, j = idx & 127, c8 = idx >> 7;
            const v4u raw = *(const v4u*)(Z + (size_t)(t0 + j) * 4096 + 2048 + h * 128 + c8 * 8);
            const float mean = vst[2 * (t0 + j)], rstd = vst[2 * (t0 + j) + 1];
            const f32x4 g0 = *(const f32x4*)(vg + h * 128 + c8 * 8), g1 = *(const f32x4*)(vg + h * 128 + c8 * 8 + 4), b0 = *(const f32x4*)(vb + h * 128 + c8 * 8), b1 = *(const f32x4*)(vb + h * 128 + c8 * 8 + 4);
            float x[8] = {bflo(raw.x), bfhi(raw.x), bflo(raw.y), bfhi(raw.y), bflo(raw.z), bfhi(raw.z), bflo(raw.w), bfhi(raw.w)};
            const float gg[8] = {g0.x, g0.y, g0.z, g0.w, g1.x, g1.y, g1.z, g1.w}, bb[8] = {b0.x, b0.y, b0.z, b0.w, b1.x, b1.y, b1.z, b1.w};
#pragma unroll
            for (int i = 0; i < 8; ++i) { const float y = (x[i] - mean) * rstd * gg[i] + bb[i]; *(LAS unsigned short*)(img + (c8 * 8 + i) * PITCH + j * 2) = (unsigned short)f2bf(y); } }
        __syncthreads();
        f32x4 acc[8];
#pragma unroll
        for (int ct = 0; ct < 8; ++ct) acc[ct] = (f32x4){0.f, 0.f, 0.f, 0.f};
        bf16x8 bw[4];
#pragma unroll
        for (int ks = 0; ks < 4; ++ks) bw[ks] = *(const bf16x8*)(WSP + ((size_t)h * 128 + 16 * w + r) * 128 + 32 * ks + 8 * q);
#pragma unroll
        for (int ct = 0; ct < 8; ++ct)
#pragma unroll
            for (int ks = 0; ks < 4; ++ks) { const bf16x8 a = *(const LAS bf16x8*)(img + (16 * ct + r) * PITCH + (32 * ks + 8 * q) * 2);
                acc[ct] = __builtin_amdgcn_mfma_f32_16x16x32_bf16(a, bw[ks], acc[ct], 0, 0, 0); }
        const int tok = t0 + 16 * w + r; const float bias = bsp[h * 128 + 16 * w + r];
#pragma unroll
        for (int ct = 0; ct < 8; ++ct) { const int col = h * 128 + 16 * ct + 4 * q;
            const v2u uu = *(const v2u*)(Z + (size_t)tok * 4096 + col);
            v2u o; o.x = pk2((acc[ct][0] + bias) * bflo(uu.x), (acc[ct][1] + bias) * bfhi(uu.x)); o.y = pk2((acc[ct][2] + bias) * bflo(uu.y), (acc[ct][3] + bias) * bfhi(uu.y));
            *(v2u*)(YG + (size_t)tok * D + col) = o; }
    }
    __syncthreads();
}

__device__ __forceinline__ void p_ln_router(Frame& F, const Args& A, const float* rin, const float* lg, const float* lbias, float* xf, bf16* xb, int layer) {
    const int gw = F.vcu * NWAVES + F.wave, NGW = F.G * NWAVES;
    const bf16* WRh = (const bf16*)(F.ws + WS_WR) + (size_t)(layer * 2 + 0) * NE * D; const bf16* WRl = (const bf16*)(F.ws + WS_WR) + (size_t)(layer * 2 + 1) * NE * D;
    const float* ebias = A.in[16] + layer * NE;
    unsigned* cnt = F.ctl + CW_CNT + layer * NE * CNT_STRIDE;
    unsigned* list = (unsigned*)(F.ws + WS_LIST); unsigned* aes = (unsigned*)(F.ws + WS_AES); float* aw = (float*)(F.ws + WS_AW);
    LAS float* Ls = (LAS float*)(F.lds + RING_OFF + F.wave * 8448); LAS float* Lc = Ls + 16 * 65;
    const int r = F.lane & 15, q = F.lane >> 4;
    for (int wt = gw; wt < T / 16; wt += NGW) {
        const int row = wt * 16 + r;
        const float* rp = rin + (size_t)row * D + 8 * q;
        float s = 0.f, ss = 0.f;
#pragma unroll 8
        for (int j = 0; j < 64; ++j) { const f32x4 a = *(const f32x4*)(rp + 32 * j), b = *(const f32x4*)(rp + 32 * j + 4);
            s += (a.x + a.y) + (a.z + a.w) + (b.x + b.y) + (b.z + b.w); ss += (a.x * a.x + a.y * a.y) + (a.z * a.z + a.w * a.w) + (b.x * b.x + b.y * b.y) + (b.z * b.z + b.w * b.w); }
        s += __shfl_xor(s, 16); s += __shfl_xor(s, 32); ss += __shfl_xor(ss, 16); ss += __shfl_xor(ss, 32);
        const float mean = s * (1.0f / D); const float var = fmaxf(ss * (1.0f / D) - mean * mean, 0.f); const float rstd = 1.0f / sqrtf(var + LN_EPS);
        f32x4 acc[4];
#pragma unroll
        for (int nt = 0; nt < 4; ++nt) acc[nt] = (f32x4){0.f, 0.f, 0.f, 0.f};
#pragma unroll 2
        for (int j = 0; j < 64; ++j) { const int c0 = 32 * j + 8 * q;
            const f32x4 a = *(const f32x4*)(rp + 32 * j), b = *(const f32x4*)(rp + 32 * j + 4);
            const f32x4 g0 = *(const f32x4*)(lg + c0), g1 = *(const f32x4*)(lg + c0 + 4), b0 = *(const f32x4*)(lbias + c0), b1 = *(const f32x4*)(lbias + c0 + 4);
            const f32x4 y0 = (a - mean) * rstd * g0 + b0, y1 = (b - mean) * rstd * g1 + b1;
            *(f32x4*)(xf + (size_t)row * D + c0) = y0; *(f32x4*)(xf + (size_t)row * D + c0 + 4) = y1;
            unsigned hi[4], lo[4];
            hi[0] = pk2(y0.x, y0.y); hi[1] = pk2(y0.z, y0.w); hi[2] = pk2(y1.x, y1.y); hi[3] = pk2(y1.z, y1.w);
            lo[0] = pk2(y0.x - bflo(hi[0]), y0.y - bfhi(hi[0])); lo[1] = pk2(y0.z - bflo(hi[1]), y0.w - bfhi(hi[1])); lo[2] = pk2(y1.x - bflo(hi[2]), y1.y - bfhi(hi[2])); lo[3] = pk2(y1.z - bflo(hi[3]), y1.w - bfhi(hi[3]));
            v4u hv; hv.x = hi[0]; hv.y = hi[1]; hv.z = hi[2]; hv.w = hi[3]; v4u lv; lv.x = lo[0]; lv.y = lo[1]; lv.z = lo[2]; lv.w = lo[3];
            *(v4u*)(xb + (size_t)row * D + c0) = hv;
            const bf16x8 ah = __builtin_bit_cast(bf16x8, hv), al = __builtin_bit_cast(bf16x8, lv);
#pragma unroll
            for (int nt = 0; nt < 4; ++nt) { const bf16x8 bh = *(const bf16x8*)(WRh + (size_t)(16 * nt + r) * D + c0), bl = *(const bf16x8*)(WRl + (size_t)(16 * nt + r) * D + c0);
                acc[nt] = __builtin_amdgcn_mfma_f32_16x16x32_bf16(ah, bh, acc[nt], 0, 0, 0);
                acc[nt] = __builtin_amdgcn_mfma_f32_16x16x32_bf16(al, bh, acc[nt], 0, 0, 0);
                acc[nt] = __builtin_amdgcn_mfma_f32_16x16x32_bf16(ah, bl, acc[nt], 0, 0, 0); } }
#pragma unroll
        for (int nt = 0; nt < 4; ++nt)
#pragma unroll
            for (int i = 0; i < 4; ++i) Ls[(4 * q + i) * 65 + 16 * nt + r] = acc[nt][i];
        LDS_WAIT(); asm volatile("" ::: "memory");
        if (F.lane < 16) {
            const int tk = F.lane, token = wt * 16 + tk;
            LAS float* ps = Ls + tk * 65; LAS float* pc = Lc + tk * 65;
            float gs[8];
#pragma unroll
            for (int g = 0; g < 8; ++g) { float m1 = -INFINITY, m2 = -INFINITY;
#pragma unroll
                for (int i = 0; i < 8; ++i) { const int e = 8 * g + i; const float sg = 1.0f / (1.0f + __expf(-ps[e])); const float c = sg + ebias[e]; ps[e] = sg; pc[e] = c;
                    if (c > m1) { m2 = m1; m1 = c; } else if (c > m2) m2 = c; }
                gs[g] = m1 + m2; }
            unsigned allowed = 0u;
#pragma unroll
            for (int k = 0; k < 4; ++k) { float best = -INFINITY; int bi = 0;
#pragma unroll
                for (int g = 0; g < 8; ++g) { const bool ok = !((allowed >> g) & 1u) && (gs[g] > best); best = ok ? gs[g] : best; bi = ok ? g : bi; }
                allowed |= 1u << bi; }
            int sel[8]; float sw[8]; float ssum = 0.f;
#pragma unroll
            for (int k = 0; k < 8; ++k) { float best = -INFINITY; int be = 0;
                for (int e = 0; e < 64; ++e) { const float c = pc[e]; const bool ok = ((allowed >> (e >> 3)) & 1u) && (c > best); best = ok ? c : best; be = ok ? e : be; }
                sel[k] = be; pc[be] = -INFINITY; sw[k] = ps[be]; ssum += sw[k]; }
            const float inv = ROUTED_SCALE / ssum;
#pragma unroll
            for (int k = 0; k < 8; ++k) { const int e = sel[k];
                const unsigned slot = __hip_atomic_fetch_add(cnt + e * CNT_STRIDE, 1u, __ATOMIC_RELAXED, __HIP_MEMORY_SCOPE_AGENT);
                list[(size_t)e * 16384 + slot] = (unsigned)token; aes[(size_t)token * 8 + k] = ((unsigned)e << 16) | slot; aw[(size_t)token * 8 + k] = sw[k] * inv; }
        }
        LDS_WAIT(); asm volatile("" ::: "memory");
    }
}

__device__ __forceinline__ void moe_tables(Frame& F, int layer, int NPN) {
    LAS int* lc = (LAS int*)(F.lds + LT_CNT); LAS int* rb = (LAS int*)(F.lds + LT_RB); LAS int* tab = (LAS int*)(F.lds + LT_UNITS); LAS int* nun = (LAS int*)(F.lds + LT_NUNITS);
    const unsigned* cnt = F.ctl + CW_CNT + layer * NE * CNT_STRIDE;
    __syncthreads();
    if (F.tid < NEA) lc[F.tid] = F.tid < NE ? (int)__hip_atomic_load(cnt + F.tid * CNT_STRIDE, __ATOMIC_RELAXED, __HIP_MEMORY_SCOPE_AGENT) : T;
    __syncthreads();
    if (F.tid == 0) {
        int run = 0, tiles = 0;
        for (int e = 0; e < NEA; ++e) { const int c = lc[e]; rb[e] = run; run += c; tiles += (c + 255) >> 8; }
        rb[NEA] = run;
        int n = 0;
        if (NPN > 0) {
            const int total = tiles * NPN, qq = total / 8, rr = total % 8;
            for (int i = 0; i < 64; ++i) {
                const long L = (long)i * F.G + (int)blockIdx.x; if (L >= total) break;
                const int xcd = (int)(L % 8), off = (int)(L / 8);
                const int up = (xcd < rr ? xcd * (qq + 1) : rr * (qq + 1) + (xcd - rr) * qq) + off;
                const int rt = up / NPN, pn = up % NPN;
                int e = 0, a = 0;
                for (; e < NEA - 1; ++e) { const int te = (lc[e] + 255) >> 8; if (rt < a + te) break; a += te; }
                const int mt = rt - a, c = lc[e];
                tab[5 * n + 0] = e; tab[5 * n + 1] = mt; tab[5 * n + 2] = pn; tab[5 * n + 3] = (c - mt * 256) < 256 ? (c - mt * 256) : 256; tab[5 * n + 4] = rb[e] + mt * 256; ++n;
            }
        }
        nun[0] = n;
    }
    __syncthreads();
}

__device__ __forceinline__ void p_combine_ln(Frame& F, const float* xres, const float* lg, const float* lbias, float* of, bf16* ob, int layer) {
    moe_tables(F, layer, 0);
    const LAS int* rb = (const LAS int*)(F.lds + LT_RB);
    const int gw = F.vcu * NWAVES + F.wave, NGW = F.G * NWAVES;
    const bf16* Y = (const bf16*)(F.ws + WS_RA); const unsigned* aes = (const unsigned*)(F.ws + WS_AES); const float* aw = (const float*)(F.ws + WS_AW);
    for (int t = gw; t < T; t += NGW) {
        int ln = F.lane; OPAQUE(ln);
        unsigned es = 0u; float wv = 0.f;
        if (F.lane < 8) { es = aes[(size_t)t * 8 + F.lane]; wv = aw[(size_t)t * 8 + F.lane]; }
        int rowk[9]; float wk[9];
#pragma unroll
        for (int k = 0; k < 8; ++k) { const unsigned x = (unsigned)__shfl((int)es, k); wk[k] = __shfl(wv, k); rowk[k] = rb[x >> 16] + (int)(x & 0xffffu); }
        rowk[8] = T * TOPK + t; wk[8] = 1.0f;
        float v[32];
#pragma unroll
        for (int jj = 0; jj < 4; ++jj) { const int c0 = 512 * jj + 8 * ln;
            const f32x4 a = *(const f32x4*)(xres + (size_t)t * D + c0), b = *(const f32x4*)(xres + (size_t)t * D + c0 + 4);
            v[8 * jj + 0] = ALPHA * a.x; v[8 * jj + 1] = ALPHA * a.y; v[8 * jj + 2] = ALPHA * a.z; v[8 * jj + 3] = ALPHA * a.w; v[8 * jj + 4] = ALPHA * b.x; v[8 * jj + 5] = ALPHA * b.y; v[8 * jj + 6] = ALPHA * b.z; v[8 * jj + 7] = ALPHA * b.w; }
#pragma unroll
        for (int k = 0; k < 9; ++k) { const bf16* yr = Y + (size_t)rowk[k] * D + 8 * ln; const float w = wk[k];
#pragma unroll
            for (int jj = 0; jj < 4; ++jj) { const v4u p = *(const v4u*)(yr + 512 * jj);
                v[8 * jj + 0] += w * bflo(p.x); v[8 * jj + 1] += w * bfhi(p.x); v[8 * jj + 2] += w * bflo(p.y); v[8 * jj + 3] += w * bfhi(p.y); v[8 * jj + 4] += w * bflo(p.z); v[8 * jj + 5] += w * bfhi(p.z); v[8 * jj + 6] += w * bflo(p.w); v[8 * jj + 7] += w * bfhi(p.w); }
            if ((k % 3) == 2) asm volatile("" ::: "memory"); }
        float s = 0.f;
#pragma unroll
        for (int i = 0; i < 32; ++i) s += v[i];
        const float mean = wave_sum(s) * (1.0f / D); float qv = 0.f;
#pragma unroll
        for (int i = 0; i < 32; ++i) { const float d = v[i] - mean; qv += d * d; }
        const float rstd = 1.0f / sqrtf(wave_sum(qv) * (1.0f / D) + LN_EPS);
#pragma unroll
        for (int jj = 0; jj < 4; ++jj) { const int c0 = 512 * jj + 8 * ln;
            const f32x4 g0 = *(const f32x4*)(lg + c0), g1 = *(const f32x4*)(lg + c0 + 4), b0 = *(const f32x4*)(lbias + c0), b1 = *(const f32x4*)(lbias + c0 + 4);
            f32x4 y0, y1;
            y0.x = (v[8 * jj + 0] - mean) * rstd * g0.x + b0.x; y0.y = (v[8 * jj + 1] - mean) * rstd * g0.y + b0.y; y0.z = (v[8 * jj + 2] - mean) * rstd * g0.z + b0.z; y0.w = (v[8 * jj + 3] - mean) * rstd * g0.w + b0.w;
            y1.x = (v[8 * jj + 4] - mean) * rstd * g1.x + b1.x; y1.y = (v[8 * jj + 5] - mean) * rstd * g1.y + b1.y; y1.z = (v[8 * jj + 6] - mean) * rstd * g1.z + b1.z; y1.w = (v[8 * jj + 7] - mean) * rstd * g1.w + b1.w;
            *(f32x4*)(of + (size_t)t * D + c0) = y0; *(f32x4*)(of + (size_t)t * D + c0 + 4) = y1;
            if (ob) { v4u w; w.x = pk2(y0.x, y0.y); w.y = pk2(y0.z, y0.w); w.z = pk2(y1.x, y1.y); w.w = pk2(y1.z, y1.w); *(v4u*)(ob + (size_t)t * D + c0) = w; } }
    }
}

__device__ __forceinline__ void p_recurrence(Frame& F, const Args& A) {
    const bf16* Q = (const bf16*)(F.ws + WS_HQ); const bf16* Kk = (const bf16*)(F.ws + WS_HK); const bf16* V = (const bf16*)(F.ws + WS_HV); const bf16* Gt = (const bf16*)(F.ws + WS_HG);
    const float* Fg = (const float*)(F.ws + WS_HF); bf16* O = (bf16*)(F.ws + WS_HO); const float* normg = A.in[12];
    LAS float* Lq = (LAS float*)(F.lds + RING_OFF); LAS float* Lk = Lq + 4096; LAS float* Lf = Lk + 4096;
    LAS unsigned short* Lv = (LAS unsigned short*)(Lf + 4096); LAS unsigned short* Lg = Lv + 4096; LAS float* Lo = (LAS float*)(Lg + 4096);
    const int v = F.tid & 127, kg = F.tid >> 7;
    for (int unit = (int)blockIdx.x; unit < NB * NH; unit += F.G) {
        const int b = unit / NH, h = unit % NH;
        float S[32];
#pragma unroll
        for (int i = 0; i < 32; ++i) S[i] = 0.f;
        for (int batch = 0; batch < SEQ / 32; ++batch) {
            const int t0 = b * SEQ + batch * 32;
            __syncthreads();
            { const int tt = F.tid >> 4, c8 = F.tid & 15; const size_t off = (size_t)(t0 + tt) * D + h * HD + c8 * 8; const int lo = tt * 128 + c8 * 8;
              const v4u qw = *(const v4u*)(Q + off), kw = *(const v4u*)(Kk + off), vw = *(const v4u*)(V + off), gw = *(const v4u*)(Gt + off);
              const f32x4 f0 = *(const f32x4*)(Fg + off), f1 = *(const f32x4*)(Fg + off + 4);
              *(LAS f32x4*)(Lq + lo) = (f32x4){bflo(qw.x), bfhi(qw.x), bflo(qw.y), bfhi(qw.y)}; *(LAS f32x4*)(Lq + lo + 4) = (f32x4){bflo(qw.z), bfhi(qw.z), bflo(qw.w), bfhi(qw.w)};
              *(LAS f32x4*)(Lk + lo) = (f32x4){bflo(kw.x), bfhi(kw.x), bflo(kw.y), bfhi(kw.y)}; *(LAS f32x4*)(Lk + lo + 4) = (f32x4){bflo(kw.z), bfhi(kw.z), bflo(kw.w), bfhi(kw.w)};
              *(LAS f32x4*)(Lf + lo) = f0; *(LAS f32x4*)(Lf + lo + 4) = f1;
              *(LAS v4u*)(Lv + lo) = vw; *(LAS v4u*)(Lg + lo) = gw; }
            __syncthreads();
            for (int tt = 0; tt < 32; ++tt) {
                const float vv = bf2f(Lv[tt * 128 + v]); float acc = 0.f;
#pragma unroll
                for (int i4 = 0; i4 < 8; ++i4) { const int ko = tt * 128 + 32 * kg + 4 * i4;
                    const f32x4 ff = *(const LAS f32x4*)(Lf + ko), kk = *(const LAS f32x4*)(Lk + ko), qq = *(const LAS f32x4*)(Lq + ko);
#pragma unroll
                    for (int j = 0; j < 4; ++j) { S[4 * i4 + j] = ff[j] * S[4 * i4 + j] + kk[j] * vv; acc += S[4 * i4 + j] * qq[j]; } }
                Lo[(tt * 4 + kg) * 128 + v] = acc;
            }
            __syncthreads();
#pragma unroll
            for (int i = 0; i < 4; ++i) { const int tt = 4 * F.wave + i;
                float o0 = 0.f, o1 = 0.f;
#pragma unroll
                for (int g = 0; g < 4; ++g) { o0 += Lo[(tt * 4 + g) * 128 + F.lane]; o1 += Lo[(tt * 4 + g) * 128 + 64 + F.lane]; }
                const float ms = wave_sum(o0 * o0 + o1 * o1) * (1.0f / HD); const float rr = 1.0f / sqrtf(ms + LN_EPS);
                const size_t off = (size_t)(t0 + tt) * D + h * HD;
                O[off + F.lane] = (bf16)f2bf(o0 * rr * normg[F.lane] * bf2f(Lg[tt * 128 + F.lane]));
                O[off + 64 + F.lane] = (bf16)f2bf(o1 * rr * normg[64 + F.lane] * bf2f(Lg[tt * 128 + 64 + F.lane])); }
        }
    }
    __syncthreads();
}

__global__ void __launch_bounds__(NWAVES * 64, 2) mk_fwd(Args args) {
    extern __shared__ __attribute__((aligned(16))) unsigned char lds[];
    Frame F;
    F.lds = (LAS unsigned char*)lds;
    F.tid = threadIdx.x; F.lane = F.tid & 63; F.wave = __builtin_amdgcn_readfirstlane(F.tid >> 6);
    F.G = gridDim.x; { const int bx = blockIdx.x; F.vcu = (F.G % 8 == 0) ? (bx % 8) * (F.G / 8) + bx / 8 : bx; }
    F.ws = args.ws; F.ctl = (unsigned*)(args.ws + WS_CTL);
    const Args& A = args;
    for (int u = F.tid; u < (LDS_BYTES - LDSCTL_OFF) / 4; u += NWAVES * 64) ((LAS unsigned*)(F.lds + LDSCTL_OFF))[u] = 0u;
    __syncthreads();
    XcdBarrier bar; bar.bar = F.ctl + CW_BAR; bar.x = 0; bar.st = nullptr;
    if (N_LAUNCHES == 1) bar = xcd_barrier_post(F.ctl + CW_BAR, (volatile LAS unsigned*)(F.lds + MISC_OFF) + 8);
    const int lo = args.ph_lo, hi = args.ph_hi;
#ifndef PH_MASK
#define PH_MASK 0xFFFF
#endif
#define IN(k) (((PH_MASK >> (k)) & 1) && lo <= (k) && (k) < hi)
#define SEAM(k) do { if (IN(k) && IN((k) + 1)) xcd_barrier(bar); } while (0)
    unsigned char* ws = args.ws;
    LAS unsigned char* ring = F.lds + RING_OFF;

    if (IN(0)) { F.refresh(); p0_prologue(F, A); SEAM(0); }
    if (IN(1)) { F.refresh();
        pg8::DenseOrder S; S.init(ws + WS_XINB, ws + WS_GIN, T, 2 * D, D, F.G, (int)blockIdx.x);
        pg8::EpiGelu E{(bf16*)(ws + WS_Z), 2 * D};
        pg8::gemm_phase<pg8::EpiGelu, pg8::DenseOrder, true, true>(ring, D, S, E);
        SEAM(1);
    }
    if (IN(2)) { F.refresh(); p_vstats(F); SEAM(2); }
    if (IN(3)) { F.refresh(); p_spatial(F, A); SEAM(3); }
    if (IN(4)) { F.refresh();
        pg8::DenseOrder S; S.init(ws + WS_YG, ws + WS_GOUT, T, D, D, F.G, (int)blockIdx.x);
        pg8::EpiRes E{A.in[0], (float*)(ws + WS_XR), D, ALPHA};
        pg8::gemm_phase<pg8::EpiRes, pg8::DenseOrder, true, true>(ring, D, S, E);
        SEAM(4);
    }
    if (IN(5)) { F.refresh(); p_ln_router(F, A, (const float*)(ws + WS_XR), A.in[1], A.in[2], (float*)(ws + WS_XA), (bf16*)(ws + WS_XB), 0); SEAM(5); }
    if (IN(6)) { F.refresh();
        moe_tables(F, 0, 4);
        pg8::MoeOrder<true> S{(const LAS int*)(F.lds + LT_UNITS), *(const LAS int*)(F.lds + LT_NUNITS), (const char*)(ws + WS_XB), (const char*)(ws + WS_W1), W1_E, D, (const unsigned*)(ws + WS_LIST)};
        pg8::EpiMoe1 E{(bf16*)(ws + WS_HM)};
        pg8::gemm_phase<pg8::EpiMoe1, pg8::MoeOrder<true>, true, true>(ring, D, S, E);
        SEAM(6);
    }
    if (IN(7)) { F.refresh();
        moe_tables(F, 0, 8);
        pg8::MoeOrder<false> S{(const LAS int*)(F.lds + LT_UNITS), *(const LAS int*)(F.lds + LT_NUNITS), (const char*)(ws + WS_HM), (const char*)(ws + WS_W2), W2_E, EXD, nullptr};
        pg8::EpiMoe2 E{(bf16*)(ws + WS_RA), D};
        pg8::gemm_phase<pg8::EpiMoe2, pg8::MoeOrder<false>, true, true>(ring, EXD, S, E);
        SEAM(7);
    }
    if (IN(8)) { F.refresh(); p_combine_ln(F, (const float*)(ws + WS_XA), A.in[3], A.in[4], (float*)(ws + WS_XR), (bf16*)(ws + WS_XB), 0); SEAM(8); }
    if (IN(9)) { F.refresh();
        pg8::DenseOrder S; S.init(ws + WS_XB, ws + WS_HIN, T, 4 * D, D, F.G, (int)blockIdx.x);
        pg8::EpiHgrn E{(bf16*)(ws + WS_HQ), (bf16*)(ws + WS_HK), (bf16*)(ws + WS_HV), (bf16*)(ws + WS_HG), (float*)(ws + WS_HF), (const float*)(ws + WS_LB), D};
        pg8::gemm_phase<pg8::EpiHgrn, pg8::DenseOrder, true, true>(ring, D, S, E);
        SEAM(9);
    }
    if (IN(10)) { F.refresh(); p_recurrence(F, A); SEAM(10); }
    if (IN(11)) { F.refresh();
        pg8::DenseOrder S; S.init(ws + WS_HO, ws + WS_HOUT, T, D, D, F.G, (int)blockIdx.x);
        pg8::EpiRes E{(const float*)(ws + WS_XR), (float*)(ws + WS_XA), D, ALPHA};
        pg8::gemm_phase<pg8::EpiRes, pg8::DenseOrder, true, true>(ring, D, S, E);
        SEAM(11);
    }
    if (IN(12)) { F.refresh(); p_ln_router(F, A, (const float*)(ws + WS_XA), A.in[1] + D, A.in[2] + D, (float*)(ws + WS_XR), (bf16*)(ws + WS_XB), 1); SEAM(12); }
    if (IN(13)) { F.refresh();
        moe_tables(F, 1, 4);
        pg8::MoeOrder<true> S{(const LAS int*)(F.lds + LT_UNITS), *(const LAS int*)(F.lds + LT_NUNITS), (const char*)(ws + WS_XB), (const char*)(ws + WS_W1 + W1_L), W1_E, D, (const unsigned*)(ws + WS_LIST)};
        pg8::EpiMoe1 E{(bf16*)(ws + WS_HM)};
        pg8::gemm_phase<pg8::EpiMoe1, pg8::MoeOrder<true>, true, true>(ring, D, S, E);
        SEAM(13);
    }
    if (IN(14)) { F.refresh();
        moe_tables(F, 1, 8);
        pg8::MoeOrder<false> S{(const LAS int*)(F.lds + LT_UNITS), *(const LAS int*)(F.lds + LT_NUNITS), (const char*)(ws + WS_HM), (const char*)(ws + WS_W2 + W2_L), W2_E, EXD, nullptr};
        pg8::EpiMoe2 E{(bf16*)(ws + WS_RA), D};
        pg8::gemm_phase<pg8::EpiMoe2, pg8::MoeOrder<false>, true, true>(ring, EXD, S, E);
        SEAM(14);
    }
    if (IN(15)) { F.refresh(); p_combine_ln(F, (const float*)(ws + WS_XR), A.in[3] + D, A.in[4] + D, A.out, nullptr, 1); }
#undef IN
#undef SEAM
}

extern "C" void kernel_launch(void* const* d_in, const int* in_sizes, int n_in, void* d_out, int out_size, void* d_ws, size_t ws_size, hipStream_t stream) {
    static int grid = 0;
    if (grid == 0) {
        if (n_in != 23 || in_sizes[0] != T * D || out_size != T * D || ws_size < WS_END) { fprintf(stderr, "kernel_launch: unexpected shapes (n_in %d, in0 %d, out %d, ws %zu < %zu); nothing launched\n", n_in, n_in > 0 ? in_sizes[0] : -1, out_size, ws_size, (size_t)WS_END); grid = -1; return; }
        int dev = 0, cus = 0, per_cu = 0;
        if (hipGetDevice(&dev) != hipSuccess || hipDeviceGetAttribute(&cus, hipDeviceAttributeMultiprocessorCount, dev) != hipSuccess) { grid = -1; return; }
        if (hipFuncSetAttribute((const void*)mk_fwd, hipFuncAttributeMaxDynamicSharedMemorySize, LDS_BYTES) != hipSuccess) { fprintf(stderr, "kernel_launch: hipFuncSetAttribute failed\n"); grid = -1; return; }
        if (hipOccupancyMaxActiveBlocksPerMultiprocessor(&per_cu, (const void*)mk_fwd, NWAVES * 64, LDS_BYTES) != hipSuccess || per_cu < 1) fprintf(stderr, "kernel_launch: note: occupancy query reports %d\n", per_cu);
        (void)hipGetLastError();
        grid = cus;
    }
    if (grid < 0) return;
    if (hipMemsetAsync((char*)d_ws + WS_CTL, 0, CTL_ZERO_BYTES, stream) != hipSuccess) return;
    Args a{};
    for (int i = 0; i < 23; ++i) a.in[i] = (const float*)d_in[i];
    a.out = (float*)d_out; a.ws = (unsigned char*)d_ws;
    for (int li = 0; li < N_LAUNCHES; ++li) {
        if (N_LAUNCHES == 1) { a.ph_lo = 0; a.ph_hi = N_PHASES; } else { a.ph_lo = li; a.ph_hi = li + 1; }
        hipLaunchKernelGGL(mk_fwd, dim3(grid), dim3(NWAVES * 64), LDS_BYTES, stream, a);
        if (hipPeekAtLastError() != hipSuccess) { fprintf(stderr, "kernel_launch: launch %d failed\n", li); break; }
    }
}
```

```cpp
#include <hip/hip_runtime.h>
#include <cstdio>
#include <cstdint>

#ifndef MK_N_LAUNCHES
#define MK_N_LAUNCHES 1
#endif

namespace pg8 {
#define PG8_LAS __attribute__((address_space(3)))
typedef unsigned short bf16_t;
typedef short bf16x8 __attribute__((ext_vector_type(8)));
typedef float f32x4 __attribute__((ext_vector_type(4)));
typedef float f32x2 __attribute__((ext_vector_type(2)));
typedef unsigned u32x4 __attribute__((ext_vector_type(4)));
constexpr int BM = 256, BK = 64, HALF = 128, HTB = HALF * BK * 2  , STAGE_BYTES = 8 * HTB, NXCD = 8, WGM = 8;

__host__ __device__ __forceinline__ int lds_byte(int r, int c) { const int st = (r >> 4) * 2 + (c >> 5), rr = r & 15, cc = c & 31, ob = rr * 64 + cc * 2; return st * 1024 + (ob ^ (((ob >> 9) & 1) << 5)); }
__host__ __device__ __forceinline__ void stage_rc(int b, int& R, int& C) { const int st = b / 1024, sb = b % 1024, swz = sb ^ (((sb >> 9) & 1) << 5); R = (st >> 1) * 16 + swz / 64; C = (st & 1) * 32 + (swz % 64) / 2; }
__host__ __device__ __forceinline__ int perm32(int rho) { const int n = rho >> 4, i = rho & 15; return 8 * (i >> 2) + 4 * n + (i & 3); }

struct Unit { int pm, pn, e, rows, orow; };

struct DenseOrder {
    static constexpr bool GATHER = false;
    const char* A; const char* Bt; int K, nM, nN, nwg, G, c;
    __device__ void init(const void* A_, const void* Bt_, int M, int N, int K_, int G_, int c_) { A = (const char*)A_; Bt = (const char*)Bt_; K = K_; nM = M / BM; nN = N / BM; nwg = nM * nN; G = G_; c = c_; }
    __device__ bool next(int i, Unit& u) const {
        const long L = (long)i * G + c; if (L >= nwg) return false;
        int wgid = (int)L; { const int q = nwg / NXCD, r = nwg % NXCD, xcd = wgid % NXCD, off = wgid / NXCD; wgid = (xcd < r ? xcd * (q + 1) : r * (q + 1) + (xcd - r) * q) + off; }
        const int nig = WGM * nN, gid = wgid / nig, fm = gid * WGM, gsz = (nM - fm) < WGM ? (nM - fm) : WGM;
        u.pm = fm + ((wgid % nig) % gsz); u.pn = (wgid % nig) / gsz; u.e = 0; u.rows = BM; u.orow = u.pm * BM; return true;
    }
    __device__ __forceinline__ const char* a_ptr(const Unit& u) const { return A + (size_t)u.pm * BM * K * 2; }
    __device__ __forceinline__ const char* b_ptr(const Unit& u) const { return Bt + (size_t)u.pn * BM * K * 2; }
    __device__ __forceinline__ int tok(const Unit&, int) const { return 0; }
};
template <bool GATHER_> struct MoeOrder {
    static constexpr bool GATHER = GATHER_;
    const PG8_LAS int* tab; int n;
    const char* A; const char* Bt; size_t b_estride; int K; const unsigned* list;
    __device__ bool next(int i, Unit& u) const { if (i >= n) return false; const PG8_LAS int* t = tab + 5 * i; u.e = t[0]; u.pm = t[1]; u.pn = t[2]; u.rows = t[3]; u.orow = t[4]; return true; }
    __device__ __forceinline__ const char* a_ptr(const Unit& u) const { return GATHER ? A : A + (size_t)u.orow * K * 2; }
    __device__ __forceinline__ const char* b_ptr(const Unit& u) const { return Bt + (size_t)u.e * b_estride + (size_t)u.pn * BM * K * 2; }
    __device__ __forceinline__ int tok(const Unit& u, int row) const { if (u.e >= 64) return u.pm * BM + row; return row < u.rows ? (int)list[(size_t)u.e * 16384 + u.pm * BM + row] : 0; }
};

__device__ __forceinline__ unsigned cvt_pk_bf16(float lo, float hi) { unsigned r; asm volatile("v_cvt_pk_bf16_f32 %0, %1, %2" : "=v"(r) : "v"(lo), "v"(hi)); return r; }
__device__ __forceinline__ f32x2 gelu_pk(f32x2 v) {
    const f32x2 av = __builtin_elementwise_abs(v), d = av * 0.2316418882f + 1.0f;
    f32x2 t; t.x = __builtin_amdgcn_rcpf(d.x); t.y = __builtin_amdgcn_rcpf(d.y);
    f32x2 q = t * 0.5307027145f + (-0.7265760135f); q = q * t + 0.7107068705f; q = q * t + (-0.142248368f); q = q * t + 0.127414796f; q = q * t;
    const f32x2 s = (v * v) * (-0.72134752044f);
    f32x2 e; e.x = __builtin_amdgcn_exp2f(s.x); e.y = __builtin_amdgcn_exp2f(s.y);
    const f32x2 m = v * (q * e), r = v - m;
    f32x2 o; o.x = v.x < 0.f ? m.x : r.x; o.y = v.y < 0.f ? m.y : r.y; return o;
}
__device__ __forceinline__ float sigmoidf_(float x) { return __builtin_amdgcn_rcpf(1.0f + __expf(-x)); }

struct EpiGelu {
    static constexpr bool PERM = true;
    bf16_t* O; int ldc;
    __device__ __forceinline__ void operator()(const f32x4 (&acc)[2][2][4][2], const Unit& u, int wr, int wc, int fr, int fq) const {
        const int row0 = u.pm * BM + wr * 64 + fr, col0 = u.pn * BM + wc * 32 + 8 * fq;
#pragma unroll
        for (int ai = 0; ai < 2; ++ai)
#pragma unroll
            for (int m = 0; m < 4; ++m) { bf16_t* rowp = O + (size_t)(row0 + ai * HALF + m * 16) * ldc + col0;
#pragma unroll
                for (int bj = 0; bj < 2; ++bj) { const f32x4 v0 = acc[ai][bj][m][0], v1 = acc[ai][bj][m][1];
                    const f32x2 a = gelu_pk((f32x2){v0[0], v0[1]}), b = gelu_pk((f32x2){v0[2], v0[3]}), c = gelu_pk((f32x2){v1[0], v1[1]}), d = gelu_pk((f32x2){v1[2], v1[3]});
                    u32x4 w; w.x = cvt_pk_bf16(a.x, a.y); w.y = cvt_pk_bf16(b.x, b.y); w.z = cvt_pk_bf16(c.x, c.y); w.w = cvt_pk_bf16(d.x, d.y);
                    *(u32x4*)(rowp + bj * HALF) = w; } }
    }
};
struct EpiRes {
    static constexpr bool PERM = false;
    const float* res; float* out; int ldc; float alpha;
    __device__ __forceinline__ void operator()(const f32x4 (&acc)[2][2][4][2], const Unit& u, int wr, int wc, int fr, int fq) const {
        const int row0 = u.pm * BM + wr * 64 + fr, col0 = u.pn * BM + wc * 32 + 4 * fq;
#pragma unroll
        for (int ai = 0; ai < 2; ++ai)
#pragma unroll
            for (int m = 0; m < 4; ++m) { const size_t off = (size_t)(row0 + ai * HALF + m * 16) * ldc + col0;
#pragma unroll
                for (int bj = 0; bj < 2; ++bj)
#pragma unroll
                    for (int n = 0; n < 2; ++n) { const f32x4 r = *(const f32x4*)(res + off + bj * HALF + n * 16); *(f32x4*)(out + off + bj * HALF + n * 16) = r * alpha + acc[ai][bj][m][n]; }
                if (m & 1) asm volatile("" ::: "memory"); }
    }
};
struct EpiHgrn {
    static constexpr bool PERM = true;
    bf16_t* Q; bf16_t* Kk; bf16_t* V; bf16_t* G; float* F; const float* lb; int D;
    __device__ __forceinline__ void operator()(const f32x4 (&acc)[2][2][4][2], const Unit& u, int wr, int wc, int fr, int fq) const {
        const int kind = u.pn / (D / BM);
        const int row0 = u.pm * BM + wr * 64 + fr, col0 = (u.pn % (D / BM)) * BM + wc * 32 + 8 * fq;
        if (kind == 1) {
#pragma unroll
            for (int bj = 0; bj < 2; ++bj) {
                const f32x4 l0 = *(const f32x4*)(lb + col0 + bj * HALF), l1 = *(const f32x4*)(lb + col0 + bj * HALF + 4);
#pragma unroll
                for (int ai = 0; ai < 2; ++ai)
#pragma unroll
                    for (int m = 0; m < 4; ++m) { const size_t off = (size_t)(row0 + ai * HALF + m * 16) * D + col0 + bj * HALF;
                        f32x4 fo[2], ko[2];
#pragma unroll
                        for (int j = 0; j < 4; ++j) { const float s0 = sigmoidf_(acc[ai][bj][m][0][j]), s1 = sigmoidf_(acc[ai][bj][m][1][j]);
                            fo[0][j] = __logf(l0[j] + (1.0f - l0[j]) * s0); ko[0][j] = (1.0f - l0[j]) * (1.0f - s0); fo[1][j] = __logf(l1[j] + (1.0f - l1[j]) * s1); ko[1][j] = (1.0f - l1[j]) * (1.0f - s1); }
                        *(f32x4*)(F + off) = fo[0]; *(f32x4*)(F + off + 4) = fo[1];
                        u32x4 w; w.x = cvt_pk_bf16(ko[0][0], ko[0][1]); w.y = cvt_pk_bf16(ko[0][2], ko[0][3]); w.z = cvt_pk_bf16(ko[1][0], ko[1][1]); w.w = cvt_pk_bf16(ko[1][2], ko[1][3]);
                        *(u32x4*)(Kk + off) = w;
                        asm volatile("" ::: "memory"); } }
        } else {
            bf16_t* O = kind == 0 ? Q : (kind == 2 ? V : G);
            const bool act = kind != 2;
#pragma unroll
            for (int ai = 0; ai < 2; ++ai)
#pragma unroll
                for (int m = 0; m < 4; ++m) { const size_t off = (size_t)(row0 + ai * HALF + m * 16) * D + col0;
#pragma unroll
                    for (int bj = 0; bj < 2; ++bj) { f32x4 o[2];
#pragma unroll
                        for (int n = 0; n < 2; ++n)
#pragma unroll
                            for (int j = 0; j < 4; ++j) { const float x = acc[ai][bj][m][n][j]; o[n][j] = act ? x * sigmoidf_(x) : x; }
                        u32x4 w; w.x = cvt_pk_bf16(o[0][0], o[0][1]); w.y = cvt_pk_bf16(o[0][2], o[0][3]); w.z = cvt_pk_bf16(o[1][0], o[1][1]); w.w = cvt_pk_bf16(o[1][2], o[1][3]);
                        *(u32x4*)(O + off + bj * HALF) = w; } }
        }
    }
};
struct EpiMoe1 {
    static constexpr bool PERM = true;
    bf16_t* H;
    __device__ __forceinline__ void operator()(const f32x4 (&acc)[2][2][4][2], const Unit& u, int wr, int wc, int fr, int fq) const {
        const int col0 = u.pn * HALF + wc * 32 + 8 * fq;
#pragma unroll
        for (int ai = 0; ai < 2; ++ai)
#pragma unroll
            for (int m = 0; m < 4; ++m) { const int r = ai * HALF + wr * 64 + m * 16 + fr;
                f32x4 o[2];
#pragma unroll
                for (int n = 0; n < 2; ++n)
#pragma unroll
                    for (int j = 0; j < 4; ++j) { const float g = acc[ai][0][m][n][j]; o[n][j] = g * sigmoidf_(g) * acc[ai][1][m][n][j]; }
                u32x4 w; w.x = cvt_pk_bf16(o[0][0], o[0][1]); w.y = cvt_pk_bf16(o[0][2], o[0][3]); w.z = cvt_pk_bf16(o[1][0], o[1][1]); w.w = cvt_pk_bf16(o[1][2], o[1][3]);
                if (r < u.rows) *(u32x4*)(H + (size_t)(u.orow + r) * 512 + col0) = w; }
    }
};
struct EpiMoe2 {
    static constexpr bool PERM = true;
    bf16_t* Y; int ldc;
    __device__ __forceinline__ void operator()(const f32x4 (&acc)[2][2][4][2], const Unit& u, int wr, int wc, int fr, int fq) const {
        const int col0 = u.pn * BM + wc * 32 + 8 * fq;
#pragma unroll
        for (int ai = 0; ai < 2; ++ai)
#pragma unroll
            for (int m = 0; m < 4; ++m) { const int r = ai * HALF + wr * 64 + m * 16 + fr;
#pragma unroll
                for (int bj = 0; bj < 2; ++bj) { const f32x4 v0 = acc[ai][bj][m][0], v1 = acc[ai][bj][m][1];
                    u32x4 w; w.x = cvt_pk_bf16(v0[0], v0[1]); w.y = cvt_pk_bf16(v0[2], v0[3]); w.z = cvt_pk_bf16(v1[0], v1[1]); w.w = cvt_pk_bf16(v1[2], v1[3]);
                    if (r < u.rows) *(u32x4*)(Y + (size_t)(u.orow + r) * ldc + col0 + bj * HALF) = w; } }
    }
};

template <class Epi, class Sched, bool ALIGN_EPI, bool SP2>
__device__ __forceinline__ void gemm_phase(PG8_LAS unsigned char* lds, const int K, const Sched& S, const Epi& E) {
    constexpr bool GATHER = Sched::GATHER;
    const int tid = threadIdx.x, wid = __builtin_amdgcn_readfirstlane(tid >> 6), lane = tid & 63, wr = wid >> 2, wc = wid & 3, fr = lane & 15, fq = lane >> 4;
    const int nt = K / BK;
    unsigned voffA[2][2], voffN[2][2], voffB[2]; int sR[2], sC[2];
#pragma unroll
    for (int i = 0; i < 2; ++i) { int R, C; stage_rc(tid * 16 + i * 8192, R, C); sR[i] = R; sC[i] = C; const int Rb = Epi::PERM ? ((R & ~31) + perm32(R & 31)) : R;
        voffA[0][i] = (unsigned)(R * K + C) * 2u; voffA[1][i] = voffA[0][i]; voffN[0][i] = voffA[0][i]; voffN[1][i] = voffA[0][i]; voffB[i] = (unsigned)(Rb * K + C) * 2u; }
    const size_t kstep = (size_t)(BK * 2);
    const size_t hstep = (size_t)HALF * K * 2;
    const unsigned ldsw = (unsigned)wid * 1024u;
    const int aoff = lds_byte(wr * 64 + fr, fq * 8), boff = lds_byte(wc * 32 + fr, fq * 8);
#define PG8_SA(b, h) (((b) * 2 + (h)) * HTB)
#define PG8_SB(b, h) ((4 + (b) * 2 + (h)) * HTB)
#define PG8_GLDS(gptr, ldsoff) __builtin_amdgcn_global_load_lds((const unsigned*)(gptr), (PG8_LAS unsigned*)(lds + (ldsoff)), 16, 0, 0)
#define PG8_STAGE_B(b, h, kptr) do { _Pragma("unroll") for (int _i = 0; _i < 2; ++_i) PG8_GLDS((kptr) + (size_t)(h) * hstep + voffB[_i], PG8_SB(b, h) + ldsw + _i * 8192); } while (0)
#define PG8_STAGE_A(b, h, kptr) do { _Pragma("unroll") for (int _i = 0; _i < 2; ++_i) { if constexpr (GATHER) PG8_GLDS((kptr) + voffA[h][_i], PG8_SA(b, h) + ldsw + _i * 8192); else PG8_GLDS((kptr) + (size_t)(h) * hstep + voffA[0][_i], PG8_SA(b, h) + ldsw + _i * 8192); } } while (0)
#define PG8_LDA(dst, b, h) do { _Pragma("unroll") for (int m = 0; m < 4; ++m) _Pragma("unroll") for (int k = 0; k < 2; ++k) dst[m][k] = *(const PG8_LAS bf16x8*)(lds + PG8_SA(b, h) + aoff + m * 2048 + k * 1024); } while (0)
#define PG8_LDB(dst, b, h) do { _Pragma("unroll") for (int n = 0; n < 2; ++n) _Pragma("unroll") for (int k = 0; k < 2; ++k) dst[n][k] = *(const PG8_LAS bf16x8*)(lds + PG8_SB(b, h) + boff + n * 2048 + k * 1024); } while (0)
#define PG8_MMA(ai, bj, At, Bt) do { __builtin_amdgcn_s_setprio(1); _Pragma("unroll") for (int m = 0; m < 4; ++m) _Pragma("unroll") for (int n = 0; n < 2; ++n) _Pragma("unroll") for (int k = 0; k < 2; ++k) \
        acc[ai][bj][m][n] = __builtin_amdgcn_mfma_f32_16x16x32_bf16(Bt[n][k], At[m][k], acc[ai][bj][m][n], 0, 0, 0); __builtin_amdgcn_s_setprio(0); } while (0)
#define PG8_WAIT_V(n) asm volatile("s_waitcnt vmcnt(" #n ")" ::: "memory")
#define PG8_WAIT_L(n) asm volatile("s_waitcnt lgkmcnt(" #n ")" ::: "memory")
#define PG8_BAR __builtin_amdgcn_s_barrier()
#define PG8_SCHED __builtin_amdgcn_sched_barrier(0)
#define PG8_LOAD_OFFS(dst, unit) do { _Pragma("unroll") for (int _h = 0; _h < 2; ++_h) _Pragma("unroll") for (int _i = 0; _i < 2; ++_i) dst[_h][_i] = (unsigned)S.tok(unit, _h * HALF + sR[_i]) * (unsigned)(K * 2) + (unsigned)(sC[_i] * 2); \
        asm volatile("s_waitcnt vmcnt(0)" ::: "memory"); } while (0)
    Unit cur, nxt; int ui = 0;
    if (!S.next(0, cur)) return;
    f32x4 acc[2][2][4][2];
#pragma unroll
    for (int a = 0; a < 2; ++a)
#pragma unroll
        for (int b = 0; b < 2; ++b)
#pragma unroll
            for (int m = 0; m < 4; ++m)
#pragma unroll
                for (int n = 0; n < 2; ++n) acc[a][b][m][n] = (f32x4){0.f, 0.f, 0.f, 0.f};
    bf16x8 At[4][2], B0[2][2], B1[2][2];
    const char* cA = S.a_ptr(cur); const char* cB = S.b_ptr(cur);
    if constexpr (GATHER) { PG8_LOAD_OFFS(voffA, cur);
#pragma unroll
        for (int h = 0; h < 2; ++h)
#pragma unroll
            for (int i = 0; i < 2; ++i) voffN[h][i] = voffA[h][i]; }
    if constexpr (SP2) {
        PG8_STAGE_B(0, 0, cB); PG8_STAGE_B(0, 1, cB); PG8_STAGE_A(0, 0, cA); PG8_STAGE_A(0, 1, cA);
        if (wr == 1) PG8_BAR;
        PG8_WAIT_V(2); PG8_BAR;
        PG8_STAGE_B(1, 0, cB + kstep); PG8_STAGE_A(1, 0, cA + kstep); PG8_STAGE_B(1, 1, cB + kstep);
        PG8_WAIT_V(6); PG8_BAR;
    } else {
        PG8_STAGE_B(0, 0, cB); PG8_STAGE_A(0, 0, cA); PG8_STAGE_B(0, 1, cB); PG8_STAGE_A(0, 1, cA);
        if (wr == 1) PG8_BAR;
        PG8_WAIT_V(4); PG8_BAR;
        PG8_STAGE_B(1, 0, cB + kstep); PG8_STAGE_A(1, 0, cA + kstep); PG8_STAGE_B(1, 1, cB + kstep);
        PG8_WAIT_V(6); PG8_BAR;
    }
    for (;;) {
        const bool has_next = S.next(ui + 1, nxt);
        const char* nA = has_next ? S.a_ptr(nxt) : cA; const char* nB = has_next ? S.b_ptr(nxt) : cB;
        for (int t = 0; t < nt; t += 2) {
            const bool last = (t == nt - 2);
            const char* a1 = cA + (size_t)(t + 1) * kstep;
            const char* a2 = last ? nA : cA + (size_t)(t + 2) * kstep; const char* b2 = last ? nB : cB + (size_t)(t + 2) * kstep;
            const char* a3 = a2 + kstep; const char* b3 = b2 + kstep;
            if constexpr (GATHER) { if (last && has_next) { PG8_LOAD_OFFS(voffN, nxt); } }
            if constexpr (SP2) {
            PG8_LDB(B0, 0, 0); PG8_LDB(B1, 0, 1); PG8_SCHED; PG8_LDA(At, 0, 0); PG8_STAGE_A(1, 1, a1);
            if constexpr (GATHER) { if (last) {
#pragma unroll
                for (int h = 0; h < 2; ++h)
#pragma unroll
                    for (int i = 0; i < 2; ++i) voffA[h][i] = voffN[h][i]; } }
            PG8_WAIT_V(8); PG8_WAIT_L(0); PG8_BAR; PG8_MMA(0, 0, At, B0); PG8_MMA(0, 1, At, B1); PG8_BAR; PG8_SCHED;
            PG8_LDA(At, 0, 1); PG8_STAGE_B(0, 0, b2); PG8_STAGE_B(0, 1, b2); PG8_STAGE_A(0, 0, a2);
            PG8_WAIT_V(8); PG8_WAIT_L(0); PG8_BAR; PG8_MMA(1, 0, At, B0); PG8_MMA(1, 1, At, B1); PG8_BAR; PG8_SCHED;
            PG8_LDB(B0, 1, 0); PG8_LDB(B1, 1, 1); PG8_SCHED; PG8_LDA(At, 1, 0); PG8_STAGE_A(0, 1, a2);
            PG8_WAIT_V(8); PG8_WAIT_L(0); PG8_BAR; PG8_MMA(0, 0, At, B0); PG8_MMA(0, 1, At, B1); PG8_BAR; PG8_SCHED;
            PG8_LDA(At, 1, 1); PG8_STAGE_B(1, 0, b3); PG8_STAGE_B(1, 1, b3); PG8_STAGE_A(1, 0, a3);
            PG8_WAIT_V(8); PG8_WAIT_L(0); PG8_BAR; PG8_MMA(1, 0, At, B0); PG8_MMA(1, 1, At, B1); PG8_BAR; PG8_SCHED;
            } else {
            PG8_LDB(B0, 0, 0); PG8_SCHED; PG8_LDA(At, 0, 0); PG8_STAGE_A(1, 1, a1);
            if constexpr (GATHER) { if (last) {
#pragma unroll
                for (int h = 0; h < 2; ++h)
#pragma unroll
                    for (int i = 0; i < 2; ++i) voffA[h][i] = voffN[h][i]; } }
            PG8_WAIT_L(8); PG8_BAR; PG8_WAIT_L(0); PG8_MMA(0, 0, At, B0); PG8_BAR; PG8_SCHED;
            PG8_LDB(B1, 0, 1); PG8_STAGE_B(0, 0, b2);
            PG8_BAR; PG8_WAIT_L(0); PG8_MMA(0, 1, At, B1); PG8_BAR;
            PG8_LDA(At, 0, 1); PG8_STAGE_A(0, 0, a2);
            PG8_BAR; PG8_WAIT_L(0); PG8_MMA(1, 0, At, B0); PG8_BAR; PG8_SCHED;
            PG8_STAGE_B(0, 1, b2);
            PG8_WAIT_V(6); PG8_BAR; PG8_MMA(1, 1, At, B1); PG8_BAR;
            PG8_LDB(B0, 1, 0); PG8_SCHED; PG8_LDA(At, 1, 0); PG8_STAGE_A(0, 1, a2);
            PG8_WAIT_L(8); PG8_BAR; PG8_WAIT_L(0); PG8_MMA(0, 0, At, B0); PG8_BAR; PG8_SCHED;
            PG8_LDB(B1, 1, 1); PG8_STAGE_B(1, 0, b3);
            PG8_BAR; PG8_WAIT_L(0); PG8_MMA(0, 1, At, B1); PG8_BAR;
            PG8_LDA(At, 1, 1); PG8_STAGE_A(1, 0, a3);
            PG8_BAR; PG8_WAIT_L(0); PG8_MMA(1, 0, At, B0); PG8_BAR; PG8_SCHED;
            PG8_STAGE_B(1, 1, b3);
            PG8_WAIT_V(6); PG8_BAR; PG8_MMA(1, 1, At, B1); PG8_BAR;
            }
        }
        if constexpr (ALIGN_EPI) { if (wr == 0) PG8_BAR; }
        E(acc, cur, wr, wc, fr, fq);
        if (!has_next) break;
#pragma unroll
        for (int a = 0; a < 2; ++a)
#pragma unroll
            for (int b = 0; b < 2; ++b)
#pragma unroll
                for (int m = 0; m < 4; ++m)
#pragma unroll
                    for (int n = 0; n < 2; ++n) acc[a][b][m][n] = (f32x4){0.f, 0.f, 0.f, 0.f};
        cur = nxt; cA = nA; cB = nB; ++ui;
        if constexpr (ALIGN_EPI) { if (wr == 1) PG8_BAR; }
    }
    PG8_WAIT_V(0);
    if constexpr (!ALIGN_EPI) { if (wr == 0) PG8_BAR; }
    PG8_BAR;
#undef PG8_SA
#undef PG8_SB
#undef PG8_GLDS
#undef PG8_STAGE_A
#undef PG8_STAGE_B
#undef PG8_LDA
#undef PG8_LDB
#undef PG8_MMA
#undef PG8_WAIT_V
#undef PG8_WAIT_L
#undef PG8_BAR
#undef PG8_SCHED
#undef PG8_LOAD_OFFS
}
}

constexpr int NWAVES = 8;
constexpr int N_LAUNCHES = MK_N_LAUNCHES;
constexpr int N_PHASES = 17;
constexpr int T = 16384, D = 2048, SEQ = 4096, NB = 4;
constexpr int NE = 64, NEA = 65, TOPK = 8, EXD = 512;
constexpr int NH = 16, HD = 128;
constexpr float LN_EPS = 1e-5f;
constexpr float ALPHA = 1.4142135623730951f;
constexpr float ROUTED_SCALE = 2.5f;
constexpr int NROWS = T * TOPK + T;

constexpr size_t MiB = 1u << 20;
constexpr size_t WS_CTL = 0, CTL_ZERO_BYTES = 1 * MiB;
constexpr size_t WS_LB = 1 * MiB;
constexpr size_t WS_VST = WS_LB + 64 * 1024;
constexpr size_t WS_WSP = 2 * MiB;
constexpr size_t WS_WR = 3 * MiB;
constexpr size_t WS_AES = 4 * MiB;
constexpr size_t WS_AW = 5 * MiB;
constexpr size_t WS_LIST = 6 * MiB;
constexpr size_t WS_GIN = 16 * MiB;
constexpr size_t WS_GOUT = WS_GIN + 16 * MiB;
constexpr size_t WS_HIN = WS_GOUT + 8 * MiB;
constexpr size_t WS_HOUT = WS_HIN + 32 * MiB;
constexpr size_t WS_W1 = WS_HOUT + 8 * MiB;
constexpr size_t W1_E = (size_t)1024 * 2048 * 2, W1_L = NEA * W1_E;
constexpr size_t WS_W2 = WS_W1 + 2 * W1_L;
constexpr size_t W2_E = (size_t)2048 * 512 * 2, W2_L = NEA * W2_E;
constexpr size_t WS_XA = WS_W2 + 2 * W2_L;
constexpr size_t WS_XR = WS_XA + 128 * MiB;
constexpr size_t WS_XB = WS_XR + 128 * MiB;
constexpr size_t WS_HM = WS_XB + 64 * MiB;
constexpr size_t WS_RA = WS_HM + 145 * MiB;
constexpr size_t WS_END = WS_RA + 576 * MiB;
constexpr size_t WS_XINB = WS_RA;
constexpr size_t WS_Z = WS_RA + 64 * MiB;
constexpr size_t WS_YG = WS_RA + 192 * MiB;
constexpr size_t WS_HQ = WS_RA, WS_HK = WS_RA + 64 * MiB, WS_HV = WS_RA + 128 * MiB, WS_HG = WS_RA + 192 * MiB;
constexpr size_t WS_HF = WS_RA + 256 * MiB;
constexpr size_t WS_HO = WS_RA + 384 * MiB;
constexpr size_t WS_HQD = WS_RA + 448 * MiB;
constexpr size_t WS_HDT = WS_RA + 512 * MiB;
constexpr size_t WS_HUT = WS_XA;
constexpr size_t WS_HOI = WS_HM;
static_assert((size_t)(NROWS + 256) * 512 * 2 <= 145 * MiB && (size_t)NROWS * D * 2 <= 576 * MiB && WS_END <= 2040 * MiB, "d_ws map");
constexpr int CW_BAR = 4096;
constexpr int CW_CNT = 16384;
constexpr int CNT_STRIDE = 16;

constexpr int RING_OFF = 0, RING_BYTES = 131072;
constexpr int LDSCTL_OFF = RING_BYTES;
constexpr int MISC_OFF = LDSCTL_OFF;
constexpr int LT_RB = LDSCTL_OFF + 256;
constexpr int LT_CNT = LDSCTL_OFF + 576;
constexpr int LT_NUNITS = LDSCTL_OFF + 896;
constexpr int LT_UNITS = LDSCTL_OFF + 1024;
constexpr int LDS_BYTES = 147456;

#define GAS __attribute__((address_space(1)))
#define LAS __attribute__((address_space(3)))
typedef unsigned short bf16;
typedef unsigned v4u __attribute__((ext_vector_type(4)));
typedef unsigned v2u __attribute__((ext_vector_type(2)));
typedef float f32x4 __attribute__((ext_vector_type(4)));
typedef short bf16x8 __attribute__((ext_vector_type(8)));
#define LDS_WAIT() asm volatile("s_waitcnt lgkmcnt(0)" ::: "memory")
#define VM_WAIT() asm volatile("s_waitcnt vmcnt(0)" ::: "memory")
__device__ __forceinline__ unsigned f2bf(float f) { unsigned u = __builtin_bit_cast(unsigned, f); return (u + 0x7fffu + ((u >> 16) & 1u)) >> 16; }
__device__ __forceinline__ unsigned pk2(float lo, float hi) { return f2bf(lo) | (f2bf(hi) << 16); }
__device__ __forceinline__ float bflo(unsigned w) { return __builtin_bit_cast(float, w << 16); }
__device__ __forceinline__ float bfhi(unsigned w) { return __builtin_bit_cast(float, w & 0xffff0000u); }
__device__ __forceinline__ float bf2f(unsigned short h) { return __builtin_bit_cast(float, (unsigned)h << 16); }

#define XB_TMO      128
#define XB_XCNT(j)  (256  + 64 * (j))
#define XB_XSUB(j)  (1280 + 64 * (j))
#define XB_XGEN(j)  (2304 + 64 * (j))
#define XB_TOP      3328
#define XB_TOPGEN   3392
#define XCD_BAR_WORDS 3456
#define XB_SPIN_CAP (1u << 18)
__device__ __forceinline__ unsigned xb_ld(unsigned* p)              { return __hip_atomic_load(p, __ATOMIC_RELAXED, __HIP_MEMORY_SCOPE_AGENT); }
__device__ __forceinline__ unsigned xb_add(unsigned* p, unsigned v) { return __hip_atomic_fetch_add(p, v, __ATOMIC_RELAXED, __HIP_MEMORY_SCOPE_AGENT); }
__device__ __forceinline__ unsigned xb_xcc_id() { return (unsigned)__builtin_amdgcn_s_getreg((3 << 11) | 20) & 0xFu; }
#define XB_SPIN(cond, bar) do { unsigned _sp = 0; while (cond) { __builtin_amdgcn_s_sleep(1); \
    if ((++_sp & 255u) == 0u) { if (xb_ld(&(bar)[XB_TMO])) break; if (_sp > XB_SPIN_CAP) { atomicAdd(&(bar)[XB_TMO], 1u); break; } } } } while (0)
struct XcdBarrier { unsigned* bar; unsigned x; volatile LAS unsigned* st; };
__device__ __forceinline__ XcdBarrier xcd_barrier_post(unsigned* bar, volatile LAS unsigned* st) {
    XcdBarrier b; b.bar = bar; b.x = xb_xcc_id(); b.st = st;
    if (threadIdx.x == 0) (void)xb_add(&bar[XB_XCNT(b.x)], 1u);
    return b;
}
__device__ __forceinline__ void xcd_barrier_complete(unsigned* bar, unsigned x, unsigned& nloc, unsigned& nx) {
    const unsigned G = gridDim.x * gridDim.y * gridDim.z;
    unsigned sum, cnt, mine, sp = 0u;
    for (;;) {
        sum = 0u; cnt = 0u; mine = 0u;
#pragma unroll
        for (unsigned j = 0; j < 16; ++j) { const unsigned c = xb_ld(&bar[XB_XCNT(j)]); sum += c; cnt += (c > 0u) ? 1u : 0u; mine = (j == x) ? c : mine; }
        if (sum == G) break;
        __builtin_amdgcn_s_sleep(1);
        if ((++sp & 255u) == 0u) { if (xb_ld(&bar[XB_TMO])) break; if (sp > XB_SPIN_CAP) { atomicAdd(&bar[XB_TMO], 1u); break; } }
    }
    nloc = mine > 0u ? mine : 1u; nx = cnt > 0u ? cnt : 1u;
}
__device__ __forceinline__ void xcd_barrier(const XcdBarrier& b) {
    asm volatile("s_waitcnt vmcnt(0)" ::: "memory");
    __syncthreads();
    if (threadIdx.x == 0) {
        unsigned* bar = b.bar;
        __builtin_amdgcn_s_waitcnt(0);
        unsigned nloc = b.st[0], nx = b.st[1];
        if (nloc == 0u) { xcd_barrier_complete(bar, b.x, nloc, nx); b.st[0] = nloc; b.st[1] = nx; }
        const unsigned old = xb_add(&bar[XB_XSUB(b.x)], 1u);
        const unsigned gen = old / nloc;
        if (old + 1u == (gen + 1u) * nloc) {
            __builtin_amdgcn_fence(__ATOMIC_RELEASE, "agent");
            asm volatile("s_waitcnt vmcnt(0)" ::: "memory");
            const unsigned og = xb_add(&bar[XB_TOP], 1u);
            const unsigned tg = og / nx;
            if (og + 1u == (tg + 1u) * nx) xb_add(&bar[XB_TOPGEN], 1u);
            else XB_SPIN(xb_ld(&bar[XB_TOPGEN]) == tg, bar);
            __builtin_amdgcn_fence(__ATOMIC_ACQUIRE, "agent");
            xb_add(&bar[XB_XGEN(b.x)], 1u);
            asm volatile("s_waitcnt vmcnt(0)" ::: "memory");
        } else {
            XB_SPIN(xb_ld(&bar[XB_XGEN(b.x)]) == gen, bar);
            __builtin_amdgcn_fence(__ATOMIC_ACQUIRE, "agent");
            asm volatile("s_waitcnt vmcnt(0)" ::: "memory");
        }
    }
    __syncthreads();
}

struct Args { const float* in[23]; float* out; unsigned char* ws; int ph_lo, ph_hi; };
struct Frame {
    LAS unsigned char* lds;
    unsigned* ctl;
    unsigned char* ws;
    int tid, lane, wave, vcu, G;
    __device__ __forceinline__ void refresh() { int t = threadIdx.x; asm volatile("" : "+v"(t)); tid = t; lane = t & 63; wave = __builtin_amdgcn_readfirstlane(t >> 6); }
};
#define DPP_F(v, ctrl) __builtin_bit_cast(float, __builtin_amdgcn_update_dpp(0, __builtin_bit_cast(int, (v)), (ctrl), 0xf, 0xf, true))
__device__ __forceinline__ float wave_sum(float v) {
    v += DPP_F(v, 0xB1); v += DPP_F(v, 0x4E); v += DPP_F(v, 0x141); v += DPP_F(v, 0x140);
    const int iv = __builtin_bit_cast(int, v);
    return (__builtin_bit_cast(float, __builtin_amdgcn_readlane(iv, 0)) + __builtin_bit_cast(float, __builtin_amdgcn_readlane(iv, 16))) + (__builtin_bit_cast(float, __builtin_amdgcn_readlane(iv, 32)) + __builtin_bit_cast(float, __builtin_amdgcn_readlane(iv, 48)));
}
#define OPAQUE(x) asm volatile("" : "+v"(x))

__device__ __forceinline__ void p0_transpose_item(const float* W, int N, int K, bf16* WT, int k0, int n0, int dst_row0, LAS float* scr, int lane) {
#pragma unroll
    for (int i = 0; i < 8; ++i) { const int kk = 8 * i + (lane >> 3), n4 = (lane & 7) * 4; const f32x4 v = *(const f32x4*)(W + (size_t)(k0 + kk) * N + n0 + n4);
        LAS float* d = scr + kk * 33 + n4; d[0] = v.x; d[1] = v.y; d[2] = v.z; d[3] = v.w; }
    LDS_WAIT(); asm volatile("" ::: "memory");
    const int c = lane & 7;
#pragma unroll
    for (int j = 0; j < 4; ++j) { const int n = (lane >> 3) + 8 * j; const LAS float* s = scr + (8 * c) * 33 + n;
        v4u o; o.x = pk2(s[0 * 33], s[1 * 33]); o.y = pk2(s[2 * 33], s[3 * 33]); o.z = pk2(s[4 * 33], s[5 * 33]); o.w = pk2(s[6 * 33], s[7 * 33]);
        *(v4u*)(WT + (size_t)(dst_row0 + n) * K + k0 + 8 * c) = o; }
    LDS_WAIT(); asm volatile("" ::: "memory");
}
__device__ __forceinline__ void p0_prologue(Frame& F, const Args& A) {
    LAS float* scr = (LAS float*)(F.lds + RING_OFF + F.wave * 16384);
    const int gw = F.vcu * NWAVES + F.wave, NGW = F.G * NWAVES;
    constexpr int I0 = 32 * 128, I1 = 32 * 64, I2 = 32 * 256, I3 = 32 * 64, IM = 2 * NEA * 1536;
    constexpr int NITEMS = I0 + I1 + I2 + I3 + IM;
    for (int it = gw; it < NITEMS; it += NGW) {
        int r = it;
        if (r < I0) { p0_transpose_item(A.in[5], 4096, 2048, (bf16*)(F.ws + WS_GIN), 64 * (r / 128), 32 * (r % 128), 32 * (r % 128), scr, F.lane); continue; } r -= I0;
        if (r < I1) { p0_transpose_item(A.in[10], 2048, 2048, (bf16*)(F.ws + WS_GOUT), 64 * (r / 64), 32 * (r % 64), 32 * (r % 64), scr, F.lane); continue; } r -= I1;
        if (r < I2) { p0_transpose_item(A.in[11], 8192, 2048, (bf16*)(F.ws + WS_HIN), 64 * (r / 256), 32 * (r % 256), 32 * (r % 256), scr, F.lane); continue; } r -= I2;
        if (r < I3) { p0_transpose_item(A.in[13], 2048, 2048, (bf16*)(F.ws + WS_HOUT), 64 * (r / 64), 32 * (r % 64), 32 * (r % 64), scr, F.lane); continue; } r -= I3;
        const int le = r / 1536, sub = r % 1536, l = le / NEA, e = le % NEA, part = sub / 512, idx = sub % 512;
        if (part < 2) {
            const float* W = e < NE ? (part == 0 ? A.in[17] : A.in[18]) + (size_t)(l * NE + e) * 2048 * 512 : (part == 0 ? A.in[20] : A.in[21]) + (size_t)l * 2048 * 512;
            const int kb = idx / 16, nb = idx % 16, n0 = 32 * nb;
            p0_transpose_item(W, 512, 2048, (bf16*)(F.ws + WS_W1 + l * W1_L + e * W1_E), 64 * kb, n0, (n0 / 128) * 256 + part * 128 + (n0 % 128), scr, F.lane);
        } else {
            const float* W = e < NE ? A.in[19] + (size_t)(l * NE + e) * 512 * 2048 : A.in[22] + (size_t)l * 512 * 2048;
            const int kb = idx / 64, nb = idx % 64;
            p0_transpose_item(W, 2048, 512, (bf16*)(F.ws + WS_W2 + l * W2_L + e * W2_E), 64 * kb, 32 * nb, 32 * nb, scr, F.lane);
        }
    }
    const size_t gt = (size_t)F.vcu * (NWAVES * 64) + F.tid, NT = (size_t)F.G * NWAVES * 64;
    { const f32x4* x4 = (const f32x4*)A.in[0]; v4u* o = (v4u*)(F.ws + WS_XINB);
      for (size_t i = gt; i < (size_t)T * D / 8; i += NT) { const f32x4 a = x4[2 * i], b = x4[2 * i + 1]; v4u w; w.x = pk2(a.x, a.y); w.y = pk2(a.z, a.w); w.z = pk2(b.x, b.y); w.w = pk2(b.z, b.w); o[i] = w; } }
    { float* lb = (float*)(F.ws + WS_LB); const float* hb = A.in[14];
      for (size_t i = gt; i < (size_t)D; i += NT) { const float a = hb[i], b = hb[D + i]; lb[i] = 1.0f / (1.0f + __expf(a - b)); } }
    { bf16* wo = (bf16*)(F.ws + WS_WSP); const float* wi = A.in[8];
      for (size_t i = gt; i < (size_t)NH * 128 * 128; i += NT) { const int ii = (int)((i >> 7) & 127), jj = (int)(i & 127); const float v = ((ii >> 6) >= (jj >> 6)) ? wi[i] : 0.0f; wo[i] = (bf16)f2bf(v); } }
    { bf16* wr = (bf16*)(F.ws + WS_WR); const float* wi = A.in[15];
      for (size_t i = gt; i < (size_t)2 * NE * D; i += NT) { const int l = (int)(i / (NE * D)), n = (int)((i / D) % NE), k = (int)(i % D);
          const float w = wi[(size_t)l * D * NE + (size_t)k * NE + n]; const unsigned hi = f2bf(w); const float lo = w - bf2f((unsigned short)hi);
          wr[((size_t)(l * 2 + 0) * NE + n) * D + k] = (bf16)hi; wr[((size_t)(l * 2 + 1) * NE + n) * D + k] = (bf16)f2bf(lo); } }
}

__device__ __forceinline__ void p_vstats(Frame& F) {
    const int gw = F.vcu * NWAVES + F.wave, NGW = F.G * NWAVES;
    const bf16* Z = (const bf16*)(F.ws + WS_Z); float* vst = (float*)(F.ws + WS_VST);
    for (int t = gw; t < T; t += NGW) {
        const v4u* p = (const v4u*)(Z + (size_t)t * 4096 + 2048) + F.lane;
        float v[32]; float s = 0.f;
#pragma unroll
        for (int j = 0; j < 4; ++j) { const v4u w = p[64 * j];
            v[8 * j + 0] = bflo(w.x); v[8 * j + 1] = bfhi(w.x); v[8 * j + 2] = bflo(w.y); v[8 * j + 3] = bfhi(w.y); v[8 * j + 4] = bflo(w.z); v[8 * j + 5] = bfhi(w.z); v[8 * j + 6] = bflo(w.w); v[8 * j + 7] = bfhi(w.w); }
#pragma unroll
        for (int i = 0; i < 32; ++i) s += v[i];
        const float mean = wave_sum(s) * (1.0f / 2048.0f); float q = 0.f;
#pragma unroll
        for (int i = 0; i < 32; ++i) { const float d = v[i] - mean; q += d * d; }
        const float rstd = 1.0f / sqrtf(wave_sum(q) * (1.0f / 2048.0f) + LN_EPS);
        if (F.lane == 0) { vst[2 * t] = mean; vst[2 * t + 1] = rstd; }
    }
}

__device__ __forceinline__ void p_spatial(Frame& F, const Args& A) {
    constexpr int PITCH = 272;
    const bf16* Z = (const bf16*)(F.ws + WS_Z); const float* vst = (const float*)(F.ws + WS_VST); const bf16* WSP = (const bf16*)(F.ws + WS_WSP); bf16* YG = (bf16*)(F.ws + WS_YG);
    const float* vg = A.in[6]; const float* vb = A.in[7]; const float* bsp = A.in[9];
    LAS unsigned char* img = F.lds + RING_OFF;
    const int r = F.lane & 15, q = F.lane >> 4, w = F.wave;
    for (int unit = F.vcu; unit < (T / 128) * NH; unit += F.G) {
        const int n = unit / NH, h = unit % NH, t0 = n * 128;
        __syncthreads();
#pragma unroll
        for (int it = 0; it < 4; ++it) { const int idx = F.tid + 512 * it, j = idx & 127, c8 = idx >> 7;
            const v4u raw = *(const v4u*)(Z + (size_t)(t0 + j) * 4096 + 2048 + h * 128 + c8 * 8);
            const float mean = vst[2 * (t0 + j)], rstd = vst[2 * (t0 + j) + 1];
            const f32x4 g0 = *(const f32x4*)(vg + h * 128 + c8 * 8), g1 = *(const f32x4*)(vg + h * 128 + c8 * 8 + 4), b0 = *(const f32x4*)(vb + h * 128 + c8 * 8), b1 = *(const f32x4*)(vb + h * 128 + c8 * 8 + 4);
            float x[8] = {bflo(raw.x), bfhi(raw.x), bflo(raw.y), bfhi(raw.y), bflo(raw.z), bfhi(raw.z), bflo(raw.w), bfhi(raw.w)};
            const float gg[8] = {g0.x, g0.y, g0.z, g0.w, g1.x, g1.y, g1.z, g1.w}, bb[8] = {b0.x, b0.y, b0.z, b0.w, b1.x, b1.y, b1.z, b1.w};
#pragma unroll
            for (int i = 0; i < 8; ++i) { const float y = (x[i] - mean) * rstd * gg[i] + bb[i]; *(LAS unsigned short*)(img + (c8 * 8 + i) * PITCH + j * 2) = (unsigned short)f2bf(y); } }
        __syncthreads();
        f32x4 acc[8];
#pragma unroll
        for (int ct = 0; ct < 8; ++ct) acc[ct] = (f32x4){0.f, 0.f, 0.f, 0.f};
        bf16x8 bw[4];
#pragma unroll
        for (int ks = 0; ks < 4; ++ks) bw[ks] = *(const bf16x8*)(WSP + ((size_t)h * 128 + 16 * w + r) * 128 + 32 * ks + 8 * q);
#pragma unroll
        for (int ct = 0; ct < 8; ++ct)
#pragma unroll
            for (int ks = 0; ks < 4; ++ks) { const bf16x8 a = *(const LAS bf16x8*)(img + (16 * ct + r) * PITCH + (32 * ks + 8 * q) * 2);
                acc[ct] = __builtin_amdgcn_mfma_f32_16x16x32_bf16(a, bw[ks], acc[ct], 0, 0, 0); }
        const int tok = t0 + 16 * w + r; const float bias = bsp[h * 128 + 16 * w + r];
#pragma unroll
        for (int ct = 0; ct < 8; ++ct) { const int col = h * 128 + 16 * ct + 4 * q;
            const v2u uu = *(const v2u*)(Z + (size_t)tok * 4096 + col);
            v2u o; o.x = pk2((acc[ct][0] + bias) * bflo(uu.x), (acc[ct][1] + bias) * bfhi(uu.x)); o.y = pk2((acc[ct][2] + bias) * bflo(uu.y), (acc[ct][3] + bias) * bfhi(uu.y));
            *(v2u*)(YG + (size_t)tok * D + col) = o; }
    }
    __syncthreads();
}

__device__ __forceinline__ void p_ln_router(Frame& F, const Args& A, const float* rin, const float* lg, const float* lbias, float* xf, bf16* xb, int layer) {
    const int gw = F.vcu * NWAVES + F.wave, NGW = F.G * NWAVES;
    const bf16* WRh = (const bf16*)(F.ws + WS_WR) + (size_t)(layer * 2 + 0) * NE * D; const bf16* WRl = (const bf16*)(F.ws + WS_WR) + (size_t)(layer * 2 + 1) * NE * D;
    const float* ebias = A.in[16] + layer * NE;
    unsigned* cnt = F.ctl + CW_CNT + layer * NE * CNT_STRIDE;
    unsigned* list = (unsigned*)(F.ws + WS_LIST); unsigned* aes = (unsigned*)(F.ws + WS_AES); float* aw = (float*)(F.ws + WS_AW);
    LAS float* Ls = (LAS float*)(F.lds + RING_OFF + F.wave * 8448); LAS float* Lc = Ls + 16 * 65;
    const int r = F.lane & 15, q = F.lane >> 4;
    for (int wt = gw; wt < T / 16; wt += NGW) {
        const int row = wt * 16 + r;
        const float* rp = rin + (size_t)row * D + 8 * q;
        float s = 0.f, ss = 0.f;
#pragma unroll 8
        for (int j = 0; j < 64; ++j) { const f32x4 a = *(const f32x4*)(rp + 32 * j), b = *(const f32x4*)(rp + 32 * j + 4);
            s += (a.x + a.y) + (a.z + a.w) + (b.x + b.y) + (b.z + b.w); ss += (a.x * a.x + a.y * a.y) + (a.z * a.z + a.w * a.w) + (b.x * b.x + b.y * b.y) + (b.z * b.z + b.w * b.w); }
        s += __shfl_xor(s, 16); s += __shfl_xor(s, 32); ss += __shfl_xor(ss, 16); ss += __shfl_xor(ss, 32);
        const float mean = s * (1.0f / D); const float var = fmaxf(ss * (1.0f / D) - mean * mean, 0.f); const float rstd = 1.0f / sqrtf(var + LN_EPS);
        f32x4 acc[4];
#pragma unroll
        for (int nt = 0; nt < 4; ++nt) acc[nt] = (f32x4){0.f, 0.f, 0.f, 0.f};
#pragma unroll 2
        for (int j = 0; j < 64; ++j) { const int c0 = 32 * j + 8 * q;
            const f32x4 a = *(const f32x4*)(rp + 32 * j), b = *(const f32x4*)(rp + 32 * j + 4);
            const f32x4 g0 = *(const f32x4*)(lg + c0), g1 = *(const f32x4*)(lg + c0 + 4), b0 = *(const f32x4*)(lbias + c0), b1 = *(const f32x4*)(lbias + c0 + 4);
            const f32x4 y0 = (a - mean) * rstd * g0 + b0, y1 = (b - mean) * rstd * g1 + b1;
            *(f32x4*)(xf + (size_t)row * D + c0) = y0; *(f32x4*)(xf + (size_t)row * D + c0 + 4) = y1;
            unsigned hi[4], lo[4];
            hi[0] = pk2(y0.x, y0.y); hi[1] = pk2(y0.z, y0.w); hi[2] = pk2(y1.x, y1.y); hi[3] = pk2(y1.z, y1.w);
            lo[0] = pk2(y0.x - bflo(hi[0]), y0.y - bfhi(hi[0])); lo[1] = pk2(y0.z - bflo(hi[1]), y0.w - bfhi(hi[1])); lo[2] = pk2(y1.x - bflo(hi[2]), y1.y - bfhi(hi[2])); lo[3] = pk2(y1.z - bflo(hi[3]), y1.w - bfhi(hi[3]));
            v4u hv; hv.x = hi[0]; hv.y = hi[1]; hv.z = hi[2]; hv.w = hi[3]; v4u lv; lv.x = lo[0]; lv.y = lo[1]; lv.z = lo[2]; lv.w = lo[3];
            *(v4u*)(xb + (size_t)row * D + c0) = hv;
            const bf16x8 ah = __builtin_bit_cast(bf16x8, hv), al = __builtin_bit_cast(bf16x8, lv);
#pragma unroll
            for (int nt = 0; nt < 4; ++nt) { const bf16x8 bh = *(const bf16x8*)(WRh + (size_t)(16 * nt + r) * D + c0), bl = *(const bf16x8*)(WRl + (size_t)(16 * nt + r) * D + c0);
                acc[nt] = __builtin_amdgcn_mfma_f32_16x16x32_bf16(ah, bh, acc[nt], 0, 0, 0);
                acc[nt] = __builtin_amdgcn_mfma_f32_16x16x32_bf16(al, bh, acc[nt], 0, 0, 0);
                acc[nt] = __builtin_amdgcn_mfma_f32_16x16x32_bf16(ah, bl, acc[nt], 0, 0, 0); } }
#pragma unroll
        for (int nt = 0; nt < 4; ++nt)
#pragma unroll
            for (int i = 0; i < 4; ++i) Ls[(4 * q + i) * 65 + 16 * nt + r] = acc[nt][i];
        LDS_WAIT(); asm volatile("" ::: "memory");
        if (F.lane < 16) {
            const int tk = F.lane, token = wt * 16 + tk;
            LAS float* ps = Ls + tk * 65; LAS float* pc = Lc + tk * 65;
            float gs[8];
#pragma unroll
            for (int g = 0; g < 8; ++g) { float m1 = -INFINITY, m2 = -INFINITY;
#pragma unroll
                for (int i = 0; i < 8; ++i) { const int e = 8 * g + i; const float sg = 1.0f / (1.0f + __expf(-ps[e])); const float c = sg + ebias[e]; ps[e] = sg; pc[e] = c;
                    if (c > m1) { m2 = m1; m1 = c; } else if (c > m2) m2 = c; }
                gs[g] = m1 + m2; }
            unsigned allowed = 0u;
#pragma unroll
            for (int k = 0; k < 4; ++k) { float best = -INFINITY; int bi = 0;
#pragma unroll
                for (int g = 0; g < 8; ++g) { const bool ok = !((allowed >> g) & 1u) && (gs[g] > best); best = ok ? gs[g] : best; bi = ok ? g : bi; }
                allowed |= 1u << bi; }
            int sel[8]; float sw[8]; float ssum = 0.f;
#pragma unroll
            for (int k = 0; k < 8; ++k) { float best = -INFINITY; int be = 0;
                for (int e = 0; e < 64; ++e) { const float c = pc[e]; const bool ok = ((allowed >> (e >> 3)) & 1u) && (c > best); best = ok ? c : best; be = ok ? e : be; }
                sel[k] = be; pc[be] = -INFINITY; sw[k] = ps[be]; ssum += sw[k]; }
            const float inv = ROUTED_SCALE / ssum;
#pragma unroll
            for (int k = 0; k < 8; ++k) { const int e = sel[k];
                const unsigned slot = __hip_atomic_fetch_add(cnt + e * CNT_STRIDE, 1u, __ATOMIC_RELAXED, __HIP_MEMORY_SCOPE_AGENT);
                list[(size_t)e * 16384 + slot] = (unsigned)token; aes[(size_t)token * 8 + k] = ((unsigned)e << 16) | slot; aw[(size_t)token * 8 + k] = sw[k] * inv; }
        }
        LDS_WAIT(); asm volatile("" ::: "memory");
    }
}

__device__ __forceinline__ void moe_tables(Frame& F, int layer, int NPN) {
    LAS int* lc = (LAS int*)(F.lds + LT_CNT); LAS int* rb = (LAS int*)(F.lds + LT_RB); LAS int* tab = (LAS int*)(F.lds + LT_UNITS); LAS int* nun = (LAS int*)(F.lds + LT_NUNITS);
    const unsigned* cnt = F.ctl + CW_CNT + layer * NE * CNT_STRIDE;
    __syncthreads();
    if (F.tid < NEA) lc[F.tid] = F.tid < NE ? (int)__hip_atomic_load(cnt + F.tid * CNT_STRIDE, __ATOMIC_RELAXED, __HIP_MEMORY_SCOPE_AGENT) : T;
    __syncthreads();
    if (F.tid == 0) {
        int run = 0, tiles = 0;
        for (int e = 0; e < NEA; ++e) { const int c = lc[e]; rb[e] = run; run += c; tiles += (c + 255) >> 8; }
        rb[NEA] = run;
        int n = 0;
        if (NPN > 0) {
            const int total = tiles * NPN, qq = total / 8, rr = total % 8;
            for (int i = 0; i < 64; ++i) {
                const long L = (long)i * F.G + (int)blockIdx.x; if (L >= total) break;
                const int xcd = (int)(L % 8), off = (int)(L / 8);
                const int up = (xcd < rr ? xcd * (qq + 1) : rr * (qq + 1) + (xcd - rr) * qq) + off;
                const int rt = up / NPN, pn = up % NPN;
                int e = 0, a = 0;
                for (; e < NEA - 1; ++e) { const int te = (lc[e] + 255) >> 8; if (rt < a + te) break; a += te; }
                const int mt = rt - a, c = lc[e];
                tab[5 * n + 0] = e; tab[5 * n + 1] = mt; tab[5 * n + 2] = pn; tab[5 * n + 3] = (c - mt * 256) < 256 ? (c - mt * 256) : 256; tab[5 * n + 4] = rb[e] + mt * 256; ++n;
            }
        }
        nun[0] = n;
    }
    __syncthreads();
}

__device__ __forceinline__ void p_combine_ln(Frame& F, const float* xres, const float* lg, const float* lbias, float* of, bf16* ob, int layer) {
    moe_tables(F, layer, 0);
    const LAS int* rb = (const LAS int*)(F.lds + LT_RB);
    const int gw = F.vcu * NWAVES + F.wave, NGW = F.G * NWAVES;
    const bf16* Y = (const bf16*)(F.ws + WS_RA); const unsigned* aes = (const unsigned*)(F.ws + WS_AES); const float* aw = (const float*)(F.ws + WS_AW);
    for (int t = gw; t < T; t += NGW) {
        int ln = F.lane; OPAQUE(ln);
        unsigned es = 0u; float wv = 0.f;
        if (F.lane < 8) { es = aes[(size_t)t * 8 + F.lane]; wv = aw[(size_t)t * 8 + F.lane]; }
        int rowk[9]; float wk[9];
#pragma unroll
        for (int k = 0; k < 8; ++k) { const unsigned x = (unsigned)__shfl((int)es, k); wk[k] = __shfl(wv, k); rowk[k] = rb[x >> 16] + (int)(x & 0xffffu); }
        rowk[8] = T * TOPK + t; wk[8] = 1.0f;
        float v[32];
#pragma unroll
        for (int jj = 0; jj < 4; ++jj) { const int c0 = 512 * jj + 8 * ln;
            const f32x4 a = *(const f32x4*)(xres + (size_t)t * D + c0), b = *(const f32x4*)(xres + (size_t)t * D + c0 + 4);
            v[8 * jj + 0] = ALPHA * a.x; v[8 * jj + 1] = ALPHA * a.y; v[8 * jj + 2] = ALPHA * a.z; v[8 * jj + 3] = ALPHA * a.w; v[8 * jj + 4] = ALPHA * b.x; v[8 * jj + 5] = ALPHA * b.y; v[8 * jj + 6] = ALPHA * b.z; v[8 * jj + 7] = ALPHA * b.w; }
#pragma unroll
        for (int k = 0; k < 9; ++k) { const bf16* yr = Y + (size_t)rowk[k] * D + 8 * ln; const float w = wk[k];
#pragma unroll
            for (int jj = 0; jj < 4; ++jj) { const v4u p = *(const v4u*)(yr + 512 * jj);
                v[8 * jj + 0] += w * bflo(p.x); v[8 * jj + 1] += w * bfhi(p.x); v[8 * jj + 2] += w * bflo(p.y); v[8 * jj + 3] += w * bfhi(p.y); v[8 * jj + 4] += w * bflo(p.z); v[8 * jj + 5] += w * bfhi(p.z); v[8 * jj + 6] += w * bflo(p.w); v[8 * jj + 7] += w * bfhi(p.w); }
            if ((k % 3) == 2) asm volatile("" ::: "memory"); }
        float s = 0.f;
#pragma unroll
        for (int i = 0; i < 32; ++i) s += v[i];
        const float mean = wave_sum(s) * (1.0f / D); float qv = 0.f;
#pragma unroll
        for (int i = 0; i < 32; ++i) { const float d = v[i] - mean; qv += d * d; }
        const float rstd = 1.0f / sqrtf(wave_sum(qv) * (1.0f / D) + LN_EPS);
#pragma unroll
        for (int jj = 0; jj < 4; ++jj) { const int c0 = 512 * jj + 8 * ln;
            const f32x4 g0 = *(const f32x4*)(lg + c0), g1 = *(const f32x4*)(lg + c0 + 4), b0 = *(const f32x4*)(lbias + c0), b1 = *(const f32x4*)(lbias + c0 + 4);
            f32x4 y0, y1;
            y0.x = (v[8 * jj + 0] - mean) * rstd * g0.x + b0.x; y0.y = (v[8 * jj + 1] - mean) * rstd * g0.y + b0.y; y0.z = (v[8 * jj + 2] - mean) * rstd * g0.z + b0.z; y0.w = (v[8 * jj + 3] - mean) * rstd * g0.w + b0.w;
            y1.x = (v[8 * jj + 4] - mean) * rstd * g1.x + b1.x; y1.y = (v[8 * jj + 5] - mean) * rstd * g1.y + b1.y; y1.z = (v[8 * jj + 6] - mean) * rstd * g1.z + b1.z; y1.w = (v[8 * jj + 7] - mean) * rstd * g1.w + b1.w;
            *(f32x4*)(of + (size_t)t * D + c0) = y0; *(f32x4*)(of + (size_t)t * D + c0 + 4) = y1;
            if (ob) { v4u w; w.x = pk2(y0.x, y0.y); w.y = pk2(y0.z, y0.w); w.z = pk2(y1.x, y1.y); w.w = pk2(y1.z, y1.w); *(v4u*)(ob + (size_t)t * D + c0) = w; } }
    }
}

__device__ __forceinline__ int kslot(int k) { const int kk = k & 31; return (k & ~31) + 8 * ((kk & 15) >> 2) + 4 * (kk >> 4) + (kk & 3); }
__device__ __forceinline__ bf16x8 pack8(const f32x4& a, const f32x4& b) { v4u w; w.x = pk2(a[0], a[1]); w.y = pk2(a[2], a[3]); w.z = pk2(b[0], b[1]); w.w = pk2(b[2], b[3]); return __builtin_bit_cast(bf16x8, w); }
__device__ __forceinline__ void p_hgrn_intra(Frame& F) {
    const bf16* Q = (const bf16*)(F.ws + WS_HQ); const bf16* Kk = (const bf16*)(F.ws + WS_HK); const bf16* V = (const bf16*)(F.ws + WS_HV); const float* LF = (const float*)(F.ws + WS_HF);
    bf16* QD = (bf16*)(F.ws + WS_HQD); bf16* UT = (bf16*)(F.ws + WS_HUT); float* OI = (float*)(F.ws + WS_HOI); float* DT = (float*)(F.ws + WS_HDT);
    LAS unsigned char* L = F.lds + RING_OFF;
    constexpr int O_KDT = 0, O_VT = 18432, O_KH = 36864, O_QIJ = 54272, O_QST = 97792, O_GT = 114176, PC = 144, PT = 272;
    const int k = F.tid & 127, tq = __builtin_amdgcn_readfirstlane(F.tid >> 7), r = F.lane & 15, q = F.lane >> 4, w = F.wave;
    const int ks_ = kslot(k);
    for (int u = F.vcu; u < NB * NH * 64; u += F.G) {
        const int bh = u >> 6, c = u & 63, b = bh >> 4, h = bh & 15, t0 = b * SEQ + c * 64;
        const size_t base = (size_t)(t0 + 16 * tq) * D + h * HD + k;
        float Bl[16], qv[16], kv[16]; unsigned vv[8]; float run = 0.f;
#pragma unroll
        for (int i = 0; i < 16; ++i) { run += LF[base + (size_t)i * D]; Bl[i] = run; }
#pragma unroll
        for (int i = 0; i < 16; ++i) { qv[i] = bf2f(Q[base + (size_t)i * D]); kv[i] = bf2f(Kk[base + (size_t)i * D]); }
#pragma unroll
        for (int i = 0; i < 8; ++i) vv[i] = (unsigned)V[base + (size_t)(2 * i) * D] | ((unsigned)V[base + (size_t)(2 * i + 1) * D] << 16);
        __syncthreads();
        ((LAS float*)(L + O_GT))[tq * 128 + k] = run;
        __syncthreads();
        const float g0 = ((LAS float*)(L + O_GT))[k], g1 = ((LAS float*)(L + O_GT))[128 + k], g2 = ((LAS float*)(L + O_GT))[256 + k], g3 = ((LAS float*)(L + O_GT))[384 + k];
        const float Rq = (tq > 0 ? g0 : 0.f) + (tq > 1 ? g1 : 0.f) + (tq > 2 ? g2 : 0.f), Btot = (g0 + g1) + (g2 + g3);
        { unsigned kd[8];
#pragma unroll
          for (int i = 0; i < 8; ++i) kd[i] = pk2(kv[2 * i] * __expf(Btot - Rq - Bl[2 * i]), kv[2 * i + 1] * __expf(Btot - Rq - Bl[2 * i + 1]));
          LAS v4u* pk_ = (LAS v4u*)(L + O_KDT + k * PC + 32 * tq); v4u a; a.x = kd[0]; a.y = kd[1]; a.z = kd[2]; a.w = kd[3]; pk_[0] = a; a.x = kd[4]; a.y = kd[5]; a.z = kd[6]; a.w = kd[7]; pk_[1] = a;
          LAS v4u* pv_ = (LAS v4u*)(L + O_VT + k * PC + 32 * tq); a.x = vv[0]; a.y = vv[1]; a.z = vv[2]; a.w = vv[3]; pv_[0] = a; a.x = vv[4]; a.y = vv[5]; a.z = vv[6]; a.w = vv[7]; pv_[1] = a; }
        { const float eR = __expf(Rq);
          const float f0 = __expf(Rq), f1 = __expf(Rq - g0), f2 = __expf(Rq - g0 - g1);
#pragma unroll
          for (int i = 0; i < 16; ++i) { const float eb = __expf(Bl[i]), qt = qv[i] * eb, kh = kv[i] * __expf(fminf(-Bl[i], 80.f));
              *(LAS unsigned short*)(L + O_KH + (16 * tq + i) * PT + k * 2) = (unsigned short)f2bf(kh);
              *(LAS unsigned short*)(L + O_QST + (16 * tq + i) * 256 + ks_ * 2) = (unsigned short)f2bf(qt * eR);
              const int blk0 = tq * (tq + 1) / 2;
              *(LAS unsigned short*)(L + O_QIJ + (blk0 + tq) * (16 * PT) + i * PT + k * 2) = (unsigned short)f2bf(qt);
              if (tq > 0) *(LAS unsigned short*)(L + O_QIJ + (blk0 + 0) * (16 * PT) + i * PT + k * 2) = (unsigned short)f2bf(qt * f0);
              if (tq > 1) *(LAS unsigned short*)(L + O_QIJ + (blk0 + 1) * (16 * PT) + i * PT + k * 2) = (unsigned short)f2bf(qt * f1);
              if (tq > 2) *(LAS unsigned short*)(L + O_QIJ + (blk0 + 2) * (16 * PT) + i * PT + k * 2) = (unsigned short)f2bf(qt * f2); }
          if (tq == 0) DT[(size_t)u * 128 + ks_] = __expf(Btot); }
        __syncthreads();
        { const LAS v4u* src = (const LAS v4u*)(L + O_QST) + 2 * F.tid; v4u* dst = (v4u*)(QD + (size_t)u * 64 * 128) + 2 * F.tid; const v4u a = src[0], bq = src[1]; dst[0] = a; dst[1] = bq; }
        { f32x4 aU[8];
#pragma unroll
          for (int a = 0; a < 8; ++a) aU[a] = (f32x4){0.f, 0.f, 0.f, 0.f};
#pragma unroll
          for (int ts = 0; ts < 2; ++ts) { const bf16x8 bv = *(const LAS bf16x8*)(L + O_VT + (16 * w + r) * PC + (32 * ts + 8 * q) * 2);
#pragma unroll
              for (int a = 0; a < 8; ++a) { const bf16x8 av = *(const LAS bf16x8*)(L + O_KDT + (16 * a + r) * PC + (32 * ts + 8 * q) * 2); aU[a] = __builtin_amdgcn_mfma_f32_16x16x32_bf16(av, bv, aU[a], 0, 0, 0); } }
#pragma unroll
          for (int ks = 0; ks < 4; ++ks) *(bf16x8*)(UT + ((size_t)u * 128 + 16 * w + r) * 128 + 32 * ks + 8 * q) = pack8(aU[2 * ks], aU[2 * ks + 1]); }
#pragma unroll
        for (int i = 0; i < 4; ++i) {
            f32x4 pT[4];
#pragma unroll
            for (int j = 0; j < 4; ++j) { pT[j] = (f32x4){0.f, 0.f, 0.f, 0.f};
                if (j <= i) {
#pragma unroll
                    for (int ks = 0; ks < 4; ++ks) { const bf16x8 av = *(const LAS bf16x8*)(L + O_KH + (16 * j + r) * PT + (32 * ks + 8 * q) * 2);
                        const bf16x8 bv = *(const LAS bf16x8*)(L + O_QIJ + (i * (i + 1) / 2 + j) * (16 * PT) + r * PT + (32 * ks + 8 * q) * 2);
                        pT[j] = __builtin_amdgcn_mfma_f32_16x16x32_bf16(av, bv, pT[j], 0, 0, 0); }
                    if (j == i) {
#pragma unroll
                        for (int e = 0; e < 4; ++e) pT[j][e] = (4 * q + e <= r) ? pT[j][e] : 0.f; } } }
            f32x4 o = (f32x4){0.f, 0.f, 0.f, 0.f};
#pragma unroll
            for (int pr = 0; pr < 2; ++pr) if (2 * pr <= i) {
                const bf16x8 av = pack8(pT[2 * pr], pT[2 * pr + 1]);
                const v2u blo = *(const LAS v2u*)(L + O_VT + (16 * w + r) * PC + (32 * pr + 4 * q) * 2), bhi = *(const LAS v2u*)(L + O_VT + (16 * w + r) * PC + (32 * pr + 16 + 4 * q) * 2);
                v4u bw; bw.x = blo.x; bw.y = blo.y; bw.z = bhi.x; bw.w = bhi.y;
                o = __builtin_amdgcn_mfma_f32_16x16x32_bf16(av, __builtin_bit_cast(bf16x8, bw), o, 0, 0, 0); }
            *(f32x4*)(OI + (((size_t)u * 8 + w) * 4 + i) * 256 + F.lane * 4) = o;
        }
    }
    __syncthreads();
}
__device__ __forceinline__ void p_hgrn_scan(Frame& F, const Args& A) {
    const bf16* QD = (const bf16*)(F.ws + WS_HQD); const bf16* UT = (const bf16*)(F.ws + WS_HUT); const float* OI = (const float*)(F.ws + WS_HOI); const float* DT = (const float*)(F.ws + WS_HDT);
    const bf16* Gt = (const bf16*)(F.ws + WS_HG); bf16* O = (bf16*)(F.ws + WS_HO); const float* normg = A.in[12];
    LAS float* Lss = (LAS float*)(F.lds + RING_OFF);
    const int r = F.lane & 15, q = F.lane >> 4, w = F.wave;
    for (int unit = (int)blockIdx.x; unit < NB * NH; unit += F.G) {
        const int b = unit / NH, h = unit % NH;
        float S[4][8];
#pragma unroll
        for (int ks = 0; ks < 4; ++ks)
#pragma unroll
            for (int e = 0; e < 8; ++e) S[ks][e] = 0.f;
        const float ng = normg[16 * w + r];
        for (int c = 0; c < 64; ++c) {
            const size_t u = (size_t)unit * 64 + c; const int t0 = b * SEQ + c * 64;
            bf16x8 sb[4];
#pragma unroll
            for (int ks = 0; ks < 4; ++ks) { v4u x; x.x = pk2(S[ks][0], S[ks][1]); x.y = pk2(S[ks][2], S[ks][3]); x.z = pk2(S[ks][4], S[ks][5]); x.w = pk2(S[ks][6], S[ks][7]); sb[ks] = __builtin_bit_cast(bf16x8, x); }
            f32x4 o[4];
#pragma unroll
            for (int ti = 0; ti < 4; ++ti) { o[ti] = *(const f32x4*)(OI + ((u * 8 + w) * 4 + ti) * 256 + F.lane * 4);
#pragma unroll
                for (int ks = 0; ks < 4; ++ks) { const bf16x8 av = *(const bf16x8*)(QD + (u * 64 + 16 * ti + r) * 128 + 32 * ks + 8 * q); o[ti] = __builtin_amdgcn_mfma_f32_16x16x32_bf16(av, sb[ks], o[ti], 0, 0, 0); } }
#pragma unroll
            for (int ks = 0; ks < 4; ++ks) { const v4u uu = *(const v4u*)(UT + (u * 128 + 16 * w + r) * 128 + 32 * ks + 8 * q);
                const f32x4 d0 = *(const f32x4*)(DT + u * 128 + 32 * ks + 8 * q), d1 = *(const f32x4*)(DT + u * 128 + 32 * ks + 8 * q + 4);
                S[ks][0] = d0.x * S[ks][0] + bflo(uu.x); S[ks][1] = d0.y * S[ks][1] + bfhi(uu.x); S[ks][2] = d0.z * S[ks][2] + bflo(uu.y); S[ks][3] = d0.w * S[ks][3] + bfhi(uu.y);
                S[ks][4] = d1.x * S[ks][4] + bflo(uu.z); S[ks][5] = d1.y * S[ks][5] + bfhi(uu.z); S[ks][6] = d1.z * S[ks][6] + bflo(uu.w); S[ks][7] = d1.w * S[ks][7] + bfhi(uu.w); }
            LAS float* ls = Lss + (c & 1) * 512;
#pragma unroll
            for (int ti = 0; ti < 4; ++ti)
#pragma unroll
                for (int e = 0; e < 4; ++e) { float x = o[ti][e] * o[ti][e]; x += DPP_F(x, 0xB1); x += DPP_F(x, 0x4E); x += DPP_F(x, 0x141); x += DPP_F(x, 0x140);
                    if (r == 0) ls[(16 * ti + 4 * q + e) * 8 + w] = x; }
            __syncthreads();
#pragma unroll
            for (int ti = 0; ti < 4; ++ti)
#pragma unroll
                for (int e = 0; e < 4; ++e) { const int t = 16 * ti + 4 * q + e; const f32x4 p0 = *(const LAS f32x4*)(ls + t * 8), p1 = *(const LAS f32x4*)(ls + t * 8 + 4);
                    const float ms = ((p0.x + p0.y) + (p0.z + p0.w) + (p1.x + p1.y) + (p1.z + p1.w)) * (1.0f / HD); const float rr = 1.0f / sqrtf(ms + LN_EPS);
                    const size_t off = (size_t)(t0 + t) * D + h * HD + 16 * w + r;
                    O[off] = (bf16)f2bf(o[ti][e] * rr * ng * bf2f(Gt[off])); }
        }
    }
    __syncthreads();
}

__global__ void __launch_bounds__(NWAVES * 64, 2) mk_fwd(Args args) {
    extern __shared__ __attribute__((aligned(16))) unsigned char lds[];
    Frame F;
    F.lds = (LAS unsigned char*)lds;
    F.tid = threadIdx.x; F.lane = F.tid & 63; F.wave = __builtin_amdgcn_readfirstlane(F.tid >> 6);
    F.G = gridDim.x; { const int bx = blockIdx.x; F.vcu = (F.G % 8 == 0) ? (bx % 8) * (F.G / 8) + bx / 8 : bx; }
    F.ws = args.ws; F.ctl = (unsigned*)(args.ws + WS_CTL);
    const Args& A = args;
    for (int u = F.tid; u < (LDS_BYTES - LDSCTL_OFF) / 4; u += NWAVES * 64) ((LAS unsigned*)(F.lds + LDSCTL_OFF))[u] = 0u;
    __syncthreads();
    XcdBarrier bar; bar.bar = F.ctl + CW_BAR; bar.x = 0; bar.st = nullptr;
    if (N_LAUNCHES == 1) bar = xcd_barrier_post(F.ctl + CW_BAR, (volatile LAS unsigned*)(F.lds + MISC_OFF) + 8);
    const int lo = args.ph_lo, hi = args.ph_hi;
#ifndef PH_MASK
#define PH_MASK 0x1FFFF
#endif
#define IN(k) (((PH_MASK >> (k)) & 1) && lo <= (k) && (k) < hi)
#define SEAM(k) do { if (IN(k) && IN((k) + 1)) xcd_barrier(bar); } while (0)
#ifndef PH_DUP
#define PH_DUP 0
#endif
#define DUPN(k) ((PH_DUP >> (k)) & 1)
#define REP(k, body) { body; if (DUPN(k)) { xcd_barrier(bar); F.refresh(); body; } }
    unsigned char* ws = args.ws;
    LAS unsigned char* ring = F.lds + RING_OFF;

    if (IN(0)) { F.refresh(); REP(0, p0_prologue(F, A)) SEAM(0); }
    if (IN(1)) { F.refresh();
        pg8::DenseOrder S; S.init(ws + WS_XINB, ws + WS_GIN, T, 2 * D, D, F.G, (int)blockIdx.x);
        pg8::EpiGelu E{(bf16*)(ws + WS_Z), 2 * D};
        pg8::gemm_phase<pg8::EpiGelu, pg8::DenseOrder, true, true>(ring, D, S, E);
        SEAM(1);
    }
    if (IN(2)) { F.refresh(); REP(2, p_vstats(F)) SEAM(2); }
    if (IN(3)) { F.refresh(); REP(3, p_spatial(F, A)) SEAM(3); }
    if (IN(4)) { F.refresh();
        pg8::DenseOrder S; S.init(ws + WS_YG, ws + WS_GOUT, T, D, D, F.G, (int)blockIdx.x);
        pg8::EpiRes E{A.in[0], (float*)(ws + WS_XR), D, ALPHA};
        pg8::gemm_phase<pg8::EpiRes, pg8::DenseOrder, true, true>(ring, D, S, E);
        SEAM(4);
    }
    if (IN(5)) { F.refresh(); p_ln_router(F, A, (const float*)(ws + WS_XR), A.in[1], A.in[2], (float*)(ws + WS_XA), (bf16*)(ws + WS_XB), 0); SEAM(5); }
    if (IN(6)) { F.refresh();
        moe_tables(F, 0, 4);
        pg8::MoeOrder<true> S{(const LAS int*)(F.lds + LT_UNITS), *(const LAS int*)(F.lds + LT_NUNITS), (const char*)(ws + WS_XB), (const char*)(ws + WS_W1), W1_E, D, (const unsigned*)(ws + WS_LIST)};
        pg8::EpiMoe1 E{(bf16*)(ws + WS_HM)};
        pg8::gemm_phase<pg8::EpiMoe1, pg8::MoeOrder<true>, true, true>(ring, D, S, E);
        SEAM(6);
    }
    if (IN(7)) { F.refresh();
        moe_tables(F, 0, 8);
        pg8::MoeOrder<false> S{(const LAS int*)(F.lds + LT_UNITS), *(const LAS int*)(F.lds + LT_NUNITS), (const char*)(ws + WS_HM), (const char*)(ws + WS_W2), W2_E, EXD, nullptr};
        pg8::EpiMoe2 E{(bf16*)(ws + WS_RA), D};
        pg8::gemm_phase<pg8::EpiMoe2, pg8::MoeOrder<false>, true, true>(ring, EXD, S, E);
        SEAM(7);
    }
    if (IN(8)) { F.refresh(); REP(8, p_combine_ln(F, (const float*)(ws + WS_XA), A.in[3], A.in[4], (float*)(ws + WS_XR), (bf16*)(ws + WS_XB), 0)) SEAM(8); }
    if (IN(9)) { F.refresh();
        pg8::DenseOrder S; S.init(ws + WS_XB, ws + WS_HIN, T, 4 * D, D, F.G, (int)blockIdx.x);
        pg8::EpiHgrn E{(bf16*)(ws + WS_HQ), (bf16*)(ws + WS_HK), (bf16*)(ws + WS_HV), (bf16*)(ws + WS_HG), (float*)(ws + WS_HF), (const float*)(ws + WS_LB), D};
        pg8::gemm_phase<pg8::EpiHgrn, pg8::DenseOrder, true, true>(ring, D, S, E);
        SEAM(9);
    }
    if (IN(10)) { F.refresh(); REP(10, p_hgrn_intra(F)) SEAM(10); }
    if (IN(11)) { F.refresh(); REP(11, p_hgrn_scan(F, A)) SEAM(11); }
    if (IN(12)) { F.refresh();
        pg8::DenseOrder S; S.init(ws + WS_HO, ws + WS_HOUT, T, D, D, F.G, (int)blockIdx.x);
        pg8::EpiRes E{(const float*)(ws + WS_XR), (float*)(ws + WS_XA), D, ALPHA};
        pg8::gemm_phase<pg8::EpiRes, pg8::DenseOrder, true, true>(ring, D, S, E);
        SEAM(12);
    }
    if (IN(13)) { F.refresh(); p_ln_router(F, A, (const float*)(ws + WS_XA), A.in[1] + D, A.in[2] + D, (float*)(ws + WS_XR), (bf16*)(ws + WS_XB), 1); SEAM(13); }
    if (IN(14)) { F.refresh();
        moe_tables(F, 1, 4);
        pg8::MoeOrder<true> S{(const LAS int*)(F.lds + LT_UNITS), *(const LAS int*)(F.lds + LT_NUNITS), (const char*)(ws + WS_XB), (const char*)(ws + WS_W1 + W1_L), W1_E, D, (const unsigned*)(ws + WS_LIST)};
        pg8::EpiMoe1 E{(bf16*)(ws + WS_HM)};
        pg8::gemm_phase<pg8::EpiMoe1, pg8::MoeOrder<true>, true, true>(ring, D, S, E);
        SEAM(14);
    }
    if (IN(15)) { F.refresh();
        moe_tables(F, 1, 8);
        pg8::MoeOrder<false> S{(const LAS int*)(F.lds + LT_UNITS), *(const LAS int*)(F.lds + LT_NUNITS), (const char*)(ws + WS_HM), (const char*)(ws + WS_W2 + W2_L), W2_E, EXD, nullptr};
        pg8::EpiMoe2 E{(bf16*)(ws + WS_RA), D};
        pg8::gemm_phase<pg8::EpiMoe2, pg8::MoeOrder<false>, true, true>(ring, EXD, S, E);
        SEAM(15);
    }
    if (IN(16)) { F.refresh(); REP(16, p_combine_ln(F, (const float*)(ws + WS_XR), A.in[3] + D, A.in[4] + D, A.out, nullptr, 1)) }
#undef IN
#undef SEAM
}

extern "C" void kernel_launch(void* const* d_in, const int* in_sizes, int n_in, void* d_out, int out_size, void* d_ws, size_t ws_size, hipStream_t stream) {
    static int grid = 0;
    if (grid == 0) {
        if (n_in != 23 || in_sizes[0] != T * D || out_size != T * D || ws_size < WS_END) { fprintf(stderr, "kernel_launch: unexpected shapes (n_in %d, in0 %d, out %d, ws %zu < %zu); nothing launched\n", n_in, n_in > 0 ? in_sizes[0] : -1, out_size, ws_size, (size_t)WS_END); grid = -1; return; }
        int dev = 0, cus = 0, per_cu = 0;
        if (hipGetDevice(&dev) != hipSuccess || hipDeviceGetAttribute(&cus, hipDeviceAttributeMultiprocessorCount, dev) != hipSuccess) { grid = -1; return; }
        if (hipFuncSetAttribute((const void*)mk_fwd, hipFuncAttributeMaxDynamicSharedMemorySize, LDS_BYTES) != hipSuccess) { fprintf(stderr, "kernel_launch: hipFuncSetAttribute failed\n"); grid = -1; return; }
        if (hipOccupancyMaxActiveBlocksPerMultiprocessor(&per_cu, (const void*)mk_fwd, NWAVES * 64, LDS_BYTES) != hipSuccess || per_cu < 1) fprintf(stderr, "kernel_launch: note: occupancy query reports %d\n", per_cu);
        (void)hipGetLastError();
        grid = cus;
    }
    if (grid < 0) return;
    if (hipMemsetAsync((char*)d_ws + WS_CTL, 0, CTL_ZERO_BYTES, stream) != hipSuccess) return;
    Args a{};
    for (int i = 0; i < 23; ++i) a.in[i] = (const float*)d_in[i];
    a.out = (float*)d_out; a.ws = (unsigned char*)d_ws;
    for (int li = 0; li < N_LAUNCHES; ++li) {
        if (N_LAUNCHES == 1) { a.ph_lo = 0; a.ph_hi = N_PHASES; } else { a.ph_lo = li; a.ph_hi = li + 1; }
        hipLaunchKernelGGL(mk_fwd, dim3(grid), dim3(NWAVES * 64), LDS_BYTES, stream, a);
        if (hipPeekAtLastError() != hipSuccess) { fprintf(stderr, "kernel_launch: launch %d failed\n", li); break; }
    }
}
```

```cpp
#include <hip/hip_runtime.h>
#include <cstdio>
#include <cstdint>

#ifndef MK_N_LAUNCHES
#define MK_N_LAUNCHES 1
#endif

namespace pg8 {
#define PG8_LAS __attribute__((address_space(3)))
typedef unsigned short bf16_t;
typedef short bf16x8 __attribute__((ext_vector_type(8)));
typedef float f32x4 __attribute__((ext_vector_type(4)));
typedef float f32x2 __attribute__((ext_vector_type(2)));
typedef unsigned u32x4 __attribute__((ext_vector_type(4)));
constexpr int BM = 256, BK = 64, HALF = 128, HTB = HALF * BK * 2  , STAGE_BYTES = 8 * HTB, NXCD = 8, WGM = 8;

__host__ __device__ __forceinline__ int lds_byte(int r, int c) { const int st = (r >> 4) * 2 + (c >> 5), rr = r & 15, cc = c & 31, ob = rr * 64 + cc * 2; return st * 1024 + (ob ^ (((ob >> 9) & 1) << 5)); }
__host__ __device__ __forceinline__ void stage_rc(int b, int& R, int& C) { const int st = b / 1024, sb = b % 1024, swz = sb ^ (((sb >> 9) & 1) << 5); R = (st >> 1) * 16 + swz / 64; C = (st & 1) * 32 + (swz % 64) / 2; }
__host__ __device__ __forceinline__ int perm32(int rho) { const int n = rho >> 4, i = rho & 15; return 8 * (i >> 2) + 4 * n + (i & 3); }

struct Unit { int pm, pn, e, rows, orow; };

struct DenseOrder {
    static constexpr bool GATHER = false;
    const char* A; const char* Bt; int K, nM, nN, nwg, G, c;
    __device__ void init(const void* A_, const void* Bt_, int M, int N, int K_, int G_, int c_) { A = (const char*)A_; Bt = (const char*)Bt_; K = K_; nM = M / BM; nN = N / BM; nwg = nM * nN; G = G_; c = c_; }
    __device__ bool next(int i, Unit& u) const {
        const long L = (long)i * G + c; if (L >= nwg) return false;
        int wgid = (int)L; { const int q = nwg / NXCD, r = nwg % NXCD, xcd = wgid % NXCD, off = wgid / NXCD; wgid = (xcd < r ? xcd * (q + 1) : r * (q + 1) + (xcd - r) * q) + off; }
        const int nig = WGM * nN, gid = wgid / nig, fm = gid * WGM, gsz = (nM - fm) < WGM ? (nM - fm) : WGM;
        u.pm = fm + ((wgid % nig) % gsz); u.pn = (wgid % nig) / gsz; u.e = 0; u.rows = BM; u.orow = u.pm * BM; return true;
    }
    __device__ __forceinline__ const char* a_ptr(const Unit& u) const { return A + (size_t)u.pm * BM * K * 2; }
    __device__ __forceinline__ const char* b_ptr(const Unit& u) const { return Bt + (size_t)u.pn * BM * K * 2; }
    __device__ __forceinline__ int tok(const Unit&, int) const { return 0; }
};
template <bool GATHER_> struct MoeOrder {
    static constexpr bool GATHER = GATHER_;
    const PG8_LAS int* tab; int n;
    const char* A; const char* Bt; size_t b_estride; int K; const unsigned* list;
    __device__ bool next(int i, Unit& u) const { if (i >= n) return false; const PG8_LAS int* t = tab + 5 * i; u.e = t[0]; u.pm = t[1]; u.pn = t[2]; u.rows = t[3]; u.orow = t[4]; return true; }
    __device__ __forceinline__ const char* a_ptr(const Unit& u) const { return GATHER ? A : A + (size_t)u.orow * K * 2; }
    __device__ __forceinline__ const char* b_ptr(const Unit& u) const { return Bt + (size_t)u.e * b_estride + (size_t)u.pn * BM * K * 2; }
    __device__ __forceinline__ int tok(const Unit& u, int row) const { if (u.e >= 64) return u.pm * BM + row; return row < u.rows ? (int)list[(size_t)u.e * 16384 + u.pm * BM + row] : 0; }
};

__device__ __forceinline__ unsigned cvt_pk_bf16(float lo, float hi) { unsigned r; asm volatile("v_cvt_pk_bf16_f32 %0, %1, %2" : "=v"(r) : "v"(lo), "v"(hi)); return r; }
__device__ __forceinline__ f32x2 gelu_pk(f32x2 v) {
    const f32x2 av = __builtin_elementwise_abs(v), d = av * 0.2316418882f + 1.0f;
    f32x2 t; t.x = __builtin_amdgcn_rcpf(d.x); t.y = __builtin_amdgcn_rcpf(d.y);
    f32x2 q = t * 0.5307027145f + (-0.7265760135f); q = q * t + 0.7107068705f; q = q * t + (-0.142248368f); q = q * t + 0.127414796f; q = q * t;
    const f32x2 s = (v * v) * (-0.72134752044f);
    f32x2 e; e.x = __builtin_amdgcn_exp2f(s.x); e.y = __builtin_amdgcn_exp2f(s.y);
    const f32x2 m = v * (q * e), r = v - m;
    f32x2 o; o.x = v.x < 0.f ? m.x : r.x; o.y = v.y < 0.f ? m.y : r.y; return o;
}
__device__ __forceinline__ float sigmoidf_(float x) { return __builtin_amdgcn_rcpf(1.0f + __expf(-x)); }

struct EpiGelu {
    static constexpr bool PERM = true;
    bf16_t* O; int ldc;
    __device__ __forceinline__ void operator()(const f32x4 (&acc)[2][2][4][2], const Unit& u, int wr, int wc, int fr, int fq) const {
        const int row0 = u.pm * BM + wr * 64 + fr, col0 = u.pn * BM + wc * 32 + 8 * fq;
#pragma unroll
        for (int ai = 0; ai < 2; ++ai)
#pragma unroll
            for (int m = 0; m < 4; ++m) { bf16_t* rowp = O + (size_t)(row0 + ai * HALF + m * 16) * ldc + col0;
#pragma unroll
                for (int bj = 0; bj < 2; ++bj) { const f32x4 v0 = acc[ai][bj][m][0], v1 = acc[ai][bj][m][1];
                    const f32x2 a = gelu_pk((f32x2){v0[0], v0[1]}), b = gelu_pk((f32x2){v0[2], v0[3]}), c = gelu_pk((f32x2){v1[0], v1[1]}), d = gelu_pk((f32x2){v1[2], v1[3]});
                    u32x4 w; w.x = cvt_pk_bf16(a.x, a.y); w.y = cvt_pk_bf16(b.x, b.y); w.z = cvt_pk_bf16(c.x, c.y); w.w = cvt_pk_bf16(d.x, d.y);
                    *(u32x4*)(rowp + bj * HALF) = w; } }
    }
};
struct EpiRes {
    static constexpr bool PERM = false;
    const float* res; float* out; int ldc; float alpha;
    __device__ __forceinline__ void operator()(const f32x4 (&acc)[2][2][4][2], const Unit& u, int wr, int wc, int fr, int fq) const {
        const int row0 = u.pm * BM + wr * 64 + fr, col0 = u.pn * BM + wc * 32 + 4 * fq;
#pragma unroll
        for (int ai = 0; ai < 2; ++ai)
#pragma unroll
            for (int m = 0; m < 4; ++m) { const size_t off = (size_t)(row0 + ai * HALF + m * 16) * ldc + col0;
#pragma unroll
                for (int bj = 0; bj < 2; ++bj)
#pragma unroll
                    for (int n = 0; n < 2; ++n) { const f32x4 r = *(const f32x4*)(res + off + bj * HALF + n * 16); *(f32x4*)(out + off + bj * HALF + n * 16) = r * alpha + acc[ai][bj][m][n]; }
                if (m & 1) asm volatile("" ::: "memory"); }
    }
};
struct EpiHgrn {
    static constexpr bool PERM = true;
    bf16_t* Q; bf16_t* Kk; bf16_t* V; bf16_t* G; float* F; const float* lb; int D;
    __device__ __forceinline__ void operator()(const f32x4 (&acc)[2][2][4][2], const Unit& u, int wr, int wc, int fr, int fq) const {
        const int kind = u.pn / (D / BM);
        const int row0 = u.pm * BM + wr * 64 + fr, col0 = (u.pn % (D / BM)) * BM + wc * 32 + 8 * fq;
        if (kind == 1) {
#pragma unroll
            for (int bj = 0; bj < 2; ++bj) {
                const f32x4 l0 = *(const f32x4*)(lb + col0 + bj * HALF), l1 = *(const f32x4*)(lb + col0 + bj * HALF + 4);
#pragma unroll
                for (int ai = 0; ai < 2; ++ai)
#pragma unroll
                    for (int m = 0; m < 4; ++m) { const size_t off = (size_t)(row0 + ai * HALF + m * 16) * D + col0 + bj * HALF;
                        f32x4 fo[2], ko[2];
#pragma unroll
                        for (int j = 0; j < 4; ++j) { const float s0 = sigmoidf_(acc[ai][bj][m][0][j]), s1 = sigmoidf_(acc[ai][bj][m][1][j]);
                            fo[0][j] = __logf(l0[j] + (1.0f - l0[j]) * s0); ko[0][j] = (1.0f - l0[j]) * (1.0f - s0); fo[1][j] = __logf(l1[j] + (1.0f - l1[j]) * s1); ko[1][j] = (1.0f - l1[j]) * (1.0f - s1); }
                        *(f32x4*)(F + off) = fo[0]; *(f32x4*)(F + off + 4) = fo[1];
                        u32x4 w; w.x = cvt_pk_bf16(ko[0][0], ko[0][1]); w.y = cvt_pk_bf16(ko[0][2], ko[0][3]); w.z = cvt_pk_bf16(ko[1][0], ko[1][1]); w.w = cvt_pk_bf16(ko[1][2], ko[1][3]);
                        *(u32x4*)(Kk + off) = w;
                        asm volatile("" ::: "memory"); } }
        } else {
            bf16_t* O = kind == 0 ? Q : (kind == 2 ? V : G);
            const bool act = kind != 2;
#pragma unroll
            for (int ai = 0; ai < 2; ++ai)
#pragma unroll
                for (int m = 0; m < 4; ++m) { const size_t off = (size_t)(row0 + ai * HALF + m * 16) * D + col0;
#pragma unroll
                    for (int bj = 0; bj < 2; ++bj) { f32x4 o[2];
#pragma unroll
                        for (int n = 0; n < 2; ++n)
#pragma unroll
                            for (int j = 0; j < 4; ++j) { const float x = acc[ai][bj][m][n][j]; o[n][j] = act ? x * sigmoidf_(x) : x; }
                        u32x4 w; w.x = cvt_pk_bf16(o[0][0], o[0][1]); w.y = cvt_pk_bf16(o[0][2], o[0][3]); w.z = cvt_pk_bf16(o[1][0], o[1][1]); w.w = cvt_pk_bf16(o[1][2], o[1][3]);
                        *(u32x4*)(O + off + bj * HALF) = w; } }
        }
    }
};
struct EpiMoe1 {
    static constexpr bool PERM = true;
    bf16_t* H;
    __device__ __forceinline__ void operator()(const f32x4 (&acc)[2][2][4][2], const Unit& u, int wr, int wc, int fr, int fq) const {
        const int col0 = u.pn * HALF + wc * 32 + 8 * fq;
#pragma unroll
        for (int ai = 0; ai < 2; ++ai)
#pragma unroll
            for (int m = 0; m < 4; ++m) { const int r = ai * HALF + wr * 64 + m * 16 + fr;
                f32x4 o[2];
#pragma unroll
                for (int n = 0; n < 2; ++n)
#pragma unroll
                    for (int j = 0; j < 4; ++j) { const float g = acc[ai][0][m][n][j]; o[n][j] = g * sigmoidf_(g) * acc[ai][1][m][n][j]; }
                u32x4 w; w.x = cvt_pk_bf16(o[0][0], o[0][1]); w.y = cvt_pk_bf16(o[0][2], o[0][3]); w.z = cvt_pk_bf16(o[1][0], o[1][1]); w.w = cvt_pk_bf16(o[1][2], o[1][3]);
                if (r < u.rows) *(u32x4*)(H + (size_t)(u.orow + r) * 512 + col0) = w; }
    }
};
struct EpiMoe2 {
    static constexpr bool PERM = true;
    bf16_t* Y; int ldc;
    __device__ __forceinline__ void operator()(const f32x4 (&acc)[2][2][4][2], const Unit& u, int wr, int wc, int fr, int fq) const {
        const int col0 = u.pn * BM + wc * 32 + 8 * fq;
#pragma unroll
        for (int ai = 0; ai < 2; ++ai)
#pragma unroll
            for (int m = 0; m < 4; ++m) { const int r = ai * HALF + wr * 64 + m * 16 + fr;
#pragma unroll
                for (int bj = 0; bj < 2; ++bj) { const f32x4 v0 = acc[ai][bj][m][0], v1 = acc[ai][bj][m][1];
                    u32x4 w; w.x = cvt_pk_bf16(v0[0], v0[1]); w.y = cvt_pk_bf16(v0[2], v0[3]); w.z = cvt_pk_bf16(v1[0], v1[1]); w.w = cvt_pk_bf16(v1[2], v1[3]);
                    if (r < u.rows) *(u32x4*)(Y + (size_t)(u.orow + r) * ldc + col0 + bj * HALF) = w; } }
    }
};

template <class Epi, class Sched, bool ALIGN_EPI, bool SP2>
__device__ __forceinline__ void gemm_phase(PG8_LAS unsigned char* lds, const int K, const Sched& S, const Epi& E) {
    constexpr bool GATHER = Sched::GATHER;
    const int tid = threadIdx.x, wid = __builtin_amdgcn_readfirstlane(tid >> 6), lane = tid & 63, wr = wid >> 2, wc = wid & 3, fr = lane & 15, fq = lane >> 4;
    const int nt = K / BK;
    unsigned voffA[2][2], voffN[2][2], voffB[2]; int sR[2], sC[2];
#pragma unroll
    for (int i = 0; i < 2; ++i) { int R, C; stage_rc(tid * 16 + i * 8192, R, C); sR[i] = R; sC[i] = C; const int Rb = Epi::PERM ? ((R & ~31) + perm32(R & 31)) : R;
        voffA[0][i] = (unsigned)(R * K + C) * 2u; voffA[1][i] = voffA[0][i]; voffN[0][i] = voffA[0][i]; voffN[1][i] = voffA[0][i]; voffB[i] = (unsigned)(Rb * K + C) * 2u; }
    const size_t kstep = (size_t)(BK * 2);
    const size_t hstep = (size_t)HALF * K * 2;
    const unsigned ldsw = (unsigned)wid * 1024u;
    const int aoff = lds_byte(wr * 64 + fr, fq * 8), boff = lds_byte(wc * 32 + fr, fq * 8);
#define PG8_SA(b, h) (((b) * 2 + (h)) * HTB)
#define PG8_SB(b, h) ((4 + (b) * 2 + (h)) * HTB)
#define PG8_GLDS(gptr, ldsoff) __builtin_amdgcn_global_load_lds((const unsigned*)(gptr), (PG8_LAS unsigned*)(lds + (ldsoff)), 16, 0, 0)
#define PG8_STAGE_B(b, h, kptr) do { _Pragma("unroll") for (int _i = 0; _i < 2; ++_i) PG8_GLDS((kptr) + (size_t)(h) * hstep + voffB[_i], PG8_SB(b, h) + ldsw + _i * 8192); } while (0)
#define PG8_STAGE_A(b, h, kptr) do { _Pragma("unroll") for (int _i = 0; _i < 2; ++_i) { if constexpr (GATHER) PG8_GLDS((kptr) + voffA[h][_i], PG8_SA(b, h) + ldsw + _i * 8192); else PG8_GLDS((kptr) + (size_t)(h) * hstep + voffA[0][_i], PG8_SA(b, h) + ldsw + _i * 8192); } } while (0)
#define PG8_LDA(dst, b, h) do { _Pragma("unroll") for (int m = 0; m < 4; ++m) _Pragma("unroll") for (int k = 0; k < 2; ++k) dst[m][k] = *(const PG8_LAS bf16x8*)(lds + PG8_SA(b, h) + aoff + m * 2048 + k * 1024); } while (0)
#define PG8_LDB(dst, b, h) do { _Pragma("unroll") for (int n = 0; n < 2; ++n) _Pragma("unroll") for (int k = 0; k < 2; ++k) dst[n][k] = *(const PG8_LAS bf16x8*)(lds + PG8_SB(b, h) + boff + n * 2048 + k * 1024); } while (0)
#define PG8_MMA(ai, bj, At, Bt) do { __builtin_amdgcn_s_setprio(1); _Pragma("unroll") for (int m = 0; m < 4; ++m) _Pragma("unroll") for (int n = 0; n < 2; ++n) _Pragma("unroll") for (int k = 0; k < 2; ++k) \
        acc[ai][bj][m][n] = __builtin_amdgcn_mfma_f32_16x16x32_bf16(Bt[n][k], At[m][k], acc[ai][bj][m][n], 0, 0, 0); __builtin_amdgcn_s_setprio(0); } while (0)
#define PG8_WAIT_V(n) asm volatile("s_waitcnt vmcnt(" #n ")" ::: "memory")
#define PG8_WAIT_L(n) asm volatile("s_waitcnt lgkmcnt(" #n ")" ::: "memory")
#define PG8_BAR __builtin_amdgcn_s_barrier()
#define PG8_SCHED __builtin_amdgcn_sched_barrier(0)
#define PG8_LOAD_OFFS(dst, unit) do { _Pragma("unroll") for (int _h = 0; _h < 2; ++_h) _Pragma("unroll") for (int _i = 0; _i < 2; ++_i) dst[_h][_i] = (unsigned)S.tok(unit, _h * HALF + sR[_i]) * (unsigned)(K * 2) + (unsigned)(sC[_i] * 2); \
        asm volatile("s_waitcnt vmcnt(0)" ::: "memory"); } while (0)
    Unit cur, nxt; int ui = 0;
    if (!S.next(0, cur)) return;
    f32x4 acc[2][2][4][2];
#pragma unroll
    for (int a = 0; a < 2; ++a)
#pragma unroll
        for (int b = 0; b < 2; ++b)
#pragma unroll
            for (int m = 0; m < 4; ++m)
#pragma unroll
                for (int n = 0; n < 2; ++n) acc[a][b][m][n] = (f32x4){0.f, 0.f, 0.f, 0.f};
    bf16x8 At[4][2], B0[2][2], B1[2][2];
    const char* cA = S.a_ptr(cur); const char* cB = S.b_ptr(cur);
    if constexpr (GATHER) { PG8_LOAD_OFFS(voffA, cur);
#pragma unroll
        for (int h = 0; h < 2; ++h)
#pragma unroll
            for (int i = 0; i < 2; ++i) voffN[h][i] = voffA[h][i]; }
    if constexpr (SP2) {
        PG8_STAGE_B(0, 0, cB); PG8_STAGE_B(0, 1, cB); PG8_STAGE_A(0, 0, cA); PG8_STAGE_A(0, 1, cA);
        if (wr == 1) PG8_BAR;
        PG8_WAIT_V(2); PG8_BAR;
        PG8_STAGE_B(1, 0, cB + kstep); PG8_STAGE_A(1, 0, cA + kstep); PG8_STAGE_B(1, 1, cB + kstep);
        PG8_WAIT_V(6); PG8_BAR;
    } else {
        PG8_STAGE_B(0, 0, cB); PG8_STAGE_A(0, 0, cA); PG8_STAGE_B(0, 1, cB); PG8_STAGE_A(0, 1, cA);
        if (wr == 1) PG8_BAR;
        PG8_WAIT_V(4); PG8_BAR;
        PG8_STAGE_B(1, 0, cB + kstep); PG8_STAGE_A(1, 0, cA + kstep); PG8_STAGE_B(1, 1, cB + kstep);
        PG8_WAIT_V(6); PG8_BAR;
    }
    for (;;) {
        const bool has_next = S.next(ui + 1, nxt);
        const char* nA = has_next ? S.a_ptr(nxt) : cA; const char* nB = has_next ? S.b_ptr(nxt) : cB;
        for (int t = 0; t < nt; t += 2) {
            const bool last = (t == nt - 2);
            const char* a1 = cA + (size_t)(t + 1) * kstep;
            const char* a2 = last ? nA : cA + (size_t)(t + 2) * kstep; const char* b2 = last ? nB : cB + (size_t)(t + 2) * kstep;
            const char* a3 = a2 + kstep; const char* b3 = b2 + kstep;
            if constexpr (GATHER) { if (last && has_next) { PG8_LOAD_OFFS(voffN, nxt); } }
            if constexpr (SP2) {
            PG8_LDB(B0, 0, 0); PG8_LDB(B1, 0, 1); PG8_SCHED; PG8_LDA(At, 0, 0); PG8_STAGE_A(1, 1, a1);
            if constexpr (GATHER) { if (last) {
#pragma unroll
                for (int h = 0; h < 2; ++h)
#pragma unroll
                    for (int i = 0; i < 2; ++i) voffA[h][i] = voffN[h][i]; } }
            PG8_WAIT_V(8); PG8_WAIT_L(0); PG8_BAR; PG8_MMA(0, 0, At, B0); PG8_MMA(0, 1, At, B1); PG8_BAR; PG8_SCHED;
            PG8_LDA(At, 0, 1); PG8_STAGE_B(0, 0, b2); PG8_STAGE_B(0, 1, b2); PG8_STAGE_A(0, 0, a2);
            PG8_WAIT_V(8); PG8_WAIT_L(0); PG8_BAR; PG8_MMA(1, 0, At, B0); PG8_MMA(1, 1, At, B1); PG8_BAR; PG8_SCHED;
            PG8_LDB(B0, 1, 0); PG8_LDB(B1, 1, 1); PG8_SCHED; PG8_LDA(At, 1, 0); PG8_STAGE_A(0, 1, a2);
            PG8_WAIT_V(8); PG8_WAIT_L(0); PG8_BAR; PG8_MMA(0, 0, At, B0); PG8_MMA(0, 1, At, B1); PG8_BAR; PG8_SCHED;
            PG8_LDA(At, 1, 1); PG8_STAGE_B(1, 0, b3); PG8_STAGE_B(1, 1, b3); PG8_STAGE_A(1, 0, a3);
            PG8_WAIT_V(8); PG8_WAIT_L(0); PG8_BAR; PG8_MMA(1, 0, At, B0); PG8_MMA(1, 1, At, B1); PG8_BAR; PG8_SCHED;
            } else {
            PG8_LDB(B0, 0, 0); PG8_SCHED; PG8_LDA(At, 0, 0); PG8_STAGE_A(1, 1, a1);
            if constexpr (GATHER) { if (last) {
#pragma unroll
                for (int h = 0; h < 2; ++h)
#pragma unroll
                    for (int i = 0; i < 2; ++i) voffA[h][i] = voffN[h][i]; } }
            PG8_WAIT_L(8); PG8_BAR; PG8_WAIT_L(0); PG8_MMA(0, 0, At, B0); PG8_BAR; PG8_SCHED;
            PG8_LDB(B1, 0, 1); PG8_STAGE_B(0, 0, b2);
            PG8_BAR; PG8_WAIT_L(0); PG8_MMA(0, 1, At, B1); PG8_BAR;
            PG8_LDA(At, 0, 1); PG8_STAGE_A(0, 0, a2);
            PG8_BAR; PG8_WAIT_L(0); PG8_MMA(1, 0, At, B0); PG8_BAR; PG8_SCHED;
            PG8_STAGE_B(0, 1, b2);
            PG8_WAIT_V(6); PG8_BAR; PG8_MMA(1, 1, At, B1); PG8_BAR;
            PG8_LDB(B0, 1, 0); PG8_SCHED; PG8_LDA(At, 1, 0); PG8_STAGE_A(0, 1, a2);
            PG8_WAIT_L(8); PG8_BAR; PG8_WAIT_L(0); PG8_MMA(0, 0, At, B0); PG8_BAR; PG8_SCHED;
            PG8_LDB(B1, 1, 1); PG8_STAGE_B(1, 0, b3);
            PG8_BAR; PG8_WAIT_L(0); PG8_MMA(0, 1, At, B1); PG8_BAR;
            PG8_LDA(At, 1, 1); PG8_STAGE_A(1, 0, a3);
            PG8_BAR; PG8_WAIT_L(0); PG8_MMA(1, 0, At, B0); PG8_BAR; PG8_SCHED;
            PG8_STAGE_B(1, 1, b3);
            PG8_WAIT_V(6); PG8_BAR; PG8_MMA(1, 1, At, B1); PG8_BAR;
            }
        }
        if constexpr (ALIGN_EPI) { if (wr == 0) PG8_BAR; }
        E(acc, cur, wr, wc, fr, fq);
        if (!has_next) break;
#pragma unroll
        for (int a = 0; a < 2; ++a)
#pragma unroll
            for (int b = 0; b < 2; ++b)
#pragma unroll
                for (int m = 0; m < 4; ++m)
#pragma unroll
                    for (int n = 0; n < 2; ++n) acc[a][b][m][n] = (f32x4){0.f, 0.f, 0.f, 0.f};
        cur = nxt; cA = nA; cB = nB; ++ui;
        if constexpr (ALIGN_EPI) { if (wr == 1) PG8_BAR; }
    }
    PG8_WAIT_V(0);
    if constexpr (!ALIGN_EPI) { if (wr == 0) PG8_BAR; }
    PG8_BAR;
#undef PG8_SA
#undef PG8_SB
#undef PG8_GLDS
#undef PG8_STAGE_A
#undef PG8_STAGE_B
#undef PG8_LDA
#undef PG8_LDB
#undef PG8_MMA
#undef PG8_WAIT_V
#undef PG8_WAIT_L
#undef PG8_BAR
#undef PG8_SCHED
#undef PG8_LOAD_OFFS
}
}

constexpr int NWAVES = 8;
constexpr int N_LAUNCHES = MK_N_LAUNCHES;
constexpr int N_PHASES = 17;
constexpr int T = 16384, D = 2048, SEQ = 4096, NB = 4;
constexpr int NE = 64, NEA = 65, TOPK = 8, EXD = 512;
constexpr int NH = 16, HD = 128;
constexpr float LN_EPS = 1e-5f;
constexpr float ALPHA = 1.4142135623730951f;
constexpr float ROUTED_SCALE = 2.5f;
constexpr int NROWS = T * TOPK + T;

constexpr size_t MiB = 1u << 20;
constexpr size_t WS_CTL = 0, CTL_ZERO_BYTES = 1 * MiB;
constexpr size_t WS_LB = 1 * MiB;
constexpr size_t WS_VST = WS_LB + 64 * 1024;
constexpr size_t WS_WSP = 2 * MiB;
constexpr size_t WS_WR = 3 * MiB;
constexpr size_t WS_AES = 4 * MiB;
constexpr size_t WS_AW = 5 * MiB;
constexpr size_t WS_LIST = 6 * MiB;
constexpr size_t WS_GIN = 16 * MiB;
constexpr size_t WS_GOUT = WS_GIN + 16 * MiB;
constexpr size_t WS_HIN = WS_GOUT + 8 * MiB;
constexpr size_t WS_HOUT = WS_HIN + 32 * MiB;
constexpr size_t WS_W1 = WS_HOUT + 8 * MiB;
constexpr size_t W1_E = (size_t)1024 * 2048 * 2, W1_L = NEA * W1_E;
constexpr size_t WS_W2 = WS_W1 + 2 * W1_L;
constexpr size_t W2_E = (size_t)2048 * 512 * 2, W2_L = NEA * W2_E;
constexpr size_t WS_XA = WS_W2 + 2 * W2_L;
constexpr size_t WS_XR = WS_XA + 128 * MiB;
constexpr size_t WS_XB = WS_XR + 128 * MiB;
constexpr size_t WS_HM = WS_XB + 64 * MiB;
constexpr size_t WS_RA = WS_HM + 145 * MiB;
constexpr size_t WS_END = WS_RA + 576 * MiB;
constexpr size_t WS_XINB = WS_RA;
constexpr size_t WS_Z = WS_RA + 64 * MiB;
constexpr size_t WS_YG = WS_RA + 192 * MiB;
constexpr size_t WS_HQ = WS_RA, WS_HK = WS_RA + 64 * MiB, WS_HV = WS_RA + 128 * MiB, WS_HG = WS_RA + 192 * MiB;
constexpr size_t WS_HF = WS_RA + 256 * MiB;
constexpr size_t WS_HO = WS_RA + 384 * MiB;
constexpr size_t WS_HQD = WS_RA + 448 * MiB;
constexpr size_t WS_HDT = WS_RA + 512 * MiB;
constexpr size_t WS_HUT = WS_XA;
constexpr size_t WS_HOI = WS_HM;
static_assert((size_t)(NROWS + 256) * 512 * 2 <= 145 * MiB && (size_t)NROWS * D * 2 <= 576 * MiB && WS_END <= 2040 * MiB, "d_ws map");
constexpr int CW_BAR = 4096;
constexpr int CW_CNT = 16384;
constexpr int CNT_STRIDE = 16;

constexpr int RING_OFF = 0, RING_BYTES = 131072;
constexpr int LDSCTL_OFF = RING_BYTES;
constexpr int MISC_OFF = LDSCTL_OFF;
constexpr int LT_RB = LDSCTL_OFF + 256;
constexpr int LT_CNT = LDSCTL_OFF + 576;
constexpr int LT_NUNITS = LDSCTL_OFF + 896;
constexpr int LT_UNITS = LDSCTL_OFF + 1024;
constexpr int LDS_BYTES = 147456;

#define GAS __attribute__((address_space(1)))
#define LAS __attribute__((address_space(3)))
typedef unsigned short bf16;
typedef unsigned v4u __attribute__((ext_vector_type(4)));
typedef unsigned v2u __attribute__((ext_vector_type(2)));
typedef float f32x4 __attribute__((ext_vector_type(4)));
typedef short bf16x8 __attribute__((ext_vector_type(8)));
#define LDS_WAIT() asm volatile("s_waitcnt lgkmcnt(0)" ::: "memory")
#define VM_WAIT() asm volatile("s_waitcnt vmcnt(0)" ::: "memory")
__device__ __forceinline__ unsigned f2bf(float f) { unsigned u = __builtin_bit_cast(unsigned, f); return (u + 0x7fffu + ((u >> 16) & 1u)) >> 16; }
__device__ __forceinline__ unsigned pk2(float lo, float hi) { return f2bf(lo) | (f2bf(hi) << 16); }
__device__ __forceinline__ float bflo(unsigned w) { return __builtin_bit_cast(float, w << 16); }
__device__ __forceinline__ float bfhi(unsigned w) { return __builtin_bit_cast(float, w & 0xffff0000u); }
__device__ __forceinline__ float bf2f(unsigned short h) { return __builtin_bit_cast(float, (unsigned)h << 16); }

#define XB_TMO      128
#define XB_XCNT(j)  (256  + 64 * (j))
#define XB_XSUB(j)  (1280 + 64 * (j))
#define XB_XGEN(j)  (2304 + 64 * (j))
#define XB_TOP      3328
#define XB_TOPGEN   3392
#define XCD_BAR_WORDS 3456
#define XB_SPIN_CAP (1u << 18)
__device__ __forceinline__ unsigned xb_ld(unsigned* p)              { return __hip_atomic_load(p, __ATOMIC_RELAXED, __HIP_MEMORY_SCOPE_AGENT); }
__device__ __forceinline__ unsigned xb_add(unsigned* p, unsigned v) { return __hip_atomic_fetch_add(p, v, __ATOMIC_RELAXED, __HIP_MEMORY_SCOPE_AGENT); }
__device__ __forceinline__ unsigned xb_xcc_id() { return (unsigned)__builtin_amdgcn_s_getreg((3 << 11) | 20) & 0xFu; }
#define XB_SPIN(cond, bar) do { unsigned _sp = 0; while (cond) { __builtin_amdgcn_s_sleep(1); \
    if ((++_sp & 255u) == 0u) { if (xb_ld(&(bar)[XB_TMO])) break; if (_sp > XB_SPIN_CAP) { atomicAdd(&(bar)[XB_TMO], 1u); break; } } } } while (0)
struct XcdBarrier { unsigned* bar; unsigned x; volatile LAS unsigned* st; };
__device__ __forceinline__ XcdBarrier xcd_barrier_post(unsigned* bar, volatile LAS unsigned* st) {
    XcdBarrier b; b.bar = bar; b.x = xb_xcc_id(); b.st = st;
    if (threadIdx.x == 0) (void)xb_add(&bar[XB_XCNT(b.x)], 1u);
    return b;
}
__device__ __forceinline__ void xcd_barrier_complete(unsigned* bar, unsigned x, unsigned& nloc, unsigned& nx) {
    const unsigned G = gridDim.x * gridDim.y * gridDim.z;
    unsigned sum, cnt, mine, sp = 0u;
    for (;;) {
        sum = 0u; cnt = 0u; mine = 0u;
#pragma unroll
        for (unsigned j = 0; j < 16; ++j) { const unsigned c = xb_ld(&bar[XB_XCNT(j)]); sum += c; cnt += (c > 0u) ? 1u : 0u; mine = (j == x) ? c : mine; }
        if (sum == G) break;
        __builtin_amdgcn_s_sleep(1);
        if ((++sp & 255u) == 0u) { if (xb_ld(&bar[XB_TMO])) break; if (sp > XB_SPIN_CAP) { atomicAdd(&bar[XB_TMO], 1u); break; } }
    }
    nloc = mine > 0u ? mine : 1u; nx = cnt > 0u ? cnt : 1u;
}
__device__ __forceinline__ void xcd_barrier(const XcdBarrier& b) {
    asm volatile("s_waitcnt vmcnt(0)" ::: "memory");
    __syncthreads();
    if (threadIdx.x == 0) {
        unsigned* bar = b.bar;
        __builtin_amdgcn_s_waitcnt(0);
        unsigned nloc = b.st[0], nx = b.st[1];
        if (nloc == 0u) { xcd_barrier_complete(bar, b.x, nloc, nx); b.st[0] = nloc; b.st[1] = nx; }
        const unsigned old = xb_add(&bar[XB_XSUB(b.x)], 1u);
        const unsigned gen = old / nloc;
        if (old + 1u == (gen + 1u) * nloc) {
            __builtin_amdgcn_fence(__ATOMIC_RELEASE, "agent");
            asm volatile("s_waitcnt vmcnt(0)" ::: "memory");
            const unsigned og = xb_add(&bar[XB_TOP], 1u);
            const unsigned tg = og / nx;
            if (og + 1u == (tg + 1u) * nx) xb_add(&bar[XB_TOPGEN], 1u);
            else XB_SPIN(xb_ld(&bar[XB_TOPGEN]) == tg, bar);
            __builtin_amdgcn_fence(__ATOMIC_ACQUIRE, "agent");
            xb_add(&bar[XB_XGEN(b.x)], 1u);
            asm volatile("s_waitcnt vmcnt(0)" ::: "memory");
        } else {
            XB_SPIN(xb_ld(&bar[XB_XGEN(b.x)]) == gen, bar);
            __builtin_amdgcn_fence(__ATOMIC_ACQUIRE, "agent");
            asm volatile("s_waitcnt vmcnt(0)" ::: "memory");
        }
    }
    __syncthreads();
}

struct Args { const float* in[23]; float* out; unsigned char* ws; int ph_lo, ph_hi; };
struct Frame {
    LAS unsigned char* lds;
    unsigned* ctl;
    unsigned char* ws;
    int tid, lane, wave, vcu, G;
    __device__ __forceinline__ void refresh() { int t = threadIdx.x; asm volatile("" : "+v"(t)); tid = t; lane = t & 63; wave = __builtin_amdgcn_readfirstlane(t >> 6); }
};
#define DPP_F(v, ctrl) __builtin_bit_cast(float, __builtin_amdgcn_update_dpp(0, __builtin_bit_cast(int, (v)), (ctrl), 0xf, 0xf, true))
__device__ __forceinline__ float wave_sum(float v) {
    v += DPP_F(v, 0xB1); v += DPP_F(v, 0x4E); v += DPP_F(v, 0x141); v += DPP_F(v, 0x140);
    const int iv = __builtin_bit_cast(int, v);
    return (__builtin_bit_cast(float, __builtin_amdgcn_readlane(iv, 0)) + __builtin_bit_cast(float, __builtin_amdgcn_readlane(iv, 16))) + (__builtin_bit_cast(float, __builtin_amdgcn_readlane(iv, 32)) + __builtin_bit_cast(float, __builtin_amdgcn_readlane(iv, 48)));
}
#define OPAQUE(x) asm volatile("" : "+v"(x))

__device__ __forceinline__ void p0_transpose_item(const float* W, int N, int K, bf16* WT, int k0, int n0, int dst_row0, LAS float* scr, int lane) {
#pragma unroll
    for (int i = 0; i < 8; ++i) { const int kk = 8 * i + (lane >> 3), n4 = (lane & 7) * 4; const f32x4 v = *(const f32x4*)(W + (size_t)(k0 + kk) * N + n0 + n4);
        LAS float* d = scr + kk * 33 + n4; d[0] = v.x; d[1] = v.y; d[2] = v.z; d[3] = v.w; }
    LDS_WAIT(); asm volatile("" ::: "memory");
    const int c = lane & 7;
#pragma unroll
    for (int j = 0; j < 4; ++j) { const int n = (lane >> 3) + 8 * j; const LAS float* s = scr + (8 * c) * 33 + n;
        v4u o; o.x = pk2(s[0 * 33], s[1 * 33]); o.y = pk2(s[2 * 33], s[3 * 33]); o.z = pk2(s[4 * 33], s[5 * 33]); o.w = pk2(s[6 * 33], s[7 * 33]);
        *(v4u*)(WT + (size_t)(dst_row0 + n) * K + k0 + 8 * c) = o; }
    LDS_WAIT(); asm volatile("" ::: "memory");
}
__device__ __forceinline__ void p0_prologue(Frame& F, const Args& A) {
    LAS float* scr = (LAS float*)(F.lds + RING_OFF + F.wave * 16384);
    const int gw = F.vcu * NWAVES + F.wave, NGW = F.G * NWAVES;
    constexpr int I0 = 32 * 128, I1 = 32 * 64, I2 = 32 * 256, I3 = 32 * 64, IM = 2 * NEA * 1536;
    constexpr int NITEMS = I0 + I1 + I2 + I3 + IM;
    for (int it = gw; it < NITEMS; it += NGW) {
        int r = it;
        if (r < I0) { p0_transpose_item(A.in[5], 4096, 2048, (bf16*)(F.ws + WS_GIN), 64 * (r / 128), 32 * (r % 128), 32 * (r % 128), scr, F.lane); continue; } r -= I0;
        if (r < I1) { p0_transpose_item(A.in[10], 2048, 2048, (bf16*)(F.ws + WS_GOUT), 64 * (r / 64), 32 * (r % 64), 32 * (r % 64), scr, F.lane); continue; } r -= I1;
        if (r < I2) { p0_transpose_item(A.in[11], 8192, 2048, (bf16*)(F.ws + WS_HIN), 64 * (r / 256), 32 * (r % 256), 32 * (r % 256), scr, F.lane); continue; } r -= I2;
        if (r < I3) { p0_transpose_item(A.in[13], 2048, 2048, (bf16*)(F.ws + WS_HOUT), 64 * (r / 64), 32 * (r % 64), 32 * (r % 64), scr, F.lane); continue; } r -= I3;
        const int le = r / 1536, sub = r % 1536, l = le / NEA, e = le % NEA, part = sub / 512, idx = sub % 512;
        if (part < 2) {
            const float* W = e < NE ? (part == 0 ? A.in[17] : A.in[18]) + (size_t)(l * NE + e) * 2048 * 512 : (part == 0 ? A.in[20] : A.in[21]) + (size_t)l * 2048 * 512;
            const int kb = idx / 16, nb = idx % 16, n0 = 32 * nb;
            p0_transpose_item(W, 512, 2048, (bf16*)(F.ws + WS_W1 + l * W1_L + e * W1_E), 64 * kb, n0, (n0 / 128) * 256 + part * 128 + (n0 % 128), scr, F.lane);
        } else {
            const float* W = e < NE ? A.in[19] + (size_t)(l * NE + e) * 512 * 2048 : A.in[22] + (size_t)l * 512 * 2048;
            const int kb = idx / 64, nb = idx % 64;
            p0_transpose_item(W, 2048, 512, (bf16*)(F.ws + WS_W2 + l * W2_L + e * W2_E), 64 * kb, 32 * nb, 32 * nb, scr, F.lane);
        }
    }
    const size_t gt = (size_t)F.vcu * (NWAVES * 64) + F.tid, NT = (size_t)F.G * NWAVES * 64;
    { const f32x4* x4 = (const f32x4*)A.in[0]; v4u* o = (v4u*)(F.ws + WS_XINB);
      for (size_t i = gt; i < (size_t)T * D / 8; i += NT) { const f32x4 a = x4[2 * i], b = x4[2 * i + 1]; v4u w; w.x = pk2(a.x, a.y); w.y = pk2(a.z, a.w); w.z = pk2(b.x, b.y); w.w = pk2(b.z, b.w); o[i] = w; } }
    { float* lb = (float*)(F.ws + WS_LB); const float* hb = A.in[14];
      for (size_t i = gt; i < (size_t)D; i += NT) { const float a = hb[i], b = hb[D + i]; lb[i] = 1.0f / (1.0f + __expf(a - b)); } }
    { bf16* wo = (bf16*)(F.ws + WS_WSP); const float* wi = A.in[8];
      for (size_t i = gt; i < (size_t)NH * 128 * 128; i += NT) { const int ii = (int)((i >> 7) & 127), jj = (int)(i & 127); const float v = ((ii >> 6) >= (jj >> 6)) ? wi[i] : 0.0f; wo[i] = (bf16)f2bf(v); } }
    { bf16* wr = (bf16*)(F.ws + WS_WR); const float* wi = A.in[15];
      for (size_t i = gt; i < (size_t)2 * NE * D; i += NT) { const int l = (int)(i / (NE * D)), n = (int)((i / D) % NE), k = (int)(i % D);
          const float w = wi[(size_t)l * D * NE + (size_t)k * NE + n]; const unsigned hi = f2bf(w); const float lo = w - bf2f((unsigned short)hi);
          wr[((size_t)(l * 2 + 0) * NE + n) * D + k] = (bf16)hi; wr[((size_t)(l * 2 + 1) * NE + n) * D + k] = (bf16)f2bf(lo); } }
}

__device__ __forceinline__ void p_vstats(Frame& F) {
    const int gw = F.vcu * NWAVES + F.wave, NGW = F.G * NWAVES;
    const bf16* Z = (const bf16*)(F.ws + WS_Z); float* vst = (float*)(F.ws + WS_VST);
    for (int t = gw; t < T; t += NGW) {
        const v4u* p = (const v4u*)(Z + (size_t)t * 4096 + 2048) + F.lane;
        float v[32]; float s = 0.f;
#pragma unroll
        for (int j = 0; j < 4; ++j) { const v4u w = p[64 * j];
            v[8 * j + 0] = bflo(w.x); v[8 * j + 1] = bfhi(w.x); v[8 * j + 2] = bflo(w.y); v[8 * j + 3] = bfhi(w.y); v[8 * j + 4] = bflo(w.z); v[8 * j + 5] = bfhi(w.z); v[8 * j + 6] = bflo(w.w); v[8 * j + 7] = bfhi(w.w); }
#pragma unroll
        for (int i = 0; i < 32; ++i) s += v[i];
        const float mean = wave_sum(s) * (1.0f / 2048.0f); float q = 0.f;
#pragma unroll
        for (int i = 0; i < 32; ++i) { const float d = v[i] - mean; q += d * d; }
        const float rstd = 1.0f / sqrtf(wave_sum(q) * (1.0f / 2048.0f) + LN_EPS);
        if (F.lane == 0) { vst[2 * t] = mean; vst[2 * t + 1] = rstd; }
    }
}

__device__ __forceinline__ void p_spatial(Frame& F, const Args& A) {
    constexpr int PITCH = 272;
    const bf16* Z = (const bf16*)(F.ws + WS_Z); const float* vst = (const float*)(F.ws + WS_VST); const bf16* WSP = (const bf16*)(F.ws + WS_WSP); bf16* YG = (bf16*)(F.ws + WS_YG);
    const float* vg = A.in[6]; const float* vb = A.in[7]; const float* bsp = A.in[9];
    LAS unsigned char* img = F.lds + RING_OFF;
    const int r = F.lane & 15, q = F.lane >> 4, w = F.wave;
    for (int unit = F.vcu; unit < (T / 128) * NH; unit += F.G) {
        const int n = unit / NH, h = unit % NH, t0 = n * 128;
        __syncthreads();
#pragma unroll
        for (int it = 0; it < 4; ++it) { const int idx = F.tid + 512 * it, j = idx & 127, c8 = idx >> 7;
            const v4u raw = *(const v4u*)(Z + (size_t)(t0 + j) * 4096 + 2048 + h * 128 + c8 * 8);
            const float mean = vst[2 * (t0 + j)], rstd = vst[2 * (t0 + j) + 1];
            const f32x4 g0 = *(const f32x4*)(vg + h * 128 + c8 * 8), g1 = *(const f32x4*)(vg + h * 128 + c8 * 8 + 4), b0 = *(const f32x4*)(vb + h * 128 + c8 * 8), b1 = *(const f32x4*)(vb + h * 128 + c8 * 8 + 4);
            float x[8] = {bflo(raw.x), bfhi(raw.x), bflo(raw.y), bfhi(raw.y), bflo(raw.z), bfhi(raw.z), bflo(raw.w), bfhi(raw.w)};
            const float gg[8] = {g0.x, g0.y, g0.z, g0.w, g1.x, g1.y, g1.z, g1.w}, bb[8] = {b0.x, b0.y, b0.z, b0.w, b1.x, b1.y, b1.z, b1.w};
#pragma unroll
            for (int i = 0; i < 8; ++i) { const float y = (x[i] - mean) * rstd * gg[i] + bb[i]; *(LAS unsigned short*)(img + (c8 * 8 + i) * PITCH + j * 2) = (unsigned short)f2bf(y); } }
        __syncthreads();
        f32x4 acc[8];
#pragma unroll
        for (int ct = 0; ct < 8; ++ct) acc[ct] = (f32x4){0.f, 0.f, 0.f, 0.f};
        bf16x8 bw[4];
#pragma unroll
        for (int ks = 0; ks < 4; ++ks) bw[ks] = *(const bf16x8*)(WSP + ((size_t)h * 128 + 16 * w + r) * 128 + 32 * ks + 8 * q);
#pragma unroll
        for (int ct = 0; ct < 8; ++ct)
#pragma unroll
            for (int ks = 0; ks < 4; ++ks) { const bf16x8 a = *(const LAS bf16x8*)(img + (16 * ct + r) * PITCH + (32 * ks + 8 * q) * 2);
                acc[ct] = __builtin_amdgcn_mfma_f32_16x16x32_bf16(a, bw[ks], acc[ct], 0, 0, 0); }
        const int tok = t0 + 16 * w + r; const float bias = bsp[h * 128 + 16 * w + r];
#pragma unroll
        for (int ct = 0; ct < 8; ++ct) { const int col = h * 128 + 16 * ct + 4 * q;
            const v2u uu = *(const v2u*)(Z + (size_t)tok * 4096 + col);
            v2u o; o.x = pk2((acc[ct][0] + bias) * bflo(uu.x), (acc[ct][1] + bias) * bfhi(uu.x)); o.y = pk2((acc[ct][2] + bias) * bflo(uu.y), (acc[ct][3] + bias) * bfhi(uu.y));
            *(v2u*)(YG + (size_t)tok * D + col) = o; }
    }
    __syncthreads();
}

__device__ __forceinline__ void p_ln_router(Frame& F, const Args& A, const float* rin, const float* lg, const float* lbias, float* xf, bf16* xb, int layer) {
    const int gw = F.vcu * NWAVES + F.wave, NGW = F.G * NWAVES;
    const bf16* WRh = (const bf16*)(F.ws + WS_WR) + (size_t)(layer * 2 + 0) * NE * D; const bf16* WRl = (const bf16*)(F.ws + WS_WR) + (size_t)(layer * 2 + 1) * NE * D;
    const float* ebias = A.in[16] + layer * NE;
    unsigned* cnt = F.ctl + CW_CNT + layer * NE * CNT_STRIDE;
    unsigned* list = (unsigned*)(F.ws + WS_LIST); unsigned* aes = (unsigned*)(F.ws + WS_AES); float* aw = (float*)(F.ws + WS_AW);
    LAS float* Ls = (LAS float*)(F.lds + RING_OFF + F.wave * 8448); LAS float* Lc = Ls + 16 * 65;
    const int r = F.lane & 15, q = F.lane >> 4;
    for (int wt = gw; wt < T / 16; wt += NGW) {
        const int row = wt * 16 + r;
        const float* rp = rin + (size_t)row * D + 8 * q;
        float s = 0.f, ss = 0.f;
#pragma unroll 8
        for (int j = 0; j < 64; ++j) { const f32x4 a = *(const f32x4*)(rp + 32 * j), b = *(const f32x4*)(rp + 32 * j + 4);
            s += (a.x + a.y) + (a.z + a.w) + (b.x + b.y) + (b.z + b.w); ss += (a.x * a.x + a.y * a.y) + (a.z * a.z + a.w * a.w) + (b.x * b.x + b.y * b.y) + (b.z * b.z + b.w * b.w); }
        s += __shfl_xor(s, 16); s += __shfl_xor(s, 32); ss += __shfl_xor(ss, 16); ss += __shfl_xor(ss, 32);
        const float mean = s * (1.0f / D); const float var = fmaxf(ss * (1.0f / D) - mean * mean, 0.f); const float rstd = 1.0f / sqrtf(var + LN_EPS);
        f32x4 acc[4];
#pragma unroll
        for (int nt = 0; nt < 4; ++nt) acc[nt] = (f32x4){0.f, 0.f, 0.f, 0.f};
#pragma unroll 2
        for (int j = 0; j < 64; ++j) { const int c0 = 32 * j + 8 * q;
            const f32x4 a = *(const f32x4*)(rp + 32 * j), b = *(const f32x4*)(rp + 32 * j + 4);
            const f32x4 g0 = *(const f32x4*)(lg + c0), g1 = *(const f32x4*)(lg + c0 + 4), b0 = *(const f32x4*)(lbias + c0), b1 = *(const f32x4*)(lbias + c0 + 4);
            const f32x4 y0 = (a - mean) * rstd * g0 + b0, y1 = (b - mean) * rstd * g1 + b1;
            *(f32x4*)(xf + (size_t)row * D + c0) = y0; *(f32x4*)(xf + (size_t)row * D + c0 + 4) = y1;
            unsigned hi[4], lo[4];
            hi[0] = pk2(y0.x, y0.y); hi[1] = pk2(y0.z, y0.w); hi[2] = pk2(y1.x, y1.y); hi[3] = pk2(y1.z, y1.w);
            lo[0] = pk2(y0.x - bflo(hi[0]), y0.y - bfhi(hi[0])); lo[1] = pk2(y0.z - bflo(hi[1]), y0.w - bfhi(hi[1])); lo[2] = pk2(y1.x - bflo(hi[2]), y1.y - bfhi(hi[2])); lo[3] = pk2(y1.z - bflo(hi[3]), y1.w - bfhi(hi[3]));
            v4u hv; hv.x = hi[0]; hv.y = hi[1]; hv.z = hi[2]; hv.w = hi[3]; v4u lv; lv.x = lo[0]; lv.y = lo[1]; lv.z = lo[2]; lv.w = lo[3];
            *(v4u*)(xb + (size_t)row * D + c0) = hv;
            const bf16x8 ah = __builtin_bit_cast(bf16x8, hv), al = __builtin_bit_cast(bf16x8, lv);
#pragma unroll
            for (int nt = 0; nt < 4; ++nt) { const bf16x8 bh = *(const bf16x8*)(WRh + (size_t)(16 * nt + r) * D + c0), bl = *(const bf16x8*)(WRl + (size_t)(16 * nt + r) * D + c0);
                acc[nt] = __builtin_amdgcn_mfma_f32_16x16x32_bf16(ah, bh, acc[nt], 0, 0, 0);
                acc[nt] = __builtin_amdgcn_mfma_f32_16x16x32_bf16(al, bh, acc[nt], 0, 0, 0);
                acc[nt] = __builtin_amdgcn_mfma_f32_16x16x32_bf16(ah, bl, acc[nt], 0, 0, 0); } }
#pragma unroll
        for (int nt = 0; nt < 4; ++nt)
#pragma unroll
            for (int i = 0; i < 4; ++i) Ls[(4 * q + i) * 65 + 16 * nt + r] = acc[nt][i];
        LDS_WAIT(); asm volatile("" ::: "memory");
        if (F.lane < 16) {
            const int tk = F.lane, token = wt * 16 + tk;
            LAS float* ps = Ls + tk * 65; LAS float* pc = Lc + tk * 65;
            float gs[8];
#pragma unroll
            for (int g = 0; g < 8; ++g) { float m1 = -INFINITY, m2 = -INFINITY;
#pragma unroll
                for (int i = 0; i < 8; ++i) { const int e = 8 * g + i; const float sg = 1.0f / (1.0f + __expf(-ps[e])); const float c = sg + ebias[e]; ps[e] = sg; pc[e] = c;
                    if (c > m1) { m2 = m1; m1 = c; } else if (c > m2) m2 = c; }
                gs[g] = m1 + m2; }
            unsigned allowed = 0u;
#pragma unroll
            for (int k = 0; k < 4; ++k) { float best = -INFINITY; int bi = 0;
#pragma unroll
                for (int g = 0; g < 8; ++g) { const bool ok = !((allowed >> g) & 1u) && (gs[g] > best); best = ok ? gs[g] : best; bi = ok ? g : bi; }
                allowed |= 1u << bi; }
            int sel[8]; float sw[8]; float ssum = 0.f;
#pragma unroll
            for (int k = 0; k < 8; ++k) { float best = -INFINITY; int be = 0;
                for (int e = 0; e < 64; ++e) { const float c = pc[e]; const bool ok = ((allowed >> (e >> 3)) & 1u) && (c > best); best = ok ? c : best; be = ok ? e : be; }
                sel[k] = be; pc[be] = -INFINITY; sw[k] = ps[be]; ssum += sw[k]; }
            const float inv = ROUTED_SCALE / ssum;
#pragma unroll
            for (int k = 0; k < 8; ++k) { const int e = sel[k];
                const unsigned slot = __hip_atomic_fetch_add(cnt + e * CNT_STRIDE, 1u, __ATOMIC_RELAXED, __HIP_MEMORY_SCOPE_AGENT);
                list[(size_t)e * 16384 + slot] = (unsigned)token; aes[(size_t)token * 8 + k] = ((unsigned)e << 16) | slot; aw[(size_t)token * 8 + k] = sw[k] * inv; }
        }
        LDS_WAIT(); asm volatile("" ::: "memory");
    }
}

__device__ __forceinline__ void moe_tables(Frame& F, int layer, int NPN) {
    LAS int* lc = (LAS int*)(F.lds + LT_CNT); LAS int* rb = (LAS int*)(F.lds + LT_RB); LAS int* tab = (LAS int*)(F.lds + LT_UNITS); LAS int* nun = (LAS int*)(F.lds + LT_NUNITS);
    const unsigned* cnt = F.ctl + CW_CNT + layer * NE * CNT_STRIDE;
    __syncthreads();
    if (F.tid < NEA) lc[F.tid] = F.tid < NE ? (int)__hip_atomic_load(cnt + F.tid * CNT_STRIDE, __ATOMIC_RELAXED, __HIP_MEMORY_SCOPE_AGENT) : T;
    __syncthreads();
    if (F.tid == 0) {
        int run = 0, tiles = 0;
        for (int e = 0; e < NEA; ++e) { const int c = lc[e]; rb[e] = run; run += c; tiles += (c + 255) >> 8; }
        rb[NEA] = run;
        int n = 0;
        if (NPN > 0) {
            const int total = tiles * NPN, qq = total / 8, rr = total % 8;
            for (int i = 0; i < 64; ++i) {
                const long L = (long)i * F.G + (int)blockIdx.x; if (L >= total) break;
                const int xcd = (int)(L % 8), off = (int)(L / 8);
                const int up = (xcd < rr ? xcd * (qq + 1) : rr * (qq + 1) + (xcd - rr) * qq) + off;
                const int rt = up / NPN, pn = up % NPN;
                int e = 0, a = 0;
                for (; e < NEA - 1; ++e) { const int te = (lc[e] + 255) >> 8; if (rt < a + te) break; a += te; }
                const int mt = rt - a, c = lc[e];
                tab[5 * n + 0] = e; tab[5 * n + 1] = mt; tab[5 * n + 2] = pn; tab[5 * n + 3] = (c - mt * 256) < 256 ? (c - mt * 256) : 256; tab[5 * n + 4] = rb[e] + mt * 256; ++n;
            }
        }
        nun[0] = n;
    }
    __syncthreads();
}

__device__ __forceinline__ void p_combine_ln(Frame& F, const float* xres, const float* lg, const float* lbias, float* of, bf16* ob, int layer) {
    moe_tables(F, layer, 0);
    const LAS int* rb = (const LAS int*)(F.lds + LT_RB);
    const int gw = F.vcu * NWAVES + F.wave, NGW = F.G * NWAVES;
    const bf16* Y = (const bf16*)(F.ws + WS_RA); const unsigned* aes = (const unsigned*)(F.ws + WS_AES); const float* aw = (const float*)(F.ws + WS_AW);
    for (int t = gw; t < T; t += NGW) {
        int ln = F.lane; OPAQUE(ln);
        unsigned es = 0u; float wv = 0.f;
        if (F.lane < 8) { es = aes[(size_t)t * 8 + F.lane]; wv = aw[(size_t)t * 8 + F.lane]; }
        int rowk[9]; float wk[9];
#pragma unroll
        for (int k = 0; k < 8; ++k) { const unsigned x = (unsigned)__shfl((int)es, k); wk[k] = __shfl(wv, k); rowk[k] = rb[x >> 16] + (int)(x & 0xffffu); }
        rowk[8] = T * TOPK + t; wk[8] = 1.0f;
        float v[32];
#pragma unroll
        for (int jj = 0; jj < 4; ++jj) { const int c0 = 512 * jj + 8 * ln;
            const f32x4 a = *(const f32x4*)(xres + (size_t)t * D + c0), b = *(const f32x4*)(xres + (size_t)t * D + c0 + 4);
            v[8 * jj + 0] = ALPHA * a.x; v[8 * jj + 1] = ALPHA * a.y; v[8 * jj + 2] = ALPHA * a.z; v[8 * jj + 3] = ALPHA * a.w; v[8 * jj + 4] = ALPHA * b.x; v[8 * jj + 5] = ALPHA * b.y; v[8 * jj + 6] = ALPHA * b.z; v[8 * jj + 7] = ALPHA * b.w; }
#pragma unroll
        for (int k = 0; k < 9; ++k) { const bf16* yr = Y + (size_t)rowk[k] * D + 8 * ln; const float w = wk[k];
#pragma unroll
            for (int jj = 0; jj < 4; ++jj) { const v4u p = *(const v4u*)(yr + 512 * jj);
                v[8 * jj + 0] += w * bflo(p.x); v[8 * jj + 1] += w * bfhi(p.x); v[8 * jj + 2] += w * bflo(p.y); v[8 * jj + 3] += w * bfhi(p.y); v[8 * jj + 4] += w * bflo(p.z); v[8 * jj + 5] += w * bfhi(p.z); v[8 * jj + 6] += w * bflo(p.w); v[8 * jj + 7] += w * bfhi(p.w); }
            if ((k % 3) == 2) asm volatile("" ::: "memory"); }
        float s = 0.f;
#pragma unroll
        for (int i = 0; i < 32; ++i) s += v[i];
        const float mean = wave_sum(s) * (1.0f / D); float qv = 0.f;
#pragma unroll
        for (int i = 0; i < 32; ++i) { const float d = v[i] - mean; qv += d * d; }
        const float rstd = 1.0f / sqrtf(wave_sum(qv) * (1.0f / D) + LN_EPS);
#pragma unroll
        for (int jj = 0; jj < 4; ++jj) { const int c0 = 512 * jj + 8 * ln;
            const f32x4 g0 = *(const f32x4*)(lg + c0), g1 = *(const f32x4*)(lg + c0 + 4), b0 = *(const f32x4*)(lbias + c0), b1 = *(const f32x4*)(lbias + c0 + 4);
            f32x4 y0, y1;
            y0.x = (v[8 * jj + 0] - mean) * rstd * g0.x + b0.x; y0.y = (v[8 * jj + 1] - mean) * rstd * g0.y + b0.y; y0.z = (v[8 * jj + 2] - mean) * rstd * g0.z + b0.z; y0.w = (v[8 * jj + 3] - mean) * rstd * g0.w + b0.w;
            y1.x = (v[8 * jj + 4] - mean) * rstd * g1.x + b1.x; y1.y = (v[8 * jj + 5] - mean) * rstd * g1.y + b1.y; y1.z = (v[8 * jj + 6] - mean) * rstd * g1.z + b1.z; y1.w = (v[8 * jj + 7] - mean) * rstd * g1.w + b1.w;
            *(f32x4*)(of + (size_t)t * D + c0) = y0; *(f32x4*)(of + (size_t)t * D + c0 + 4) = y1;
            if (ob) { v4u w; w.x = pk2(y0.x, y0.y); w.y = pk2(y0.z, y0.w); w.z = pk2(y1.x, y1.y); w.w = pk2(y1.z, y1.w); *(v4u*)(ob + (size_t)t * D + c0) = w; } }
    }
}

__device__ __forceinline__ int kslot(int k) { const int kk = k & 31; return (k & ~31) + 8 * ((kk & 15) >> 2) + 4 * (kk >> 4) + (kk & 3); }
__device__ __forceinline__ bf16x8 pack8(const f32x4& a, const f32x4& b) { v4u w; w.x = pk2(a[0], a[1]); w.y = pk2(a[2], a[3]); w.z = pk2(b[0], b[1]); w.w = pk2(b[2], b[3]); return __builtin_bit_cast(bf16x8, w); }
__device__ __forceinline__ void p_hgrn_intra(Frame& F) {
    const bf16* Q = (const bf16*)(F.ws + WS_HQ); const bf16* Kk = (const bf16*)(F.ws + WS_HK); const bf16* V = (const bf16*)(F.ws + WS_HV); const float* LF = (const float*)(F.ws + WS_HF);
    bf16* QD = (bf16*)(F.ws + WS_HQD); bf16* UT = (bf16*)(F.ws + WS_HUT); float* OI = (float*)(F.ws + WS_HOI); float* DT = (float*)(F.ws + WS_HDT);
    LAS unsigned char* L = F.lds + RING_OFF;
    constexpr int O_KDT = 0, O_VT = 18432, O_KH = 36864, O_QIJ = 54272, O_QST = 97792, O_GT = 114176, PC = 144, PT = 272;
    const int k = F.tid & 127, tq = __builtin_amdgcn_readfirstlane(F.tid >> 7), r = F.lane & 15, q = F.lane >> 4, w = F.wave;
    const int ks_ = kslot(k);
    for (int u = F.vcu; u < NB * NH * 64; u += F.G) {
        const int bh = u >> 6, c = u & 63, b = bh >> 4, h = bh & 15, t0 = b * SEQ + c * 64;
        const size_t base = (size_t)(t0 + 16 * tq) * D + h * HD + k;
        float Bl[16], qv[16], kv[16]; unsigned vv[8]; float run = 0.f;
#pragma unroll
        for (int i = 0; i < 16; ++i) { run += LF[base + (size_t)i * D]; Bl[i] = run; }
#pragma unroll
        for (int i = 0; i < 16; ++i) { qv[i] = bf2f(Q[base + (size_t)i * D]); kv[i] = bf2f(Kk[base + (size_t)i * D]); }
#pragma unroll
        for (int i = 0; i < 8; ++i) vv[i] = (unsigned)V[base + (size_t)(2 * i) * D] | ((unsigned)V[base + (size_t)(2 * i + 1) * D] << 16);
        __syncthreads();
        ((LAS float*)(L + O_GT))[tq * 128 + k] = run;
        __syncthreads();
        const float g0 = ((LAS float*)(L + O_GT))[k], g1 = ((LAS float*)(L + O_GT))[128 + k], g2 = ((LAS float*)(L + O_GT))[256 + k], g3 = ((LAS float*)(L + O_GT))[384 + k];
        const float Rq = (tq > 0 ? g0 : 0.f) + (tq > 1 ? g1 : 0.f) + (tq > 2 ? g2 : 0.f), Btot = (g0 + g1) + (g2 + g3);
        { unsigned kd[8];
#pragma unroll
          for (int i = 0; i < 8; ++i) kd[i] = pk2(kv[2 * i] * __expf(Btot - Rq - Bl[2 * i]), kv[2 * i + 1] * __expf(Btot - Rq - Bl[2 * i + 1]));
          LAS v4u* pk_ = (LAS v4u*)(L + O_KDT + k * PC + 32 * tq); v4u a; a.x = kd[0]; a.y = kd[1]; a.z = kd[2]; a.w = kd[3]; pk_[0] = a; a.x = kd[4]; a.y = kd[5]; a.z = kd[6]; a.w = kd[7]; pk_[1] = a;
          LAS v4u* pv_ = (LAS v4u*)(L + O_VT + k * PC + 32 * tq); a.x = vv[0]; a.y = vv[1]; a.z = vv[2]; a.w = vv[3]; pv_[0] = a; a.x = vv[4]; a.y = vv[5]; a.z = vv[6]; a.w = vv[7]; pv_[1] = a; }
        { const float eR = __expf(Rq);
          const float f0 = __expf(Rq), f1 = __expf(Rq - g0), f2 = __expf(Rq - g0 - g1);
#pragma unroll
          for (int i = 0; i < 16; ++i) { const float eb = __expf(Bl[i]), qt = qv[i] * eb, kh = kv[i] * __expf(fminf(-Bl[i], 80.f));
              *(LAS unsigned short*)(L + O_KH + (16 * tq + i) * PT + k * 2) = (unsigned short)f2bf(kh);
              *(LAS unsigned short*)(L + O_QST + (16 * tq + i) * 256 + ks_ * 2) = (unsigned short)f2bf(qt * eR);
              const int blk0 = tq * (tq + 1) / 2;
              *(LAS unsigned short*)(L + O_QIJ + (blk0 + tq) * (16 * PT) + i * PT + k * 2) = (unsigned short)f2bf(qt);
              if (tq > 0) *(LAS unsigned short*)(L + O_QIJ + (blk0 + 0) * (16 * PT) + i * PT + k * 2) = (unsigned short)f2bf(qt * f0);
              if (tq > 1) *(LAS unsigned short*)(L + O_QIJ + (blk0 + 1) * (16 * PT) + i * PT + k * 2) = (unsigned short)f2bf(qt * f1);
              if (tq > 2) *(LAS unsigned short*)(L + O_QIJ + (blk0 + 2) * (16 * PT) + i * PT + k * 2) = (unsigned short)f2bf(qt * f2); }
          if (tq == 0) DT[(size_t)u * 128 + ks_] = __expf(Btot); }
        __syncthreads();
        { const LAS v4u* src = (const LAS v4u*)(L + O_QST) + 2 * F.tid; v4u* dst = (v4u*)(QD + (size_t)u * 64 * 128) + 2 * F.tid; const v4u a = src[0], bq = src[1]; dst[0] = a; dst[1] = bq; }
        { f32x4 aU[8];
#pragma unroll
          for (int a = 0; a < 8; ++a) aU[a] = (f32x4){0.f, 0.f, 0.f, 0.f};
#pragma unroll
          for (int ts = 0; ts < 2; ++ts) { const bf16x8 bv = *(const LAS bf16x8*)(L + O_VT + (16 * w + r) * PC + (32 * ts + 8 * q) * 2);
#pragma unroll
              for (int a = 0; a < 8; ++a) { const bf16x8 av = *(const LAS bf16x8*)(L + O_KDT + (16 * a + r) * PC + (32 * ts + 8 * q) * 2); aU[a] = __builtin_amdgcn_mfma_f32_16x16x32_bf16(av, bv, aU[a], 0, 0, 0); } }
#pragma unroll
          for (int ks = 0; ks < 4; ++ks) *(bf16x8*)(UT + ((size_t)u * 128 + 16 * w + r) * 128 + 32 * ks + 8 * q) = pack8(aU[2 * ks], aU[2 * ks + 1]); }
#pragma unroll
        for (int i = 0; i < 4; ++i) {
            f32x4 pT[4];
#pragma unroll
            for (int j = 0; j < 4; ++j) { pT[j] = (f32x4){0.f, 0.f, 0.f, 0.f};
                if (j <= i) {
#pragma unroll
                    for (int ks = 0; ks < 4; ++ks) { const bf16x8 av = *(const LAS bf16x8*)(L + O_KH + (16 * j + r) * PT + (32 * ks + 8 * q) * 2);
                        const bf16x8 bv = *(const LAS bf16x8*)(L + O_QIJ + (i * (i + 1) / 2 + j) * (16 * PT) + r * PT + (32 * ks + 8 * q) * 2);
                        pT[j] = __builtin_amdgcn_mfma_f32_16x16x32_bf16(av, bv, pT[j], 0, 0, 0); }
                    if (j == i) {
#pragma unroll
                        for (int e = 0; e < 4; ++e) pT[j][e] = (4 * q + e <= r) ? pT[j][e] : 0.f; } } }
            f32x4 o = (f32x4){0.f, 0.f, 0.f, 0.f};
#pragma unroll
            for (int pr = 0; pr < 2; ++pr) if (2 * pr <= i) {
                const bf16x8 av = pack8(pT[2 * pr], pT[2 * pr + 1]);
                const v2u blo = *(const LAS v2u*)(L + O_VT + (16 * w + r) * PC + (32 * pr + 4 * q) * 2), bhi = *(const LAS v2u*)(L + O_VT + (16 * w + r) * PC + (32 * pr + 16 + 4 * q) * 2);
                v4u bw; bw.x = blo.x; bw.y = blo.y; bw.z = bhi.x; bw.w = bhi.y;
                o = __builtin_amdgcn_mfma_f32_16x16x32_bf16(av, __builtin_bit_cast(bf16x8, bw), o, 0, 0, 0); }
            *(f32x4*)(OI + (((size_t)u * 8 + w) * 4 + i) * 256 + F.lane * 4) = o;
        }
    }
    __syncthreads();
}
#define LBAR() asm volatile("s_waitcnt lgkmcnt(0)\n\ts_barrier" ::: "memory")
__device__ __forceinline__ void p_hgrn_scan(Frame& F, const Args& A) {
    const bf16* QD = (const bf16*)(F.ws + WS_HQD); const bf16* UT = (const bf16*)(F.ws + WS_HUT); const float* OI = (const float*)(F.ws + WS_HOI); const float* DT = (const float*)(F.ws + WS_HDT);
    const bf16* Gt = (const bf16*)(F.ws + WS_HG); bf16* O = (bf16*)(F.ws + WS_HO); const float* normg = A.in[12];
    constexpr int PT = 272, TILE = 64 * PT, O_Q = 0, O_G = 2 * TILE, O_O = 4 * TILE, O_D = 5 * TILE, O_S = O_D + 1024;
    LAS unsigned char* L = F.lds + RING_OFF;
    const int r = F.lane & 15, q = F.lane >> 4, w = F.wave, row = F.tid >> 3, seg = F.tid & 7;
    for (int unit = (int)blockIdx.x; unit < NB * NH; unit += F.G) {
        const int b = unit / NH, h = unit % NH;
        float S[4][8];
#pragma unroll
        for (int ks = 0; ks < 4; ++ks)
#pragma unroll
            for (int e = 0; e < 8; ++e) S[ks][e] = 0.f;
        const float ng = normg[16 * w + r];
        v4u pQ[2], pG[2], pU[4]; f32x4 pO[4]; float pD = 0.f;
#define SCAN_LOAD(cc) do { const size_t u_ = (size_t)unit * 64 + (cc); const int t0_ = b * SEQ + (cc) * 64; \
            const v4u* q_ = (const v4u*)(QD + (u_ * 64 + row) * 128 + seg * 16); pQ[0] = q_[0]; pQ[1] = q_[1]; \
            const v4u* g_ = (const v4u*)(Gt + (size_t)(t0_ + row) * D + h * HD + seg * 16); pG[0] = g_[0]; pG[1] = g_[1]; \
            _Pragma("unroll") for (int ti = 0; ti < 4; ++ti) pO[ti] = *(const f32x4*)(OI + ((u_ * 8 + w) * 4 + ti) * 256 + F.lane * 4); \
            _Pragma("unroll") for (int ks = 0; ks < 4; ++ks) pU[ks] = *(const v4u*)(UT + (u_ * 128 + 16 * w + r) * 128 + 32 * ks + 8 * q); \
            if (F.tid < 128) pD = DT[u_ * 128 + F.tid]; } while (0)
#define SCAN_STORE(cc) do { const LAS v4u* so_ = (const LAS v4u*)(L + O_O + row * PT + seg * 32); const v4u a0_ = so_[0], a1_ = so_[1]; \
            v4u* dst_ = (v4u*)(O + (size_t)(b * SEQ + (cc) * 64 + row) * D + h * HD + seg * 16); dst_[0] = a0_; dst_[1] = a1_; } while (0)
        SCAN_LOAD(0);
        for (int c = 0; c < 64; ++c) {
            const int par = c & 1;
            { LAS v4u* dq = (LAS v4u*)(L + O_Q + par * TILE + row * PT + seg * 32); dq[0] = pQ[0]; dq[1] = pQ[1];
              LAS v4u* dg = (LAS v4u*)(L + O_G + par * TILE + row * PT + seg * 32); dg[0] = pG[0]; dg[1] = pG[1];
              if (F.tid < 128) ((LAS float*)(L + O_D + par * 512))[F.tid] = pD; }
            f32x4 o[4]; v4u uu[4];
#pragma unroll
            for (int i = 0; i < 4; ++i) { o[i] = pO[i]; uu[i] = pU[i]; }
            if (c + 1 < 64) SCAN_LOAD(c + 1);
            LBAR();
            if (c > 0) SCAN_STORE(c - 1);
            bf16x8 sb[4];
#pragma unroll
            for (int ks = 0; ks < 4; ++ks) { v4u x; x.x = pk2(S[ks][0], S[ks][1]); x.y = pk2(S[ks][2], S[ks][3]); x.z = pk2(S[ks][4], S[ks][5]); x.w = pk2(S[ks][6], S[ks][7]); sb[ks] = __builtin_bit_cast(bf16x8, x); }
#pragma unroll
            for (int ti = 0; ti < 4; ++ti)
#pragma unroll
                for (int ks = 0; ks < 4; ++ks) { const bf16x8 av = *(const LAS bf16x8*)(L + O_Q + par * TILE + (16 * ti + r) * PT + (32 * ks + 8 * q) * 2); o[ti] = __builtin_amdgcn_mfma_f32_16x16x32_bf16(av, sb[ks], o[ti], 0, 0, 0); }
#pragma unroll
            for (int ks = 0; ks < 4; ++ks) { const f32x4 d0 = *(const LAS f32x4*)(L + O_D + par * 512 + (32 * ks + 8 * q) * 4), d1 = *(const LAS f32x4*)(L + O_D + par * 512 + (32 * ks + 8 * q + 4) * 4);
                S[ks][0] = d0.x * S[ks][0] + bflo(uu[ks].x); S[ks][1] = d0.y * S[ks][1] + bfhi(uu[ks].x); S[ks][2] = d0.z * S[ks][2] + bflo(uu[ks].y); S[ks][3] = d0.w * S[ks][3] + bfhi(uu[ks].y);
                S[ks][4] = d1.x * S[ks][4] + bflo(uu[ks].z); S[ks][5] = d1.y * S[ks][5] + bfhi(uu[ks].z); S[ks][6] = d1.z * S[ks][6] + bflo(uu[ks].w); S[ks][7] = d1.w * S[ks][7] + bfhi(uu[ks].w); }
            LAS float* ls = (LAS float*)(L + O_S);
#pragma unroll
            for (int ti = 0; ti < 4; ++ti)
#pragma unroll
                for (int e = 0; e < 4; ++e) { float x = o[ti][e] * o[ti][e]; x += DPP_F(x, 0xB1); x += DPP_F(x, 0x4E); x += DPP_F(x, 0x141); x += DPP_F(x, 0x140);
                    if (r == 0) ls[(16 * ti + 4 * q + e) * 8 + w] = x; }
            LBAR();
#pragma unroll
            for (int ti = 0; ti < 4; ++ti)
#pragma unroll
                for (int e = 0; e < 4; ++e) { const int t = 16 * ti + 4 * q + e; const f32x4 p0 = *(const LAS f32x4*)(ls + t * 8), p1 = *(const LAS f32x4*)(ls + t * 8 + 4);
                    const float ms = ((p0.x + p0.y) + (p0.z + p0.w) + (p1.x + p1.y) + (p1.z + p1.w)) * (1.0f / HD); const float rr = 1.0f / sqrtf(ms + LN_EPS);
                    const float g = bf2f(*(const LAS unsigned short*)(L + O_G + par * TILE + t * PT + (16 * w + r) * 2));
                    *(LAS unsigned short*)(L + O_O + t * PT + (16 * w + r) * 2) = (unsigned short)f2bf(o[ti][e] * rr * ng * g); }
        }
        LBAR();
        SCAN_STORE(63);
        LBAR();
#undef SCAN_LOAD
#undef SCAN_STORE
    }
    __syncthreads();
}

__global__ void __launch_bounds__(NWAVES * 64, 2) mk_fwd(Args args) {
    extern __shared__ __attribute__((aligned(16))) unsigned char lds[];
    Frame F;
    F.lds = (LAS unsigned char*)lds;
    F.tid = threadIdx.x; F.lane = F.tid & 63; F.wave = __builtin_amdgcn_readfirstlane(F.tid >> 6);
    F.G = gridDim.x; { const int bx = blockIdx.x; F.vcu = (F.G % 8 == 0) ? (bx % 8) * (F.G / 8) + bx / 8 : bx; }
    F.ws = args.ws; F.ctl = (unsigned*)(args.ws + WS_CTL);
    const Args& A = args;
    for (int u = F.tid; u < (LDS_BYTES - LDSCTL_OFF) / 4; u += NWAVES * 64) ((LAS unsigned*)(F.lds + LDSCTL_OFF))[u] = 0u;
    __syncthreads();
    XcdBarrier bar; bar.bar = F.ctl + CW_BAR; bar.x = 0; bar.st = nullptr;
    if (N_LAUNCHES == 1) bar = xcd_barrier_post(F.ctl + CW_BAR, (volatile LAS unsigned*)(F.lds + MISC_OFF) + 8);
    const int lo = args.ph_lo, hi = args.ph_hi;
#ifndef PH_MASK
#define PH_MASK 0x1FFFF
#endif
#define IN(k) (((PH_MASK >> (k)) & 1) && lo <= (k) && (k) < hi)
#define SEAM(k) do { if (IN(k) && IN((k) + 1)) xcd_barrier(bar); } while (0)
#ifndef PH_DUP
#define PH_DUP 0
#endif
#define DUPN(k) ((PH_DUP >> (k)) & 1)
#define REP(k, body) { body; if (DUPN(k)) { xcd_barrier(bar); F.refresh(); body; } }
    unsigned char* ws = args.ws;
    LAS unsigned char* ring = F.lds + RING_OFF;

    if (IN(0)) { F.refresh(); REP(0, p0_prologue(F, A)) SEAM(0); }
    if (IN(1)) { F.refresh();
        pg8::DenseOrder S; S.init(ws + WS_XINB, ws + WS_GIN, T, 2 * D, D, F.G, (int)blockIdx.x);
        pg8::EpiGelu E{(bf16*)(ws + WS_Z), 2 * D};
        pg8::gemm_phase<pg8::EpiGelu, pg8::DenseOrder, true, true>(ring, D, S, E);
        SEAM(1);
    }
    if (IN(2)) { F.refresh(); REP(2, p_vstats(F)) SEAM(2); }
    if (IN(3)) { F.refresh(); REP(3, p_spatial(F, A)) SEAM(3); }
    if (IN(4)) { F.refresh();
        pg8::DenseOrder S; S.init(ws + WS_YG, ws + WS_GOUT, T, D, D, F.G, (int)blockIdx.x);
        pg8::EpiRes E{A.in[0], (float*)(ws + WS_XR), D, ALPHA};
        pg8::gemm_phase<pg8::EpiRes, pg8::DenseOrder, true, true>(ring, D, S, E);
        SEAM(4);
    }
    if (IN(5)) { F.refresh(); p_ln_router(F, A, (const float*)(ws + WS_XR), A.in[1], A.in[2], (float*)(ws + WS_XA), (bf16*)(ws + WS_XB), 0); SEAM(5); }
    if (IN(6)) { F.refresh();
        moe_tables(F, 0, 4);
        pg8::MoeOrder<true> S{(const LAS int*)(F.lds + LT_UNITS), *(const LAS int*)(F.lds + LT_NUNITS), (const char*)(ws + WS_XB), (const char*)(ws + WS_W1), W1_E, D, (const unsigned*)(ws + WS_LIST)};
        pg8::EpiMoe1 E{(bf16*)(ws + WS_HM)};
        pg8::gemm_phase<pg8::EpiMoe1, pg8::MoeOrder<true>, true, true>(ring, D, S, E);
        SEAM(6);
    }
    if (IN(7)) { F.refresh();
        moe_tables(F, 0, 8);
        pg8::MoeOrder<false> S{(const LAS int*)(F.lds + LT_UNITS), *(const LAS int*)(F.lds + LT_NUNITS), (const char*)(ws + WS_HM), (const char*)(ws + WS_W2), W2_E, EXD, nullptr};
        pg8::EpiMoe2 E{(bf16*)(ws + WS_RA), D};
        pg8::gemm_phase<pg8::EpiMoe2, pg8::MoeOrder<false>, true, true>(ring, EXD, S, E);
        SEAM(7);
    }
    if (IN(8)) { F.refresh(); REP(8, p_combine_ln(F, (const float*)(ws + WS_XA), A.in[3], A.in[4], (float*)(ws + WS_XR), (bf16*)(ws + WS_XB), 0)) SEAM(8); }
    if (IN(9)) { F.refresh();
        pg8::DenseOrder S; S.init(ws + WS_XB, ws + WS_HIN, T, 4 * D, D, F.G, (int)blockIdx.x);
        pg8::EpiHgrn E{(bf16*)(ws + WS_HQ), (bf16*)(ws + WS_HK), (bf16*)(ws + WS_HV), (bf16*)(ws + WS_HG), (float*)(ws + WS_HF), (const float*)(ws + WS_LB), D};
        pg8::gemm_phase<pg8::EpiHgrn, pg8::DenseOrder, true, true>(ring, D, S, E);
        SEAM(9);
    }
    if (IN(10)) { F.refresh(); REP(10, p_hgrn_intra(F)) SEAM(10); }
    if (IN(11)) { F.refresh(); REP(11, p_hgrn_scan(F, A)) SEAM(11); }
    if (IN(12)) { F.refresh();
        pg8::DenseOrder S; S.init(ws + WS_HO, ws + WS_HOUT, T, D, D, F.G, (int)blockIdx.x);
        pg8::EpiRes E{(const float*)(ws + WS_XR), (float*)(ws + WS_XA), D, ALPHA};
        pg8::gemm_phase<pg8::EpiRes, pg8::DenseOrder, true, true>(ring, D, S, E);
        SEAM(12);
    }
    if (IN(13)) { F.refresh(); p_ln_router(F, A, (const float*)(ws + WS_XA), A.in[1] + D, A.in[2] + D, (float*)(ws + WS_XR), (bf16*)(ws + WS_XB), 1); SEAM(13); }
    if (IN(14)) { F.refresh();
        moe_tables(F, 1, 4);
        pg8::MoeOrder<true> S{(const LAS int*)(F.lds + LT_UNITS), *(const LAS int*)(F.lds + LT_NUNITS), (const char*)(ws + WS_XB), (const char*)(ws + WS_W1 + W1_L), W1_E, D, (const unsigned*)(ws + WS_LIST)};
        pg8::EpiMoe1 E{(bf16*)(ws + WS_HM)};
        pg8::gemm_phase<pg8::EpiMoe1, pg8::MoeOrder<true>, true, true>(ring, D, S, E);
        SEAM(14);
    }
    if (IN(15)) { F.refresh();
        moe_tables(F, 1, 8);
        pg8::MoeOrder<false> S{(const LAS int*)(F.lds + LT_UNITS), *(const LAS int*)(F.lds + LT_NUNITS), (const char*)(ws + WS_HM), (const char*)(ws + WS_W2 + W2_L), W2_E, EXD, nullptr};
        pg8::EpiMoe2 E{(bf16*)(ws + WS_RA), D};
        pg8::gemm_phase<pg8::EpiMoe2, pg8::MoeOrder<false>, true, true>(ring, EXD, S, E);
        SEAM(15);
    }
    if (IN(16)) { F.refresh(); REP(16, p_combine_ln(F, (const float*)(ws + WS_XR), A.in[3] + D, A.in[4] + D, A.out, nullptr, 1)) }
#undef IN
#undef SEAM
}

extern "C" void kernel_launch(void* const* d_in, const int* in_sizes, int n_in, void* d_out, int out_size, void* d_ws, size_t ws_size, hipStream_t stream) {
    static int grid = 0;
    if (grid == 0) {
        if (n_in != 23 || in_sizes[0] != T * D || out_size != T * D || ws_size < WS_END) { fprintf(stderr, "kernel_launch: unexpected shapes (n_in %d, in0 %d, out %d, ws %zu < %zu); nothing launched\n", n_in, n_in > 0 ? in_sizes[0] : -1, out_size, ws_size, (size_t)WS_END); grid = -1; return; }
        int dev = 0, cus = 0, per_cu = 0;
        if (hipGetDevice(&dev) != hipSuccess || hipDeviceGetAttribute(&cus, hipDeviceAttributeMultiprocessorCount, dev) != hipSuccess) { grid = -1; return; }
        if (hipFuncSetAttribute((const void*)mk_fwd, hipFuncAttributeMaxDynamicSharedMemorySize, LDS_BYTES) != hipSuccess) { fprintf(stderr, "kernel_launch: hipFuncSetAttribute failed\n"); grid = -1; return; }
        if (hipOccupancyMaxActiveBlocksPerMultiprocessor(&per_cu, (const void*)mk_fwd, NWAVES * 64, LDS_BYTES) != hipSuccess || per_cu < 1) fprintf(stderr, "kernel_launch: note: occupancy query reports %d\n", per_cu);
        (void)hipGetLastError();
        grid = cus;
    }
    if (grid < 0) return;
    if (hipMemsetAsync((char*)d_ws + WS_CTL, 0, CTL_ZERO_BYTES, stream) != hipSuccess) return;
    Args a{};
    for (int i = 0; i < 23; ++i) a.in[i] = (const float*)d_in[i];
    a.out = (float*)d_out; a.ws = (unsigned char*)d_ws;
    for (int li = 0; li < N_LAUNCHES; ++li) {
        if (N_LAUNCHES == 1) { a.ph_lo = 0; a.ph_hi = N_PHASES; } else { a.ph_lo = li; a.ph_hi = li + 1; }
        hipLaunchKernelGGL(mk_fwd, dim3(grid), dim3(NWAVES * 64), LDS_BYTES, stream, a);
        if (hipPeekAtLastError() != hipSuccess) { fprintf(stderr, "kernel_launch: launch %d failed\n", li); break; }
    }
}
```

```cpp
#include <hip/hip_runtime.h>
#include <cstdio>
#include <cstdint>

#ifndef MK_N_LAUNCHES
#define MK_N_LAUNCHES 1
#endif

namespace pg8 {
#define PG8_LAS __attribute__((address_space(3)))
typedef unsigned short bf16_t;
typedef short bf16x8 __attribute__((ext_vector_type(8)));
typedef float f32x4 __attribute__((ext_vector_type(4)));
typedef float f32x2 __attribute__((ext_vector_type(2)));
typedef unsigned u32x4 __attribute__((ext_vector_type(4)));
constexpr int BM = 256, BK = 64, HALF = 128, HTB = HALF * BK * 2  , STAGE_BYTES = 8 * HTB, NXCD = 8, WGM = 8;

__host__ __device__ __forceinline__ int lds_byte(int r, int c) { const int st = (r >> 4) * 2 + (c >> 5), rr = r & 15, cc = c & 31, ob = rr * 64 + cc * 2; return st * 1024 + (ob ^ (((ob >> 9) & 1) << 5)); }
__host__ __device__ __forceinline__ void stage_rc(int b, int& R, int& C) { const int st = b / 1024, sb = b % 1024, swz = sb ^ (((sb >> 9) & 1) << 5); R = (st >> 1) * 16 + swz / 64; C = (st & 1) * 32 + (swz % 64) / 2; }
__host__ __device__ __forceinline__ int perm32(int rho) { const int n = rho >> 4, i = rho & 15; return 8 * (i >> 2) + 4 * n + (i & 3); }

struct Unit { int pm, pn, e, rows, orow; };

struct DenseOrder {
    static constexpr bool GATHER = false;
    const char* A; const char* Bt; int K, nM, nN, nwg, G, c;
    __device__ void init(const void* A_, const void* Bt_, int M, int N, int K_, int G_, int c_) { A = (const char*)A_; Bt = (const char*)Bt_; K = K_; nM = M / BM; nN = N / BM; nwg = nM * nN; G = G_; c = c_; }
    __device__ bool next(int i, Unit& u) const {
        const long L = (long)i * G + c; if (L >= nwg) return false;
        int wgid = (int)L; { const int q = nwg / NXCD, r = nwg % NXCD, xcd = wgid % NXCD, off = wgid / NXCD; wgid = (xcd < r ? xcd * (q + 1) : r * (q + 1) + (xcd - r) * q) + off; }
        const int nig = WGM * nN, gid = wgid / nig, fm = gid * WGM, gsz = (nM - fm) < WGM ? (nM - fm) : WGM;
        u.pm = fm + ((wgid % nig) % gsz); u.pn = (wgid % nig) / gsz; u.e = 0; u.rows = BM; u.orow = u.pm * BM; return true;
    }
    __device__ __forceinline__ const char* a_ptr(const Unit& u) const { return A + (size_t)u.pm * BM * K * 2; }
    __device__ __forceinline__ const char* b_ptr(const Unit& u) const { return Bt + (size_t)u.pn * BM * K * 2; }
    __device__ __forceinline__ int tok(const Unit&, int) const { return 0; }
};
template <bool GATHER_> struct MoeOrder {
    static constexpr bool GATHER = GATHER_;
    const PG8_LAS int* tab; int n;
    const char* A; const char* Bt; size_t b_estride; int K; const unsigned* list;
    __device__ bool next(int i, Unit& u) const { if (i >= n) return false; const PG8_LAS int* t = tab + 5 * i; u.e = t[0]; u.pm = t[1]; u.pn = t[2]; u.rows = t[3]; u.orow = t[4]; return true; }
    __device__ __forceinline__ const char* a_ptr(const Unit& u) const { return GATHER ? A : A + (size_t)u.orow * K * 2; }
    __device__ __forceinline__ const char* b_ptr(const Unit& u) const { return Bt + (size_t)u.e * b_estride + (size_t)u.pn * BM * K * 2; }
    __device__ __forceinline__ int tok(const Unit& u, int row) const { if (u.e >= 64) return u.pm * BM + row; return row < u.rows ? (int)list[(size_t)u.e * 16384 + u.pm * BM + row] : 0; }
};

__device__ __forceinline__ unsigned cvt_pk_bf16(float lo, float hi) { unsigned r; asm volatile("v_cvt_pk_bf16_f32 %0, %1, %2" : "=v"(r) : "v"(lo), "v"(hi)); return r; }
__device__ __forceinline__ f32x2 gelu_pk(f32x2 v) {
    const f32x2 av = __builtin_elementwise_abs(v), d = av * 0.2316418882f + 1.0f;
    f32x2 t; t.x = __builtin_amdgcn_rcpf(d.x); t.y = __builtin_amdgcn_rcpf(d.y);
    f32x2 q = t * 0.5307027145f + (-0.7265760135f); q = q * t + 0.7107068705f; q = q * t + (-0.142248368f); q = q * t + 0.127414796f; q = q * t;
    const f32x2 s = (v * v) * (-0.72134752044f);
    f32x2 e; e.x = __builtin_amdgcn_exp2f(s.x); e.y = __builtin_amdgcn_exp2f(s.y);
    const f32x2 m = v * (q * e), r = v - m;
    f32x2 o; o.x = v.x < 0.f ? m.x : r.x; o.y = v.y < 0.f ? m.y : r.y; return o;
}
__device__ __forceinline__ float sigmoidf_(float x) { return __builtin_amdgcn_rcpf(1.0f + __expf(-x)); }

struct EpiGelu {
    static constexpr bool PERM = true; static constexpr bool PERM64 = false;
    bf16_t* O; int ldc;
    __device__ __forceinline__ void operator()(const f32x4 (&acc)[2][2][4][2], const Unit& u, int wr, int wc, int fr, int fq) const {
        const int row0 = u.pm * BM + wr * 64 + fr, col0 = u.pn * BM + wc * 32 + 8 * fq;
#pragma unroll
        for (int ai = 0; ai < 2; ++ai)
#pragma unroll
            for (int m = 0; m < 4; ++m) { bf16_t* rowp = O + (size_t)(row0 + ai * HALF + m * 16) * ldc + col0;
#pragma unroll
                for (int bj = 0; bj < 2; ++bj) { const f32x4 v0 = acc[ai][bj][m][0], v1 = acc[ai][bj][m][1];
                    const f32x2 a = gelu_pk((f32x2){v0[0], v0[1]}), b = gelu_pk((f32x2){v0[2], v0[3]}), c = gelu_pk((f32x2){v1[0], v1[1]}), d = gelu_pk((f32x2){v1[2], v1[3]});
                    u32x4 w; w.x = cvt_pk_bf16(a.x, a.y); w.y = cvt_pk_bf16(b.x, b.y); w.z = cvt_pk_bf16(c.x, c.y); w.w = cvt_pk_bf16(d.x, d.y);
                    *(u32x4*)(rowp + bj * HALF) = w; } }
    }
};
struct EpiRes {
    static constexpr bool PERM = true; static constexpr bool PERM64 = false;
    const bf16_t* res; bf16_t* out; int ldc; float alpha; float sc;
    __device__ __forceinline__ void operator()(const f32x4 (&acc)[2][2][4][2], const Unit& u, int wr, int wc, int fr, int fq) const {
        const int row0 = u.pm * BM + wr * 64 + fr, col0 = u.pn * BM + wc * 32 + 8 * fq;
#pragma unroll
        for (int ai = 0; ai < 2; ++ai)
#pragma unroll
            for (int m = 0; m < 4; ++m) { const size_t off = (size_t)(row0 + ai * HALF + m * 16) * ldc + col0;
#pragma unroll
                for (int bj = 0; bj < 2; ++bj) { const u32x4 rr = *(const u32x4*)(res + off + bj * HALF); const f32x4 v0 = acc[ai][bj][m][0] * sc, v1 = acc[ai][bj][m][1] * sc;
                    u32x4 w;
                    w.x = cvt_pk_bf16(alpha * __builtin_bit_cast(float, rr.x << 16) + v0[0], alpha * __builtin_bit_cast(float, rr.x & 0xffff0000u) + v0[1]);
                    w.y = cvt_pk_bf16(alpha * __builtin_bit_cast(float, rr.y << 16) + v0[2], alpha * __builtin_bit_cast(float, rr.y & 0xffff0000u) + v0[3]);
                    w.z = cvt_pk_bf16(alpha * __builtin_bit_cast(float, rr.z << 16) + v1[0], alpha * __builtin_bit_cast(float, rr.z & 0xffff0000u) + v1[1]);
                    w.w = cvt_pk_bf16(alpha * __builtin_bit_cast(float, rr.w << 16) + v1[2], alpha * __builtin_bit_cast(float, rr.w & 0xffff0000u) + v1[3]);
                    *(u32x4*)(out + off + bj * HALF) = w; }
                if (m & 1) asm volatile("" ::: "memory"); }
    }
};
struct EpiHgrn {
    static constexpr bool PERM = true; static constexpr bool PERM64 = false;
    bf16_t* Q; bf16_t* Kk; bf16_t* V; bf16_t* G; _Float16* F; const float* lb; int D;
    __device__ __forceinline__ void operator()(const f32x4 (&acc)[2][2][4][2], const Unit& u, int wr, int wc, int fr, int fq) const {
        const int kind = u.pn / (D / BM);
        const int row0 = u.pm * BM + wr * 64 + fr, col0 = (u.pn % (D / BM)) * BM + wc * 32 + 8 * fq;
        if (kind == 1) {
#pragma unroll
            for (int bj = 0; bj < 2; ++bj) {
                const f32x4 l0 = *(const f32x4*)(lb + col0 + bj * HALF), l1 = *(const f32x4*)(lb + col0 + bj * HALF + 4);
#pragma unroll
                for (int ai = 0; ai < 2; ++ai)
#pragma unroll
                    for (int m = 0; m < 4; ++m) { const size_t off = (size_t)(row0 + ai * HALF + m * 16) * D + col0 + bj * HALF;
                        f32x4 fo[2];
#pragma unroll
                        for (int j = 0; j < 4; ++j) { const float s0 = sigmoidf_(acc[ai][bj][m][0][j] * (1.0f / 8192.0f)), s1 = sigmoidf_(acc[ai][bj][m][1][j] * (1.0f / 8192.0f));
                            fo[0][j] = __logf(l0[j] + (1.0f - l0[j]) * s0); fo[1][j] = __logf(l1[j] + (1.0f - l1[j]) * s1); }
                        { typedef _Float16 h8 __attribute__((ext_vector_type(8))); h8 hv; hv[0] = (_Float16)fo[0][0]; hv[1] = (_Float16)fo[0][1]; hv[2] = (_Float16)fo[0][2]; hv[3] = (_Float16)fo[0][3]; hv[4] = (_Float16)fo[1][0]; hv[5] = (_Float16)fo[1][1]; hv[6] = (_Float16)fo[1][2]; hv[7] = (_Float16)fo[1][3];
                          *(h8*)(F + off) = hv; }
                        asm volatile("" ::: "memory"); } }
        } else {
            bf16_t* O = kind == 0 ? Q : (kind == 2 ? V : G);
            const bool act = kind != 2;
#pragma unroll
            for (int ai = 0; ai < 2; ++ai)
#pragma unroll
                for (int m = 0; m < 4; ++m) { const size_t off = (size_t)(row0 + ai * HALF + m * 16) * D + col0;
#pragma unroll
                    for (int bj = 0; bj < 2; ++bj) { f32x4 o[2];
#pragma unroll
                        for (int n = 0; n < 2; ++n)
#pragma unroll
                            for (int j = 0; j < 4; ++j) { const float x = acc[ai][bj][m][n][j] * (1.0f / 8192.0f); o[n][j] = act ? x * sigmoidf_(x) : x; }
                        u32x4 w; w.x = cvt_pk_bf16(o[0][0], o[0][1]); w.y = cvt_pk_bf16(o[0][2], o[0][3]); w.z = cvt_pk_bf16(o[1][0], o[1][1]); w.w = cvt_pk_bf16(o[1][2], o[1][3]);
                        *(u32x4*)(O + off + bj * HALF) = w; } }
        }
    }
};
struct EpiMoe1 {
    static constexpr bool PERM = true; static constexpr bool PERM64 = false;
    unsigned char* H;
    __device__ __forceinline__ void operator()(const f32x4 (&acc)[2][2][4][2], const Unit& u, int wr, int wc, int fr, int fq) const {
        const int col0 = u.pn * HALF + wc * 32 + 8 * fq;
#pragma unroll
        for (int ai = 0; ai < 2; ++ai)
#pragma unroll
            for (int m = 0; m < 4; ++m) { const int r = ai * HALF + wr * 64 + m * 16 + fr;
                f32x4 o[2];
#pragma unroll
                for (int n = 0; n < 2; ++n)
#pragma unroll
                    for (int j = 0; j < 4; ++j) { const float g = acc[ai][0][m][n][j] * (1.0f / 8192.0f); o[n][j] = g * sigmoidf_(g) * acc[ai][1][m][n][j] * (8.0f / 8192.0f); }
                int lo = __builtin_amdgcn_cvt_pk_fp8_f32(o[0][0], o[0][1], 0, false); lo = __builtin_amdgcn_cvt_pk_fp8_f32(o[0][2], o[0][3], lo, true);
                int hi = __builtin_amdgcn_cvt_pk_fp8_f32(o[1][0], o[1][1], 0, false); hi = __builtin_amdgcn_cvt_pk_fp8_f32(o[1][2], o[1][3], hi, true);
                typedef int i32x2 __attribute__((ext_vector_type(2))); i32x2 w; w.x = lo; w.y = hi;
                if (r < u.rows) *(i32x2*)(H + (size_t)(u.orow + r) * 512 + col0) = w; }
    }
};
struct EpiMoe2 {
    static constexpr bool PERM = true; static constexpr bool PERM64 = true;
    unsigned char* Y; int ldc;
    __device__ __forceinline__ void operator()(const f32x4 (&acc)[2][2][4][2], const Unit& u, int wr, int wc, int fr, int fq) const {
        int col0 = u.pn * BM + wc * 64 + 16 * fq; asm volatile("" : "+v"(col0));
        int rb_ = wr * 64 + fr; asm volatile("" : "+v"(rb_));
        const float sc = 16.0f / 4096.0f;
#pragma unroll
        for (int ai = 0; ai < 2; ++ai)
#pragma unroll
            for (int m = 0; m < 4; ++m) { const int r = ai * HALF + m * 16 + rb_;
                typedef int i32x4 __attribute__((ext_vector_type(4))); i32x4 w;
#pragma unroll
                for (int bj = 0; bj < 2; ++bj)
#pragma unroll
                    for (int n = 0; n < 2; ++n) { const f32x4 v = acc[ai][bj][m][n] * sc;
                        int p_ = __builtin_amdgcn_cvt_pk_fp8_f32(v[0], v[1], 0, false); p_ = __builtin_amdgcn_cvt_pk_fp8_f32(v[2], v[3], p_, true); w[2 * bj + n] = p_; }
                if (r < u.rows) *(i32x4*)(Y + (size_t)(u.orow + r) * ldc + col0) = w; }
    }
};

template <class Epi, class Sched, bool ALIGN_EPI, bool SP2, bool F8 = false>
__device__ __forceinline__ void gemm_phase(PG8_LAS unsigned char* lds, const int K, const Sched& S, const Epi& E) {
    constexpr bool GATHER = Sched::GATHER;
    const int tid = threadIdx.x, wid = __builtin_amdgcn_readfirstlane(tid >> 6), lane = tid & 63, wr = wid >> 2, wc = wid & 3, fr = lane & 15, fq = lane >> 4;
    const int nt = K / BK;
    unsigned voffA[2][2], voffB[2];
#pragma unroll
    for (int i = 0; i < 2; ++i) { int R, C; stage_rc(tid * 16 + i * 8192, R, C); const int Rb = Epi::PERM ? ((R & ~31) + perm32(R & 31)) : R;
        const int Rh = Epi::PERM64 ? (64 * (R >> 5) + 16 * ((R & 15) >> 2) + 4 * ((R >> 4) & 1) + (R & 3)) : Rb;
        voffA[0][i] = (unsigned)(R * K + C) * 2u; voffA[1][i] = voffA[0][i]; voffB[i] = (unsigned)(Rh * K + C) * 2u; }
    const size_t kstep = (size_t)(BK * 2);
    const size_t hstep = (size_t)HALF * K * 2;
    const unsigned ldsw = (unsigned)wid * 1024u;
    const int aoff = lds_byte(wr * 64 + fr, fq * 8), boff = lds_byte(wc * 32 + fr, fq * 8);
#define PG8_SA(b, h) (((b) * 2 + (h)) * HTB)
#define PG8_SB(b, h) ((4 + (b) * 2 + (h)) * HTB)
#define PG8_GLDS(gptr, ldsoff) __builtin_amdgcn_global_load_lds((const unsigned*)(gptr), (PG8_LAS unsigned*)(lds + (ldsoff)), 16, 0, 0)
#define PG8_GLDS_S(sbase, voff, ldsoff) do { unsigned keep_; const unsigned la_ = (unsigned)(size_t)(lds + (ldsoff)); const char* sb_ = (sbase); \
        asm volatile("s_nop 4\n\ts_mov_b32 %0, m0\n\ts_mov_b32 m0, %3\n\ts_nop 0\n\tglobal_load_lds_dwordx4 %1, %2\n\ts_mov_b32 m0, %0" : "=&s"(keep_) : "v"(voff), "s"(sb_), "s"(la_) : "memory"); } while (0)
#define PG8_STAGE_B(b, h, kptr) do { _Pragma("unroll") for (int _i = 0; _i < 2; ++_i) PG8_GLDS_S((kptr) + (Epi::PERM64 ? (size_t)(h) * 8 * K * 2 : (size_t)(h) * hstep), voffB[_i], PG8_SB(b, h) + ldsw + _i * 8192); } while (0)
#define PG8_STAGE_A(b, h, kptr) do { _Pragma("unroll") for (int _i = 0; _i < 2; ++_i) { if constexpr (GATHER) PG8_GLDS_S((kptr), voffA[h][_i], PG8_SA(b, h) + ldsw + _i * 8192); else PG8_GLDS_S((kptr) + (size_t)(h) * hstep, voffA[0][_i], PG8_SA(b, h) + ldsw + _i * 8192); } } while (0)
#define PG8_LDA(dst, b, h) do { _Pragma("unroll") for (int m = 0; m < 4; ++m) { dst[m].lo = *(const PG8_LAS i32x4_*)(lds + PG8_SA(b, h) + aoff + m * 2048); dst[m].hi = *(const PG8_LAS i32x4_*)(lds + PG8_SA(b, h) + aoff + m * 2048 + 1024); } } while (0)
#define PG8_LDB(dst, b, h) do { _Pragma("unroll") for (int n = 0; n < 2; ++n) { dst[n].lo = *(const PG8_LAS i32x4_*)(lds + PG8_SB(b, h) + boff + n * 2048); dst[n].hi = *(const PG8_LAS i32x4_*)(lds + PG8_SB(b, h) + boff + n * 2048 + 1024); } } while (0)
#define PG8_MMA(ai, bj, At, Bt) do { __builtin_amdgcn_s_setprio(1); _Pragma("unroll") for (int m = 0; m < 4; ++m) _Pragma("unroll") for (int n = 0; n < 2; ++n) { \
          if constexpr (F8) {   \
              acc[ai][bj][m][n] = __builtin_amdgcn_mfma_scale_f32_16x16x128_f8f6f4(Bt[n], At[m], acc[ai][bj][m][n], 0, 0, 0, 0x7F7F7F7F, 0, 0x7F7F7F7F); } \
          else { acc[ai][bj][m][n] = __builtin_amdgcn_mfma_f32_16x16x32_bf16(__builtin_bit_cast(bf16x8, __builtin_shufflevector(Bt[n], Bt[n], 0, 1, 2, 3)), __builtin_bit_cast(bf16x8, __builtin_shufflevector(At[m], At[m], 0, 1, 2, 3)), acc[ai][bj][m][n], 0, 0, 0); \
                 acc[ai][bj][m][n] = __builtin_amdgcn_mfma_f32_16x16x32_bf16(__builtin_bit_cast(bf16x8, __builtin_shufflevector(Bt[n], Bt[n], 4, 5, 6, 7)), __builtin_bit_cast(bf16x8, __builtin_shufflevector(At[m], At[m], 4, 5, 6, 7)), acc[ai][bj][m][n], 0, 0, 0); } } __builtin_amdgcn_s_setprio(0); } while (0)
#define PG8_WAIT_V(n) asm volatile("s_waitcnt vmcnt(" #n ")" ::: "memory")
#define PG8_WAIT_L(n) asm volatile("s_waitcnt lgkmcnt(" #n ")" ::: "memory")
#define PG8_BAR __builtin_amdgcn_s_barrier()
#define PG8_SCHED __builtin_amdgcn_sched_barrier(0)
#define PG8_LOAD_OFFS(dst, unit) do { _Pragma("unroll") for (int _i = 0; _i < 2; ++_i) { int R_, C_; stage_rc(tid * 16 + _i * 8192, R_, C_); \
            _Pragma("unroll") for (int _h = 0; _h < 2; ++_h) dst[_h][_i] = (unsigned)S.tok(unit, _h * HALF + R_) * (unsigned)(K * 2) + (unsigned)(C_ * 2); } \
        asm volatile("s_waitcnt vmcnt(0)" ::: "memory"); } while (0)
    Unit cur, nxt; int ui = 0;
    if (!S.next(0, cur)) return;
    f32x4 acc[2][2][4][2];
#pragma unroll
    for (int a = 0; a < 2; ++a)
#pragma unroll
        for (int b = 0; b < 2; ++b)
#pragma unroll
            for (int m = 0; m < 4; ++m)
#pragma unroll
                for (int n = 0; n < 2; ++n) acc[a][b][m][n] = (f32x4){0.f, 0.f, 0.f, 0.f};
    typedef int i32x8_ __attribute__((ext_vector_type(8))); typedef int i32x4_ __attribute__((ext_vector_type(4)));
    i32x8_ At[4], B0[2], B1[2];
    const char* cA = S.a_ptr(cur); const char* cB = S.b_ptr(cur);
    if constexpr (GATHER) { PG8_LOAD_OFFS(voffA, cur); }
    if constexpr (SP2) {
        PG8_STAGE_B(0, 0, cB); PG8_STAGE_B(0, 1, cB); PG8_STAGE_A(0, 0, cA); PG8_STAGE_A(0, 1, cA);
        if (wr == 1) PG8_BAR;
        PG8_WAIT_V(2); PG8_BAR;
        PG8_STAGE_B(1, 0, cB + kstep); PG8_STAGE_A(1, 0, cA + kstep); PG8_STAGE_B(1, 1, cB + kstep);
        PG8_WAIT_V(6); PG8_BAR;
    } else {
        PG8_STAGE_B(0, 0, cB); PG8_STAGE_A(0, 0, cA); PG8_STAGE_B(0, 1, cB); PG8_STAGE_A(0, 1, cA);
        if (wr == 1) PG8_BAR;
        PG8_WAIT_V(4); PG8_BAR;
        PG8_STAGE_B(1, 0, cB + kstep); PG8_STAGE_A(1, 0, cA + kstep); PG8_STAGE_B(1, 1, cB + kstep);
        PG8_WAIT_V(6); PG8_BAR;
    }
    for (;;) {
        const bool has_next = S.next(ui + 1, nxt);
        const char* nA = has_next ? S.a_ptr(nxt) : cA; const char* nB = has_next ? S.b_ptr(nxt) : cB;
        for (int t = 0; t < nt; t += 2) {
            const bool last = (t == nt - 2);
            const char* a1 = cA + (size_t)(t + 1) * kstep;
            const char* a2 = last ? nA : cA + (size_t)(t + 2) * kstep; const char* b2 = last ? nB : cB + (size_t)(t + 2) * kstep;
            const char* a3 = a2 + kstep; const char* b3 = b2 + kstep;
            if constexpr (SP2) {
            PG8_LDB(B0, 0, 0); PG8_LDB(B1, 0, 1); PG8_SCHED; PG8_LDA(At, 0, 0); PG8_STAGE_A(1, 1, a1);
            if constexpr (GATHER) { if (last && has_next) { PG8_LOAD_OFFS(voffA, nxt); } }
            PG8_WAIT_V(8); PG8_WAIT_L(0); PG8_BAR; PG8_MMA(0, 0, At, B0); PG8_MMA(0, 1, At, B1); PG8_BAR; PG8_SCHED;
            PG8_LDA(At, 0, 1); PG8_STAGE_B(0, 0, b2); PG8_STAGE_B(0, 1, b2); PG8_STAGE_A(0, 0, a2);
            PG8_WAIT_V(8); PG8_WAIT_L(0); PG8_BAR; PG8_MMA(1, 0, At, B0); PG8_MMA(1, 1, At, B1); PG8_BAR; PG8_SCHED;
            PG8_LDB(B0, 1, 0); PG8_LDB(B1, 1, 1); PG8_SCHED; PG8_LDA(At, 1, 0); PG8_STAGE_A(0, 1, a2);
            PG8_WAIT_V(8); PG8_WAIT_L(0); PG8_BAR; PG8_MMA(0, 0, At, B0); PG8_MMA(0, 1, At, B1); PG8_BAR; PG8_SCHED;
            PG8_LDA(At, 1, 1); PG8_STAGE_B(1, 0, b3); PG8_STAGE_B(1, 1, b3); PG8_STAGE_A(1, 0, a3);
            PG8_WAIT_V(8); PG8_WAIT_L(0); PG8_BAR; PG8_MMA(1, 0, At, B0); PG8_MMA(1, 1, At, B1); PG8_BAR; PG8_SCHED;
            } else {
            PG8_LDB(B0, 0, 0); PG8_SCHED; PG8_LDA(At, 0, 0); PG8_STAGE_A(1, 1, a1);
            if constexpr (GATHER) { if (last && has_next) { PG8_LOAD_OFFS(voffA, nxt); } }
            PG8_WAIT_L(8); PG8_BAR; PG8_WAIT_L(0); PG8_MMA(0, 0, At, B0); PG8_BAR; PG8_SCHED;
            PG8_LDB(B1, 0, 1); PG8_STAGE_B(0, 0, b2);
            PG8_BAR; PG8_WAIT_L(0); PG8_MMA(0, 1, At, B1); PG8_BAR;
            PG8_LDA(At, 0, 1); PG8_STAGE_A(0, 0, a2);
            PG8_BAR; PG8_WAIT_L(0); PG8_MMA(1, 0, At, B0); PG8_BAR; PG8_SCHED;
            PG8_STAGE_B(0, 1, b2);
            PG8_WAIT_V(6); PG8_BAR; PG8_MMA(1, 1, At, B1); PG8_BAR;
            PG8_LDB(B0, 1, 0); PG8_SCHED; PG8_LDA(At, 1, 0); PG8_STAGE_A(0, 1, a2);
            PG8_WAIT_L(8); PG8_BAR; PG8_WAIT_L(0); PG8_MMA(0, 0, At, B0); PG8_BAR; PG8_SCHED;
            PG8_LDB(B1, 1, 1); PG8_STAGE_B(1, 0, b3);
            PG8_BAR; PG8_WAIT_L(0); PG8_MMA(0, 1, At, B1); PG8_BAR;
            PG8_LDA(At, 1, 1); PG8_STAGE_A(1, 0, a3);
            PG8_BAR; PG8_WAIT_L(0); PG8_MMA(1, 0, At, B0); PG8_BAR; PG8_SCHED;
            PG8_STAGE_B(1, 1, b3);
            PG8_WAIT_V(6); PG8_BAR; PG8_MMA(1, 1, At, B1); PG8_BAR;
            }
        }
        if constexpr (ALIGN_EPI) { if (wr == 0) PG8_BAR; }
        E(acc, cur, wr, wc, fr, fq);
        if (!has_next) break;
#pragma unroll
        for (int a = 0; a < 2; ++a)
#pragma unroll
            for (int b = 0; b < 2; ++b)
#pragma unroll
                for (int m = 0; m < 4; ++m)
#pragma unroll
                    for (int n = 0; n < 2; ++n) acc[a][b][m][n] = (f32x4){0.f, 0.f, 0.f, 0.f};
        cur = nxt; cA = nA; cB = nB; ++ui;
        if constexpr (ALIGN_EPI) { if (wr == 1) PG8_BAR; }
    }
    PG8_WAIT_V(0);
    if constexpr (!ALIGN_EPI) { if (wr == 0) PG8_BAR; }
    PG8_BAR;
#undef PG8_SA
#undef PG8_SB
#undef PG8_GLDS
#undef PG8_GLDS_S
#undef PG8_STAGE_A
#undef PG8_STAGE_B
#undef PG8_LDA
#undef PG8_LDB
#undef PG8_MMA
#undef PG8_WAIT_V
#undef PG8_WAIT_L
#undef PG8_BAR
#undef PG8_SCHED
#undef PG8_LOAD_OFFS
}
}

constexpr int NWAVES = 8;
constexpr int N_LAUNCHES = MK_N_LAUNCHES;
constexpr int N_PHASES = 18;
constexpr int T = 16384, D = 2048, SEQ = 4096, NB = 4;
constexpr int NE = 64, NEA = 65, TOPK = 8, EXD = 512;
constexpr int NH = 16, HD = 128;
constexpr float LN_EPS = 1e-5f;
constexpr float ALPHA = 1.4142135623730951f;
constexpr float ROUTED_SCALE = 2.5f;
constexpr int NROWS = T * TOPK + T;

constexpr size_t MiB = 1u << 20;
constexpr size_t WS_CTL = 0, CTL_ZERO_BYTES = 1 * MiB;
constexpr size_t WS_LB = 1 * MiB;
constexpr size_t WS_VST = WS_LB + 64 * 1024;
constexpr size_t WS_WSP = 2 * MiB;
constexpr size_t WS_WR = 3 * MiB;
constexpr size_t WS_AES = 4 * MiB;
constexpr size_t WS_AW = 5 * MiB;
constexpr size_t WS_LIST = 6 * MiB;
constexpr size_t WS_GIN = 16 * MiB;
constexpr size_t WS_GOUT = WS_GIN + 16 * MiB;
constexpr size_t WS_HIN = WS_GOUT + 8 * MiB;
constexpr size_t WS_HOUT = WS_HIN + 32 * MiB;
constexpr size_t WS_W1 = WS_HOUT + 8 * MiB;
constexpr size_t W1_E = (size_t)1024 * 2048 * 2, W1_L = NEA * W1_E;
constexpr size_t WS_W2 = WS_W1 + 2 * W1_L;
constexpr size_t W2_E = (size_t)2048 * 512 * 2, W2_L = NEA * W2_E;
constexpr size_t WS_XA = WS_W2 + 2 * W2_L;
constexpr size_t WS_XR = WS_XA + 128 * MiB;
constexpr size_t WS_XB = WS_XR + 128 * MiB;
constexpr size_t WS_HM = WS_XB + 64 * MiB;
constexpr size_t WS_RA = WS_HM + 145 * MiB;
constexpr size_t WS_END = WS_RA + 576 * MiB;
constexpr size_t WS_XINB = WS_RA;
constexpr size_t WS_Z = WS_RA + 64 * MiB;
constexpr size_t WS_YG = WS_RA + 192 * MiB;
constexpr size_t WS_HQ = WS_RA, WS_HK = WS_RA + 64 * MiB, WS_HV = WS_RA + 128 * MiB, WS_HG = WS_RA + 192 * MiB;
constexpr size_t WS_HF = WS_RA + 256 * MiB;
constexpr size_t WS_HO = WS_RA + 384 * MiB;
constexpr size_t WS_HQD = WS_RA + 448 * MiB;
constexpr size_t WS_HDT = WS_RA + 512 * MiB;
constexpr size_t WS_HUT = WS_XA;
constexpr size_t WS_XQ = WS_XA + 64 * MiB;
constexpr size_t WS_HOI = WS_HM;
static_assert((size_t)(NROWS + 256) * 512 * 2 <= 145 * MiB && (size_t)NROWS * D * 2 <= 576 * MiB && WS_END <= 2040 * MiB, "d_ws map");
constexpr int CW_BAR = 4096;
constexpr int CW_CNT = 16384;
constexpr int CNT_STRIDE = 16;

constexpr int RING_OFF = 0, RING_BYTES = 131072;
constexpr int LDSCTL_OFF = RING_BYTES;
constexpr int MISC_OFF = LDSCTL_OFF;
constexpr int LT_RB = LDSCTL_OFF + 256;
constexpr int LT_CNT = LDSCTL_OFF + 576;
constexpr int LT_NUNITS = LDSCTL_OFF + 896;
constexpr int LT_TP = LDSCTL_OFF + 2560;
constexpr int LT_UNITS = LDSCTL_OFF + 1024;
constexpr int LDS_BYTES = 147456;

#define GAS __attribute__((address_space(1)))
#define LAS __attribute__((address_space(3)))
typedef unsigned short bf16;
typedef unsigned v4u __attribute__((ext_vector_type(4)));
typedef unsigned v2u __attribute__((ext_vector_type(2)));
typedef float f32x4 __attribute__((ext_vector_type(4)));
typedef short bf16x8 __attribute__((ext_vector_type(8)));
#define LDS_WAIT() asm volatile("s_waitcnt lgkmcnt(0)" ::: "memory")
#define VM_WAIT() asm volatile("s_waitcnt vmcnt(0)" ::: "memory")
#define LBAR() asm volatile("s_waitcnt lgkmcnt(0)\n\ts_barrier" ::: "memory")
typedef __bf16 bf16x2n_t __attribute__((ext_vector_type(2))); typedef float f32x2n_t __attribute__((ext_vector_type(2)));
__device__ __forceinline__ unsigned pk2(float lo, float hi) { return __builtin_bit_cast(unsigned, __builtin_convertvector((f32x2n_t){lo, hi}, bf16x2n_t)); }
__device__ __forceinline__ unsigned f2bf(float f) { return (unsigned)__builtin_bit_cast(unsigned short, (__bf16)f); }
__device__ __forceinline__ unsigned pk2_sw(float lo, float hi) { const unsigned a = __builtin_bit_cast(unsigned, lo), b = __builtin_bit_cast(unsigned, hi); return ((a + 0x7fffu + ((a >> 16) & 1u)) >> 16) | (((b + 0x7fffu + ((b >> 16) & 1u)) >> 16) << 16); }
__device__ __forceinline__ float bflo(unsigned w) { return __builtin_bit_cast(float, w << 16); }
__device__ __forceinline__ float bfhi(unsigned w) { return __builtin_bit_cast(float, w & 0xffff0000u); }
__device__ __forceinline__ float bf2f(unsigned short h) { return __builtin_bit_cast(float, (unsigned)h << 16); }

#define XB_TMO      128
#define XB_XCNT(j)  (256  + 64 * (j))
#define XB_XSUB(j)  (1280 + 64 * (j))
#define XB_XGEN(j)  (2304 + 64 * (j))
#define XB_TOP      3328
#define XB_TOPGEN   3392
#define XCD_BAR_WORDS 3456
#define XB_SPIN_CAP (1u << 18)
__device__ __forceinline__ unsigned xb_ld(unsigned* p)              { return __hip_atomic_load(p, __ATOMIC_RELAXED, __HIP_MEMORY_SCOPE_AGENT); }
__device__ __forceinline__ unsigned xb_add(unsigned* p, unsigned v) { return __hip_atomic_fetch_add(p, v, __ATOMIC_RELAXED, __HIP_MEMORY_SCOPE_AGENT); }
__device__ __forceinline__ unsigned xb_xcc_id() { return (unsigned)__builtin_amdgcn_s_getreg((3 << 11) | 20) & 0xFu; }
#define XB_SPIN(cond, bar) do { unsigned _sp = 0; while (cond) { __builtin_amdgcn_s_sleep(1); \
    if ((++_sp & 255u) == 0u) { if (xb_ld(&(bar)[XB_TMO])) break; if (_sp > XB_SPIN_CAP) { atomicAdd(&(bar)[XB_TMO], 1u); break; } } } } while (0)
struct XcdBarrier { unsigned* bar; unsigned x; volatile LAS unsigned* st; };
__device__ __forceinline__ XcdBarrier xcd_barrier_post(unsigned* bar, volatile LAS unsigned* st) {
    XcdBarrier b; b.bar = bar; b.x = xb_xcc_id(); b.st = st;
    if (threadIdx.x == 0) (void)xb_add(&bar[XB_XCNT(b.x)], 1u);
    return b;
}
__device__ __forceinline__ void xcd_barrier_complete(unsigned* bar, unsigned x, unsigned& nloc, unsigned& nx) {
    const unsigned G = gridDim.x * gridDim.y * gridDim.z;
    unsigned sum, cnt, mine, sp = 0u;
    for (;;) {
        sum = 0u; cnt = 0u; mine = 0u;
#pragma unroll
        for (unsigned j = 0; j < 16; ++j) { const unsigned c = xb_ld(&bar[XB_XCNT(j)]); sum += c; cnt += (c > 0u) ? 1u : 0u; mine = (j == x) ? c : mine; }
        if (sum == G) break;
        __builtin_amdgcn_s_sleep(1);
        if ((++sp & 255u) == 0u) { if (xb_ld(&bar[XB_TMO])) break; if (sp > XB_SPIN_CAP) { atomicAdd(&bar[XB_TMO], 1u); break; } }
    }
    nloc = mine > 0u ? mine : 1u; nx = cnt > 0u ? cnt : 1u;
}
__device__ __forceinline__ void xcd_barrier(const XcdBarrier& b) {
    asm volatile("s_waitcnt vmcnt(0)" ::: "memory");
    __syncthreads();
    if (threadIdx.x == 0) {
        unsigned* bar = b.bar;
        __builtin_amdgcn_s_waitcnt(0);
        unsigned nloc = b.st[0], nx = b.st[1];
        if (nloc == 0u) { xcd_barrier_complete(bar, b.x, nloc, nx); b.st[0] = nloc; b.st[1] = nx; }
        const unsigned old = xb_add(&bar[XB_XSUB(b.x)], 1u);
        const unsigned gen = old / nloc;
        if (old + 1u == (gen + 1u) * nloc) {
            __builtin_amdgcn_fence(__ATOMIC_RELEASE, "agent");
            asm volatile("s_waitcnt vmcnt(0)" ::: "memory");
            const unsigned og = xb_add(&bar[XB_TOP], 1u);
            const unsigned tg = og / nx;
            if (og + 1u == (tg + 1u) * nx) xb_add(&bar[XB_TOPGEN], 1u);
            else XB_SPIN(xb_ld(&bar[XB_TOPGEN]) == tg, bar);
            __builtin_amdgcn_fence(__ATOMIC_ACQUIRE, "agent");
            xb_add(&bar[XB_XGEN(b.x)], 1u);
            asm volatile("s_waitcnt vmcnt(0)" ::: "memory");
        } else {
            XB_SPIN(xb_ld(&bar[XB_XGEN(b.x)]) == gen, bar);
            __builtin_amdgcn_fence(__ATOMIC_ACQUIRE, "agent");
            asm volatile("s_waitcnt vmcnt(0)" ::: "memory");
        }
    }
    __syncthreads();
}

struct Args { const float* in[23]; float* out; unsigned char* ws; int ph_lo, ph_hi; };
struct Frame {
    LAS unsigned char* lds;
    unsigned* ctl;
    unsigned char* ws;
    int tid, lane, wave, vcu, G;
    __device__ __forceinline__ void refresh(unsigned char* w_) { int t = threadIdx.x; asm volatile("" : "+v"(t)); tid = t; lane = t & 63; wave = __builtin_amdgcn_readfirstlane(t >> 6);
        asm volatile("" : "+s"(w_)); ws = w_; ctl = (unsigned*)(w_ + WS_CTL); }
};
#define DPP_F(v, ctrl) __builtin_bit_cast(float, __builtin_amdgcn_update_dpp(0, __builtin_bit_cast(int, (v)), (ctrl), 0xf, 0xf, true))
__device__ __forceinline__ float wave_sum(float v) {
    v += DPP_F(v, 0xB1); v += DPP_F(v, 0x4E); v += DPP_F(v, 0x141); v += DPP_F(v, 0x140);
    const int iv = __builtin_bit_cast(int, v);
    return (__builtin_bit_cast(float, __builtin_amdgcn_readlane(iv, 0)) + __builtin_bit_cast(float, __builtin_amdgcn_readlane(iv, 16))) + (__builtin_bit_cast(float, __builtin_amdgcn_readlane(iv, 32)) + __builtin_bit_cast(float, __builtin_amdgcn_readlane(iv, 48)));
}
#define OPAQUE(x) asm volatile("" : "+v"(x))

__device__ __forceinline__ void p0_transpose_item(const float* W, int N, int K, bf16* WT, int k0, int n0, int dst_row0, LAS float* scr, int lane) {
#pragma unroll
    for (int i = 0; i < 8; ++i) { const int kk = 8 * i + (lane >> 3), n4 = (lane & 7) * 4; const f32x4 v = *(const f32x4*)(W + (size_t)(k0 + kk) * N + n0 + n4);
        LAS float* d = scr + kk * 33 + n4; d[0] = v.x; d[1] = v.y; d[2] = v.z; d[3] = v.w; }
    LDS_WAIT(); asm volatile("" ::: "memory");
    const int c = lane & 7;
#pragma unroll
    for (int j = 0; j < 4; ++j) { const int n = (lane >> 3) + 8 * j; const LAS float* s = scr + (8 * c) * 33 + n;
        v4u o; o.x = pk2(s[0 * 33], s[1 * 33]); o.y = pk2(s[2 * 33], s[3 * 33]); o.z = pk2(s[4 * 33], s[5 * 33]); o.w = pk2(s[6 * 33], s[7 * 33]);
        *(v4u*)(WT + (size_t)(dst_row0 + n) * K + k0 + 8 * c) = o; }
    LDS_WAIT(); asm volatile("" ::: "memory");
}
struct CvtItem { const float* W; bf16* WT; int N, K, k0, n0, dst0, f8; };
__device__ __forceinline__ CvtItem moe_item(Frame& F, const Args& A, int l, int r) {
    const int e = r / 192, sub = r % 192, part = sub / 64, idx = sub % 64; CvtItem it;
    if (part < 2) {
        it.W = e < NE ? (part == 0 ? A.in[17] : A.in[18]) + (size_t)(l * NE + e) * 2048 * 512 : (part == 0 ? A.in[20] : A.in[21]) + (size_t)l * 2048 * 512;
        const int kb = idx / 4, nb = idx % 4;
        it.WT = (bf16*)(F.ws + WS_W1 + l * W1_L + e * W1_E); it.N = 512; it.K = 2048; it.k0 = 128 * kb; it.n0 = 128 * nb; it.dst0 = nb * 256 + part * 128; it.f8 = 1;
    } else {
        it.W = e < NE ? A.in[19] + (size_t)(l * NE + e) * 512 * 2048 : A.in[22] + (size_t)l * 512 * 2048;
        const int kb = idx / 16, nb = idx % 16;
        it.WT = (bf16*)(F.ws + WS_W2 + l * W2_L + e * W2_E); it.N = 2048; it.K = 512; it.k0 = 128 * kb; it.n0 = 128 * nb; it.dst0 = 128 * nb; it.f8 = 1;
    }
    return it;
}
__device__ __forceinline__ CvtItem cvt_item(Frame& F, const Args& A, int it) {
    constexpr int I0 = 16 * 32, I1 = 16 * 16, I2 = 16 * 64, I3 = 16 * 16;
    int r = it;
    if (r < I0) return CvtItem{A.in[5], (bf16*)(F.ws + WS_GIN), 4096, 2048, 128 * (r / 32), 128 * (r % 32), 128 * (r % 32), 0};
    if ((r -= I0) < I1) return CvtItem{A.in[10], (bf16*)(F.ws + WS_GOUT), 2048, 2048, 128 * (r / 16), 128 * (r % 16), 128 * (r % 16), 0};
    if ((r -= I1) < I2) return CvtItem{A.in[11], (bf16*)(F.ws + WS_HIN), 8192, 2048, 128 * (r / 64), 128 * (r % 64), 128 * (r % 64), 1};
    if ((r -= I2) < I3) return CvtItem{A.in[13], (bf16*)(F.ws + WS_HOUT), 2048, 2048, 128 * (r / 16), 128 * (r % 16), 128 * (r % 16), 1};
    r -= I3; return moe_item(F, A, r / (NEA * 192), r % (NEA * 192));
}
__device__ __forceinline__ void p0_prologue(Frame& F, const Args& A) {
    constexpr int NTILES = 16 * 32 + 16 * 16 + 16 * 64 + 16 * 16 + 2 * NEA * 192;
    LAS unsigned* img = (LAS unsigned*)(F.lds + RING_OFF);
    f32x4 ra0[4], rb0[4], ra1[4], rb1[4];
#define CVT_LOAD(c, ra, rb) do { int t_ = F.tid; OPAQUE(t_); const int kp_ = t_ >> 5, n4_ = t_ & 31; const float* src_ = (c).W + (size_t)((c).k0 + 2 * kp_) * (c).N + (c).n0 + 4 * n4_; \
        _Pragma("unroll") for (int i = 0; i < 4; ++i) { ra[i] = *(const f32x4*)(src_ + (size_t)(32 * i) * (c).N); rb[i] = *(const f32x4*)(src_ + (size_t)(32 * i + 1) * (c).N); } } while (0)
#define CVT_PUT(c, ra, rb, par) do { int t_ = F.tid; OPAQUE(t_); const int kp = t_ >> 5, n4 = t_ & 31; LAS unsigned* ib = img + (par) * 8192; \
          if ((c).f8) {        \
              LAS unsigned short* ih = (LAS unsigned short*)ib; \
              _Pragma("unroll") for (int i = 0; i < 4; ++i) { const int kd = (kp >> 1) + 8 * i, pos = (((kd >> 2) ^ ((n4 >> 2) & 7)) << 2) + ((kd & 3) ^ (n4 & 3)); \
                  _Pragma("unroll") for (int j = 0; j < 4; ++j) ih[((4 * n4 + j) * 32 + pos) * 2 + (kp & 1)] = (unsigned short)__builtin_amdgcn_cvt_pk_fp8_f32(ra[i][j] * 512.0f, rb[i][j] * 512.0f, 0, false); } \
          } else { \
          _Pragma("unroll") for (int i = 0; i < 4; ++i) { const int kd = kp + 16 * i, pos = (((kd >> 2) ^ (n4 & 7)) << 2) + ((kd & 3) ^ ((n4 >> 3) & 3)); \
              _Pragma("unroll") for (int j = 0; j < 4; ++j) ib[(4 * n4 + j) * 64 + pos] = pk2(ra[i][j], rb[i][j]); } } } while (0)
#define CVT_OUT(prev, par) do { int t_ = F.tid; OPAQUE(t_); const LAS unsigned* ib = img + (par) * 8192; \
          if ((prev).f8) { \
              _Pragma("unroll") for (int m = 0; m < 2; ++m) { const int c = t_ + 512 * m, n = c >> 3, kc = c & 7, s01 = (n >> 2) & 3; \
                  const v4u x = *(const LAS v4u*)(ib + n * 32 + ((kc ^ ((n >> 4) & 7)) << 2)); \
                  v4u y; y.x = (s01 & 1) ? x.y : x.x; y.y = (s01 & 1) ? x.x : x.y; y.z = (s01 & 1) ? x.w : x.z; y.w = (s01 & 1) ? x.z : x.w; \
                  v4u z; z.x = (s01 & 2) ? y.z : y.x; z.y = (s01 & 2) ? y.w : y.y; z.z = (s01 & 2) ? y.x : y.z; z.w = (s01 & 2) ? y.y : y.w; \
                  *(v4u*)((unsigned char*)(prev).WT + (size_t)((prev).dst0 + n) * (prev).K + (prev).k0 + 16 * kc) = z; } \
          } else { \
          _Pragma("unroll") for (int m = 0; m < 4; ++m) { const int c = t_ + 512 * m, n = c >> 4, kc = c & 15, s01 = (n >> 5) & 3; \
              const v4u x = *(const LAS v4u*)(ib + n * 64 + ((kc ^ ((n >> 2) & 7)) << 2)); \
              v4u y; y.x = (s01 & 1) ? x.y : x.x; y.y = (s01 & 1) ? x.x : x.y; y.z = (s01 & 1) ? x.w : x.z; y.w = (s01 & 1) ? x.z : x.w; \
              v4u z; z.x = (s01 & 2) ? y.z : y.x; z.y = (s01 & 2) ? y.w : y.y; z.z = (s01 & 2) ? y.x : y.z; z.w = (s01 & 2) ? y.y : y.w; \
              *(v4u*)((prev).WT + (size_t)((prev).dst0 + n) * (prev).K + (prev).k0 + 8 * kc) = z; } } } while (0)
    int itA = F.vcu, itB = F.vcu + F.G;
    CvtItem curA = cvt_item(F, A, itA < NTILES ? itA : 0), curB = cvt_item(F, A, itB < NTILES ? itB : 0);
    if (itA < NTILES) CVT_LOAD(curA, ra0, rb0);
    if (itB < NTILES) CVT_LOAD(curB, ra1, rb1);
    while (itA < NTILES) {
        { CVT_PUT(curA, ra0, rb0, 0); const CvtItem prev = curA; itA += 2 * F.G;
          if (itA < NTILES) { curA = cvt_item(F, A, itA); CVT_LOAD(curA, ra0, rb0); }
          LBAR(); CVT_OUT(prev, 0); }
        if (itB >= NTILES) break;
        { CVT_PUT(curB, ra1, rb1, 1); const CvtItem prev = curB; itB += 2 * F.G;
          if (itB < NTILES) { curB = cvt_item(F, A, itB); CVT_LOAD(curB, ra1, rb1); }
          LBAR(); CVT_OUT(prev, 1); }
    }
#undef CVT_LOAD
#undef CVT_PUT
#undef CVT_OUT
    LBAR();
    const size_t gt = (size_t)F.vcu * (NWAVES * 64) + F.tid, NT = (size_t)F.G * NWAVES * 64;
    { const f32x4* x4 = (const f32x4*)A.in[0]; v4u* o = (v4u*)(F.ws + WS_XINB);
      for (size_t i = gt; i < (size_t)T * D / 8; i += NT) { const f32x4 a = x4[2 * i], b = x4[2 * i + 1]; v4u w; w.x = pk2(a.x, a.y); w.y = pk2(a.z, a.w); w.z = pk2(b.x, b.y); w.w = pk2(b.z, b.w); o[i] = w; } }
    { float* lb = (float*)(F.ws + WS_LB); const float* hb = A.in[14];
      for (size_t i = gt; i < (size_t)D; i += NT) { const float a = hb[i], b = hb[D + i]; lb[i] = 1.0f / (1.0f + __expf(a - b)); } }
    { bf16* wo = (bf16*)(F.ws + WS_WSP); const float* wi = A.in[8];
      for (size_t i = gt; i < (size_t)NH * 128 * 128; i += NT) { const int ii = (int)((i >> 7) & 127), jj = (int)(i & 127); const float v = ((ii >> 6) >= (jj >> 6)) ? wi[i] : 0.0f; wo[i] = (bf16)f2bf(v); } }
    { bf16* wr = (bf16*)(F.ws + WS_WR); const float* wi = A.in[15];
      for (size_t i = gt; i < (size_t)2 * NE * D; i += NT) { const int l = (int)(i / (NE * D)), n = (int)((i / D) % NE), k = (int)(i % D);
          const float w = wi[(size_t)l * D * NE + (size_t)k * NE + n]; const unsigned hi = f2bf(w); const float lo = w - bf2f((unsigned short)hi);
          wr[((size_t)(l * 2 + 0) * NE + n) * D + k] = (bf16)hi; wr[((size_t)(l * 2 + 1) * NE + n) * D + k] = (bf16)f2bf(lo); } }
}

__device__ __forceinline__ void p_vstats(Frame& F) {
    const int gw = F.vcu * NWAVES + F.wave, NGW = F.G * NWAVES;
    const bf16* Z = (const bf16*)(F.ws + WS_Z); float* vst = (float*)(F.ws + WS_VST);
    for (int t = gw; t < T; t += NGW) {
        const v4u* p = (const v4u*)(Z + (size_t)t * 4096 + 2048) + F.lane;
        float v[32]; float s = 0.f;
#pragma unroll
        for (int j = 0; j < 4; ++j) { const v4u w = p[64 * j];
            v[8 * j + 0] = bflo(w.x); v[8 * j + 1] = bfhi(w.x); v[8 * j + 2] = bflo(w.y); v[8 * j + 3] = bfhi(w.y); v[8 * j + 4] = bflo(w.z); v[8 * j + 5] = bfhi(w.z); v[8 * j + 6] = bflo(w.w); v[8 * j + 7] = bfhi(w.w); }
#pragma unroll
        for (int i = 0; i < 32; ++i) s += v[i];
        const float mean = wave_sum(s) * (1.0f / 2048.0f); float q = 0.f;
#pragma unroll
        for (int i = 0; i < 32; ++i) { const float d = v[i] - mean; q += d * d; }
        const float rstd = __builtin_amdgcn_rsqf(wave_sum(q) * (1.0f / 2048.0f) + LN_EPS);
        if (F.lane == 0) { vst[2 * t] = mean; vst[2 * t + 1] = rstd; }
    }
}

__device__ __forceinline__ void p_spatial(Frame& F, const Args& A) {
    constexpr int PITCH = 272;
    const bf16* Z = (const bf16*)(F.ws + WS_Z); const bf16* WSP = (const bf16*)(F.ws + WS_WSP); bf16* YG = (bf16*)(F.ws + WS_YG);
    const float* vg = A.in[6]; const float* vb = A.in[7]; const float* bsp = A.in[9];
    LAS unsigned char* img = F.lds + RING_OFF;
    const int r = F.lane & 15, q = F.lane >> 4, w = F.wave;
    LAS float* vst = (LAS float*)(img + 36864);
    for (int unit2 = F.vcu; unit2 < (T / 128) * 2; unit2 += F.G) {
        const int n = unit2 >> 1, t0 = n * 128;
        v4u rawn[4];
#define SP_RAW(hh) do { int t_ = F.tid; OPAQUE(t_); _Pragma("unroll") for (int it = 0; it < 4; ++it) { const int idx = t_ + 512 * it, j = idx & 127, c8 = idx >> 7; rawn[it] = *(const v4u*)(Z + (size_t)(t0 + j) * 4096 + 2048 + (hh) * 128 + c8 * 8); } } while (0)
        SP_RAW(8 * (unit2 & 1));
        __syncthreads();
#pragma unroll 1
        for (int i0 = 0; i0 < 16; i0 += 4) {
            v4u rw[4][4];
#pragma unroll
            for (int i = 0; i < 4; ++i) { const v4u* p = (const v4u*)(Z + (size_t)(t0 + 16 * w + i0 + i) * 4096 + 2048) + F.lane;
#pragma unroll
                for (int jj = 0; jj < 4; ++jj) rw[i][jj] = p[64 * jj]; }
#pragma unroll
            for (int i = 0; i < 4; ++i) { const int row = 16 * w + i0 + i;
                float v[32]; float sm = 0.f;
#pragma unroll
                for (int jj = 0; jj < 4; ++jj) { const v4u ww = rw[i][jj];
                    v[8 * jj + 0] = bflo(ww.x); v[8 * jj + 1] = bfhi(ww.x); v[8 * jj + 2] = bflo(ww.y); v[8 * jj + 3] = bfhi(ww.y); v[8 * jj + 4] = bflo(ww.z); v[8 * jj + 5] = bfhi(ww.z); v[8 * jj + 6] = bflo(ww.w); v[8 * jj + 7] = bfhi(ww.w); }
#pragma unroll
                for (int e = 0; e < 32; ++e) sm += v[e];
                const float mean_ = wave_sum(sm) * (1.0f / 2048.0f); float qq = 0.f;
#pragma unroll
                for (int e = 0; e < 32; ++e) { const float d = v[e] - mean_; qq += d * d; }
                const float rstd_ = __builtin_amdgcn_rsqf(wave_sum(qq) * (1.0f / 2048.0f) + LN_EPS);
                if (F.lane == 0) { vst[2 * row] = mean_; vst[2 * row + 1] = rstd_; } } }
        for (int hI = 0; hI < 8; ++hI) {
        const int h = 8 * (unit2 & 1) + hI;
        __syncthreads();
        { int t_ = F.tid; OPAQUE(t_);
#pragma unroll
        for (int it = 0; it < 4; ++it) { const int idx = t_ + 512 * it, j = idx & 127, c8 = idx >> 7;
            const v4u raw = rawn[it];
            const float mean = vst[2 * j], rstd = vst[2 * j + 1];
            const f32x4 g0 = *(const f32x4*)(vg + h * 128 + c8 * 8), g1 = *(const f32x4*)(vg + h * 128 + c8 * 8 + 4), b0 = *(const f32x4*)(vb + h * 128 + c8 * 8), b1 = *(const f32x4*)(vb + h * 128 + c8 * 8 + 4);
            float x[8] = {bflo(raw.x), bfhi(raw.x), bflo(raw.y), bfhi(raw.y), bflo(raw.z), bfhi(raw.z), bflo(raw.w), bfhi(raw.w)};
            const float gg[8] = {g0.x, g0.y, g0.z, g0.w, g1.x, g1.y, g1.z, g1.w}, bb[8] = {b0.x, b0.y, b0.z, b0.w, b1.x, b1.y, b1.z, b1.w};
#pragma unroll
            for (int i = 0; i < 8; ++i) { const float y = (x[i] - mean) * rstd * gg[i] + bb[i]; *(LAS unsigned short*)(img + (c8 * 8 + i) * PITCH + j * 2) = (unsigned short)f2bf(y); } } }
        if (hI + 1 < 8) SP_RAW(h + 1);
        const int tok = t0 + 16 * w + r; const float bias = bsp[h * 128 + 16 * w + r];
        v2u uu[8];
#pragma unroll
        for (int ct = 0; ct < 8; ++ct) uu[ct] = *(const v2u*)(Z + (size_t)tok * 4096 + h * 128 + 16 * ct + 4 * q);
        bf16x8 bw[4];
#pragma unroll
        for (int ks = 0; ks < 4; ++ks) bw[ks] = *(const bf16x8*)(WSP + ((size_t)h * 128 + 16 * w + r) * 128 + 32 * ks + 8 * q);
        __syncthreads();
        f32x4 acc[8];
#pragma unroll
        for (int ct = 0; ct < 8; ++ct) acc[ct] = (f32x4){0.f, 0.f, 0.f, 0.f};
#pragma unroll
        for (int ct = 0; ct < 8; ++ct)
#pragma unroll
            for (int ks = 0; ks < 4; ++ks) { const bf16x8 a = *(const LAS bf16x8*)(img + (16 * ct + r) * PITCH + (32 * ks + 8 * q) * 2);
                acc[ct] = __builtin_amdgcn_mfma_f32_16x16x32_bf16(a, bw[ks], acc[ct], 0, 0, 0); }
#pragma unroll
        for (int ct = 0; ct < 8; ++ct) { const int col = h * 128 + 16 * ct + 4 * q;
            v2u o; o.x = pk2((acc[ct][0] + bias) * bflo(uu[ct].x), (acc[ct][1] + bias) * bfhi(uu[ct].x)); o.y = pk2((acc[ct][2] + bias) * bflo(uu[ct].y), (acc[ct][3] + bias) * bfhi(uu[ct].y));
            *(v2u*)(YG + (size_t)tok * D + col) = o; }
        }
#undef SP_RAW
    }
    __syncthreads();
}

__device__ __forceinline__ float grp8_max(float v) { v = fmaxf(v, DPP_F(v, 0xB1)); v = fmaxf(v, DPP_F(v, 0x4E)); v = fmaxf(v, DPP_F(v, 0x141)); return v; }
__device__ __forceinline__ float wave_max(float v) {
    v = fmaxf(v, DPP_F(v, 0xB1)); v = fmaxf(v, DPP_F(v, 0x4E)); v = fmaxf(v, DPP_F(v, 0x141)); v = fmaxf(v, DPP_F(v, 0x140));
    const int iv = __builtin_bit_cast(int, v);
    return fmaxf(fmaxf(__builtin_bit_cast(float, __builtin_amdgcn_readlane(iv, 0)), __builtin_bit_cast(float, __builtin_amdgcn_readlane(iv, 16))), fmaxf(__builtin_bit_cast(float, __builtin_amdgcn_readlane(iv, 32)), __builtin_bit_cast(float, __builtin_amdgcn_readlane(iv, 48))));
}
__device__ __forceinline__ void p_ln_router(Frame& F, const Args& A, const bf16* rin, const float* lg, const float* lbias, bf16* xb, unsigned char* xq, int layer) {
    const bf16* WRh = (const bf16*)(F.ws + WS_WR) + (size_t)(layer * 2 + 0) * NE * D; const bf16* WRl = (const bf16*)(F.ws + WS_WR) + (size_t)(layer * 2 + 1) * NE * D;
    const float* ebias = A.in[16] + layer * NE;
    unsigned* cnt = F.ctl + CW_CNT + layer * NE * CNT_STRIDE;
    unsigned* list = (unsigned*)(F.ws + WS_LIST); unsigned* aes = (unsigned*)(F.ws + WS_AES); float* aw = (float*)(F.ws + WS_AW);
    LAS float* PL = (LAS float*)(F.lds + RING_OFF);
    LAS float* Lst = PL + 8 * 32 * 65;
    LAS float* Lgb = Lst + 64 * 16;
    LAS int* Lh = (LAS int*)(Lgb + 2 * D);
    LAS int* Lrec = Lh + 128;
    LAS float* Lrw = (LAS float*)(Lrec + 512);
    const int w = F.wave;
    if (F.tid < 64) Lh[F.tid] = 0;
    int itl = 0, tile0 = 0;
#define LNR_FLUSH() do { __syncthreads(); \
        if (F.tid < 64) { const int c_ = Lh[F.tid]; Lh[64 + F.tid] = c_ ? (int)__hip_atomic_fetch_add(cnt + F.tid * CNT_STRIDE, (unsigned)c_, __ATOMIC_RELAXED, __HIP_MEMORY_SCOPE_AGENT) : 0; Lh[F.tid] = 0; } \
        __syncthreads(); \
        for (int i_ = F.tid; i_ < itl * 256; i_ += NWAVES * 64) { const int rc_ = Lrec[i_], me_ = rc_ & 255, slot_ = Lh[64 + me_] + (rc_ >> 8); \
            const int token_ = (tile0 + (i_ >> 8)) * 32 + ((i_ >> 3) & 31); \
            list[(size_t)me_ * 16384 + slot_] = (unsigned)token_; aes[(size_t)token_ * 8 + (i_ & 7)] = ((unsigned)me_ << 16) | (unsigned)slot_; aw[(size_t)token_ * 8 + (i_ & 7)] = Lrw[i_]; } \
        itl = 0; } while (0)
    for (int i = F.tid; i < D / 4; i += NWAVES * 64) { ((LAS f32x4*)Lgb)[i] = ((const f32x4*)lg)[i]; ((LAS f32x4*)(Lgb + D))[i] = ((const f32x4*)lbias)[i]; }
    for (int tile = F.vcu; tile < T / 64; tile += F.G) {
        int t_ = F.tid; OPAQUE(t_);
        const int ln = t_ & 63, r = t_ & 15, q = (t_ >> 4) & 3, cw = 256 * w + 8 * q; const size_t wro = (size_t)r * D + cw;
        float mean[4], rstd[4];
#pragma unroll
        for (int hf = 0; hf < 2; ++hf) {
            v4u vr[2][8];
#pragma unroll
            for (int mt = 0; mt < 2; ++mt) { const bf16* rp = rin + (size_t)(tile * 64 + 32 * hf + 16 * mt + r) * D + cw;
#pragma unroll
                for (int j = 0; j < 8; ++j) vr[mt][j] = *(const v4u*)(rp + 32 * j); }
#pragma unroll
            for (int mt = 0; mt < 2; ++mt) { float s = 0.f, ss = 0.f;
#pragma unroll
                for (int j = 0; j < 8; ++j) { const v4u x = vr[mt][j]; const float x0 = bflo(x.x), x1 = bfhi(x.x), x2 = bflo(x.y), x3 = bfhi(x.y), x4 = bflo(x.z), x5 = bfhi(x.z), x6 = bflo(x.w), x7 = bfhi(x.w);
                    s += (x0 + x1) + (x2 + x3) + (x4 + x5) + (x6 + x7); ss += (x0 * x0 + x1 * x1) + (x2 * x2 + x3 * x3) + (x4 * x4 + x5 * x5) + (x6 * x6 + x7 * x7); }
                s += __shfl_xor(s, 16); s += __shfl_xor(s, 32); ss += __shfl_xor(ss, 16); ss += __shfl_xor(ss, 32);
                if (q == 0) { Lst[((32 * hf + 16 * mt + r) * 8 + w) * 2] = s; Lst[((32 * hf + 16 * mt + r) * 8 + w) * 2 + 1] = ss; } }
            asm volatile("" ::: "memory"); }
        __syncthreads();
#pragma unroll
        for (int mt = 0; mt < 4; ++mt) { const LAS float* lp = Lst + (16 * mt + r) * 16;
            const f32x4 p0 = *(const LAS f32x4*)(lp), p1 = *(const LAS f32x4*)(lp + 4), p2 = *(const LAS f32x4*)(lp + 8), p3 = *(const LAS f32x4*)(lp + 12);
            const float st = (p0.x + p0.z) + (p1.x + p1.z) + (p2.x + p2.z) + (p3.x + p3.z), sq = (p0.y + p0.w) + (p1.y + p1.w) + (p2.y + p2.w) + (p3.y + p3.w);
            mean[mt] = st * (1.0f / D); const float var = fmaxf(sq * (1.0f / D) - mean[mt] * mean[mt], 0.f); rstd[mt] = __builtin_amdgcn_rsqf(var + LN_EPS); }
        f32x4 acc[4][4];
#pragma unroll
        for (int mt = 0; mt < 4; ++mt)
#pragma unroll
            for (int nt = 0; nt < 4; ++nt) acc[mt][nt] = (f32x4){0.f, 0.f, 0.f, 0.f};
#pragma unroll
        for (int j = 0; j < 8; ++j) { const int c0 = cw + 32 * j;
            const f32x4 g0 = *(const LAS f32x4*)(Lgb + c0), g1 = *(const LAS f32x4*)(Lgb + c0 + 4), b0 = *(const LAS f32x4*)(Lgb + D + c0), b1 = *(const LAS f32x4*)(Lgb + D + c0 + 4);
            bf16x8 ah[4], al[4];
#pragma unroll
            for (int mt = 0; mt < 4; ++mt) { const v4u x = *(const v4u*)(rin + (size_t)(tile * 64 + 16 * mt + r) * D + c0);
                const f32x4 xa = (f32x4){bflo(x.x), bfhi(x.x), bflo(x.y), bfhi(x.y)}, xc = (f32x4){bflo(x.z), bfhi(x.z), bflo(x.w), bfhi(x.w)};
                const f32x4 y0 = (xa - mean[mt]) * rstd[mt] * g0 + b0, y1 = (xc - mean[mt]) * rstd[mt] * g1 + b1;
                v4u hv, lv;
                hv.x = pk2(y0.x, y0.y); hv.y = pk2(y0.z, y0.w); hv.z = pk2(y1.x, y1.y); hv.w = pk2(y1.z, y1.w);
                lv.x = pk2(y0.x - bflo(hv.x), y0.y - bfhi(hv.x)); lv.y = pk2(y0.z - bflo(hv.y), y0.w - bfhi(hv.y)); lv.z = pk2(y1.x - bflo(hv.z), y1.y - bfhi(hv.z)); lv.w = pk2(y1.z - bflo(hv.w), y1.w - bfhi(hv.w));
                *(v4u*)(xb + (size_t)(tile * 64 + 16 * mt + r) * D + c0) = hv;
                { const f32x4 z0 = y0 * 16.0f, z1 = y1 * 16.0f; int lo_ = __builtin_amdgcn_cvt_pk_fp8_f32(z0.x, z0.y, 0, false); lo_ = __builtin_amdgcn_cvt_pk_fp8_f32(z0.z, z0.w, lo_, true);
                  int hi_ = __builtin_amdgcn_cvt_pk_fp8_f32(z1.x, z1.y, 0, false); hi_ = __builtin_amdgcn_cvt_pk_fp8_f32(z1.z, z1.w, hi_, true);
                  v2u q8; q8.x = (unsigned)lo_; q8.y = (unsigned)hi_; *(v2u*)(xq + (size_t)(tile * 64 + 16 * mt + r) * D + c0) = q8; }
                ah[mt] = __builtin_bit_cast(bf16x8, hv); al[mt] = __builtin_bit_cast(bf16x8, lv); }
#pragma unroll
            for (int nt = 0; nt < 4; ++nt) { const bf16x8 bh = *(const bf16x8*)(WRh + wro + (size_t)(16 * nt) * D + 32 * j), bl = *(const bf16x8*)(WRl + wro + (size_t)(16 * nt) * D + 32 * j);
#pragma unroll
                for (int mt = 0; mt < 4; ++mt) {
                    acc[mt][nt] = __builtin_amdgcn_mfma_f32_16x16x32_bf16(ah[mt], bh, acc[mt][nt], 0, 0, 0);
                    acc[mt][nt] = __builtin_amdgcn_mfma_f32_16x16x32_bf16(al[mt], bh, acc[mt][nt], 0, 0, 0);
                    acc[mt][nt] = __builtin_amdgcn_mfma_f32_16x16x32_bf16(ah[mt], bl, acc[mt][nt], 0, 0, 0); } }
            asm volatile("" ::: "memory"); }
#pragma unroll
        for (int hf = 0; hf < 2; ++hf) {
            if (hf) __syncthreads();
#pragma unroll
            for (int mt = 0; mt < 2; ++mt)
#pragma unroll
                for (int nt = 0; nt < 4; ++nt)
#pragma unroll
                    for (int i = 0; i < 4; ++i) PL[(w * 32 + 16 * mt + 4 * q + i) * 65 + 16 * nt + r] = acc[2 * hf + mt][nt][i];
            __syncthreads();
#pragma unroll 1
            for (int tt = 0; tt < 4; ++tt) {
                const int tk = 4 * w + tt, g = ln >> 3;
                float lgt = 0.f;
#pragma unroll
                for (int w2 = 0; w2 < 8; ++w2) lgt += PL[(w2 * 32 + tk) * 65 + ln];
                const float sg = 1.0f / (1.0f + __expf(-lgt)), c = sg + ebias[ln];
                const float m1 = grp8_max(c);
                const unsigned long long bm = __ballot(c == m1);
                const unsigned gm = (unsigned)(bm >> (8 * g)) & 0xffu;
                const int first = __builtin_ctz(gm | 0x100u);
                const float m2 = grp8_max(((ln & 7) == first) ? -INFINITY : c);
                const float gs = m1 + m2;
                unsigned selg = 0u;
#pragma unroll
                for (int k = 0; k < 4; ++k) { const float v = ((selg >> g) & 1u) ? -INFINITY : gs; const float best = wave_max(v); const unsigned long long b2 = __ballot(v == best); selg |= 1u << (__builtin_ctzll(b2 | (1ull << 63)) >> 3); }
                float cc = ((selg >> g) & 1u) ? c : -INFINITY;
                int me = 0; float mw = 0.f, ssum = 0.f;
#pragma unroll
                for (int k = 0; k < 8; ++k) { const float best = wave_max(cc); const unsigned long long b3 = __ballot(cc == best); const int es = __builtin_ctzll(b3 | (1ull << 63));
                    const float swk = __builtin_bit_cast(float, __builtin_amdgcn_readlane(__builtin_bit_cast(int, sg), es)); ssum += swk;
                    if (ln == k) { me = es; mw = swk; } if (ln == es) cc = -INFINITY; }
                if (ln < 8) { const int lr = __hip_atomic_fetch_add(Lh + me, 1, __ATOMIC_RELAXED, __HIP_MEMORY_SCOPE_WORKGROUP);
                    Lrec[(itl * 32 + tk) * 8 + ln] = me | (lr << 8); Lrw[(itl * 32 + tk) * 8 + ln] = mw * (ROUTED_SCALE / ssum); }
            }
            if (itl == 0) tile0 = tile * 2;
            ++itl;
        }
        LNR_FLUSH();
    }
#undef LNR_FLUSH
    __syncthreads();
}

__device__ __forceinline__ void moe_tables(Frame& F, int layer, int NPN, bool fresh) {
    LAS int* lc = (LAS int*)(F.lds + LT_CNT); LAS int* rb = (LAS int*)(F.lds + LT_RB); LAS int* tp = (LAS int*)(F.lds + LT_TP); LAS int* tab = (LAS int*)(F.lds + LT_UNITS); LAS int* nun = (LAS int*)(F.lds + LT_NUNITS);
    const unsigned* cnt = F.ctl + CW_CNT + layer * NE * CNT_STRIDE;
    __syncthreads();
    if (fresh || MK_N_LAUNCHES != 1) {
    if (F.tid < NEA) lc[F.tid] = F.tid < NE ? (int)__hip_atomic_load(cnt + F.tid * CNT_STRIDE, __ATOMIC_RELAXED, __HIP_MEMORY_SCOPE_AGENT) : T;
    __syncthreads();
    if (F.tid <= NEA) { int run = 0, tiles = 0; for (int e = 0; e < F.tid; ++e) { const int c = lc[e]; run += c; tiles += (c + 255) >> 8; } rb[F.tid] = run; tp[F.tid] = tiles; }
    __syncthreads();
    }
    if (NPN > 0 && F.tid < 64) {
        const int total = tp[NEA] * NPN, qq = total / 8, rr = total % 8, i = F.tid;
        const long L = (long)i * F.G + (int)blockIdx.x;
        if (L < total) {
            const int xcd = (int)(L % 8), off = (int)(L / 8);
            const int up = (xcd < rr ? xcd * (qq + 1) : rr * (qq + 1) + (xcd - rr) * qq) + off;
            const int rt = up / NPN, pn = up % NPN;
            int lo = 0, hi = NEA;
            while (hi - lo > 1) { const int mid = (lo + hi) >> 1; if (tp[mid] <= rt) lo = mid; else hi = mid; }
            const int e = lo, mt = rt - tp[e], c = lc[e];
            tab[5 * i + 0] = e; tab[5 * i + 1] = mt; tab[5 * i + 2] = pn; tab[5 * i + 3] = (c - mt * 256) < 256 ? (c - mt * 256) : 256; tab[5 * i + 4] = rb[e] + mt * 256;
        }
        if (i == 0) { const long rem = (long)total - (int)blockIdx.x; int n = rem > 0 ? (int)((rem + F.G - 1) / F.G) : 0; nun[0] = n < 64 ? n : 64; }
    }
    if (NPN == 0 && F.tid == 0) nun[0] = 0;
    __syncthreads();
}

__device__ __forceinline__ void p_combine_ln(Frame& F, const bf16* xres, const float* lg, const float* lbias, float* of, bf16* ob, int layer) {
    moe_tables(F, layer, 0, false);
    const LAS int* rb = (const LAS int*)(F.lds + LT_RB);
    const int gw = F.vcu * NWAVES + F.wave, NGW = F.G * NWAVES;
    const unsigned char* Y = (const unsigned char*)(F.ws + WS_RA); const unsigned* aes = (const unsigned*)(F.ws + WS_AES); const float* aw = (const float*)(F.ws + WS_AW);
    for (int t = gw; t < T; t += NGW) {
        int ln = F.lane; OPAQUE(ln);
        unsigned es = 0u; float wv = 0.f;
        if (F.lane < 8) { es = aes[(size_t)t * 8 + F.lane]; wv = aw[(size_t)t * 8 + F.lane]; }
        int rowk[9]; float wk[9];
#pragma unroll
        for (int k = 0; k < 8; ++k) { const unsigned x = (unsigned)__shfl((int)es, k); wk[k] = __shfl(wv, k); rowk[k] = rb[x >> 16] + (int)(x & 0xffffu); }
#pragma unroll
        for (int k = 0; k < 8; ++k) wk[k] *= (1.0f / 16.0f);
        rowk[8] = T * TOPK + t; wk[8] = 1.0f / 16.0f;
        float v[32];
#pragma unroll
        for (int jj = 0; jj < 4; ++jj) { const int c0 = 512 * jj + 8 * ln;
            const v4u a = *(const v4u*)(xres + (size_t)t * D + c0);
            v[8 * jj + 0] = ALPHA * bflo(a.x); v[8 * jj + 1] = ALPHA * bfhi(a.x); v[8 * jj + 2] = ALPHA * bflo(a.y); v[8 * jj + 3] = ALPHA * bfhi(a.y); v[8 * jj + 4] = ALPHA * bflo(a.z); v[8 * jj + 5] = ALPHA * bfhi(a.z); v[8 * jj + 6] = ALPHA * bflo(a.w); v[8 * jj + 7] = ALPHA * bfhi(a.w); }
#pragma unroll
        for (int k = 0; k < 9; ++k) { const unsigned char* yr = Y + (size_t)rowk[k] * D + 8 * ln; const float w = wk[k];
#pragma unroll
            for (int jj = 0; jj < 4; ++jj) { const v2u p = *(const v2u*)(yr + 512 * jj);
                typedef float f32x2_ __attribute__((ext_vector_type(2)));
                const f32x2_ a0 = __builtin_amdgcn_cvt_pk_f32_fp8((int)p.x, false), a1 = __builtin_amdgcn_cvt_pk_f32_fp8((int)p.x, true), a2 = __builtin_amdgcn_cvt_pk_f32_fp8((int)p.y, false), a3 = __builtin_amdgcn_cvt_pk_f32_fp8((int)p.y, true);
                v[8 * jj + 0] += w * a0.x; v[8 * jj + 1] += w * a0.y; v[8 * jj + 2] += w * a1.x; v[8 * jj + 3] += w * a1.y; v[8 * jj + 4] += w * a2.x; v[8 * jj + 5] += w * a2.y; v[8 * jj + 6] += w * a3.x; v[8 * jj + 7] += w * a3.y; }
            if ((k % 3) == 2) asm volatile("" ::: "memory"); }
        float s = 0.f;
#pragma unroll
        for (int i = 0; i < 32; ++i) s += v[i];
        const float mean = wave_sum(s) * (1.0f / D); float qv = 0.f;
#pragma unroll
        for (int i = 0; i < 32; ++i) { const float d = v[i] - mean; qv += d * d; }
        const float rstd = __builtin_amdgcn_rsqf(wave_sum(qv) * (1.0f / D) + LN_EPS);
#pragma unroll
        for (int jj = 0; jj < 4; ++jj) { const int c0 = 512 * jj + 8 * ln;
            const f32x4 g0 = *(const f32x4*)(lg + c0), g1 = *(const f32x4*)(lg + c0 + 4), b0 = *(const f32x4*)(lbias + c0), b1 = *(const f32x4*)(lbias + c0 + 4);
            f32x4 y0, y1;
            y0.x = (v[8 * jj + 0] - mean) * rstd * g0.x + b0.x; y0.y = (v[8 * jj + 1] - mean) * rstd * g0.y + b0.y; y0.z = (v[8 * jj + 2] - mean) * rstd * g0.z + b0.z; y0.w = (v[8 * jj + 3] - mean) * rstd * g0.w + b0.w;
            y1.x = (v[8 * jj + 4] - mean) * rstd * g1.x + b1.x; y1.y = (v[8 * jj + 5] - mean) * rstd * g1.y + b1.y; y1.z = (v[8 * jj + 6] - mean) * rstd * g1.z + b1.z; y1.w = (v[8 * jj + 7] - mean) * rstd * g1.w + b1.w;
            if (of) { *(f32x4*)(of + (size_t)t * D + c0) = y0; *(f32x4*)(of + (size_t)t * D + c0 + 4) = y1; }
            if (ob) { v4u w; w.x = pk2_sw(y0.x, y0.y); w.y = pk2_sw(y0.z, y0.w); w.z = pk2_sw(y1.x, y1.y); w.w = pk2_sw(y1.z, y1.w); *(v4u*)(ob + (size_t)t * D + c0) = w;
                      const f32x4 z0 = y0 * 16.0f, z1 = y1 * 16.0f; int lo_ = __builtin_amdgcn_cvt_pk_fp8_f32(z0.x, z0.y, 0, false); lo_ = __builtin_amdgcn_cvt_pk_fp8_f32(z0.z, z0.w, lo_, true);
                      int hi_ = __builtin_amdgcn_cvt_pk_fp8_f32(z1.x, z1.y, 0, false); hi_ = __builtin_amdgcn_cvt_pk_fp8_f32(z1.z, z1.w, hi_, true);
                      v2u q8; q8.x = (unsigned)lo_; q8.y = (unsigned)hi_; *(v2u*)(F.ws + WS_XQ + (size_t)t * D + c0) = q8; } }
    }
}

typedef float f32x2_t __attribute__((ext_vector_type(2)));
__device__ __forceinline__ v2u f8_pack8(const float (&x)[8]) { v2u r; int lo = __builtin_amdgcn_cvt_pk_fp8_f32(x[0] * 8.f, x[1] * 8.f, 0, false); lo = __builtin_amdgcn_cvt_pk_fp8_f32(x[2] * 8.f, x[3] * 8.f, lo, true);
    int hi = __builtin_amdgcn_cvt_pk_fp8_f32(x[4] * 8.f, x[5] * 8.f, 0, false); hi = __builtin_amdgcn_cvt_pk_fp8_f32(x[6] * 8.f, x[7] * 8.f, hi, true); r.x = (unsigned)lo; r.y = (unsigned)hi; return r; }
__device__ __forceinline__ void f8_unpack8(v2u p, float (&x)[8]) { const f32x2_t a0 = __builtin_amdgcn_cvt_pk_f32_fp8((int)p.x, false), a1 = __builtin_amdgcn_cvt_pk_f32_fp8((int)p.x, true), a2 = __builtin_amdgcn_cvt_pk_f32_fp8((int)p.y, false), a3 = __builtin_amdgcn_cvt_pk_f32_fp8((int)p.y, true);
    x[0] = a0.x * 0.125f; x[1] = a0.y * 0.125f; x[2] = a1.x * 0.125f; x[3] = a1.y * 0.125f; x[4] = a2.x * 0.125f; x[5] = a2.y * 0.125f; x[6] = a3.x * 0.125f; x[7] = a3.y * 0.125f; }
__device__ __forceinline__ int kslot(int k) { const int kk = k & 31; return (k & ~31) + 8 * ((kk & 15) >> 2) + 4 * (kk >> 4) + (kk & 3); }
__device__ __forceinline__ bf16x8 pack8(const f32x4& a, const f32x4& b) { v4u w; w.x = pk2(a[0], a[1]); w.y = pk2(a[2], a[3]); w.z = pk2(b[0], b[1]); w.w = pk2(b[2], b[3]); return __builtin_bit_cast(bf16x8, w); }
__device__ __forceinline__ void p_hgrn_intra(Frame& F) {
    const bf16* Q = (const bf16*)(F.ws + WS_HQ); const bf16* Kk = (const bf16*)(F.ws + WS_HK); const bf16* V = (const bf16*)(F.ws + WS_HV); const _Float16* LF = (const _Float16*)(F.ws + WS_HF);
    bf16* QD = (bf16*)(F.ws + WS_HQD); unsigned char* UT = (unsigned char*)(F.ws + WS_HUT); bf16* OI = (bf16*)(F.ws + WS_HOI); float* DT = (float*)(F.ws + WS_HDT);
    LAS unsigned char* L = F.lds + RING_OFF;
    constexpr int O_KDT = 0, O_VT = 18432, O_KH = 36864, O_QIJ = 54272, O_QST = 97792, O_GT = 114176, O_PA = 116736  , PC = 144, PT = 272;
    const int k = F.tid & 127, tq = __builtin_amdgcn_readfirstlane(F.tid >> 7), r = F.lane & 15, q = F.lane >> 4, w = F.wave;
    const int ks_ = kslot(k);
    float plf[16]; unsigned short pq[16], pv[16];
#define INTRA_LOAD(uu) do { const int bh_ = (uu) >> 6, c_ = (uu) & 63; const size_t base_ = (size_t)((bh_ >> 4) * SEQ + c_ * 64 + 16 * tq) * D + (bh_ & 15) * HD + k; \
        _Pragma("unroll") for (int i = 0; i < 16; ++i) { plf[i] = (float)LF[base_ + (size_t)i * D]; pq[i] = Q[base_ + (size_t)i * D]; pv[i] = V[base_ + (size_t)i * D]; } } while (0)
    if (F.vcu < NB * NH * 64) INTRA_LOAD(F.vcu);
    for (int u = F.vcu; u < NB * NH * 64; u += F.G) {
        float Bl[16], qv[16], kv[16]; unsigned vv[8]; float run = 0.f;
#pragma unroll
        for (int i = 0; i < 16; ++i) { run += plf[i]; Bl[i] = run; qv[i] = bf2f(pq[i]); kv[i] = 1.0f - __expf(plf[i]); }
#pragma unroll
        for (int i = 0; i < 8; ++i) vv[i] = (unsigned)pv[2 * i] | ((unsigned)pv[2 * i + 1] << 16);
        LBAR();
        ((LAS float*)(L + O_GT))[tq * 128 + k] = run;
        LBAR();
        const float g0 = ((LAS float*)(L + O_GT))[k], g1 = ((LAS float*)(L + O_GT))[128 + k], g2 = ((LAS float*)(L + O_GT))[256 + k], g3 = ((LAS float*)(L + O_GT))[384 + k];
        const float Rq = (tq > 0 ? g0 : 0.f) + (tq > 1 ? g1 : 0.f) + (tq > 2 ? g2 : 0.f), Btot = (g0 + g1) + (g2 + g3);
        { unsigned kd[8];
#pragma unroll
          for (int i = 0; i < 8; ++i) kd[i] = pk2(kv[2 * i] * __expf(Btot - Rq - Bl[2 * i]), kv[2 * i + 1] * __expf(Btot - Rq - Bl[2 * i + 1]));
          LAS v4u* pk_ = (LAS v4u*)(L + O_KDT + k * PC + 32 * tq); v4u a; a.x = kd[0]; a.y = kd[1]; a.z = kd[2]; a.w = kd[3]; pk_[0] = a; a.x = kd[4]; a.y = kd[5]; a.z = kd[6]; a.w = kd[7]; pk_[1] = a;
          LAS v4u* pv_ = (LAS v4u*)(L + O_VT + k * PC + 32 * tq); a.x = vv[0]; a.y = vv[1]; a.z = vv[2]; a.w = vv[3]; pv_[0] = a; a.x = vv[4]; a.y = vv[5]; a.z = vv[6]; a.w = vv[7]; pv_[1] = a; }
        { const float eR = __expf(Rq);
          const float f0 = __expf(Rq), f1 = __expf(Rq - g0), f2 = __expf(Rq - g0 - g1);
#pragma unroll
          for (int i = 0; i < 16; ++i) { const float eb = __expf(Bl[i]), qt = qv[i] * eb, kh = kv[i] * __expf(fminf(-Bl[i], 80.f));
              *(LAS unsigned short*)(L + O_KH + (16 * tq + i) * PT + k * 2) = (unsigned short)f2bf(kh);
              *(LAS unsigned short*)(L + O_QST + (16 * tq + i) * 256 + ks_ * 2) = (unsigned short)f2bf(qt * eR);
              const int blk0 = tq * (tq + 1) / 2;
              *(LAS unsigned short*)(L + O_QIJ + (blk0 + tq) * (16 * PT) + i * PT + k * 2) = (unsigned short)f2bf(qt);
              if (tq > 0) *(LAS unsigned short*)(L + O_QIJ + (blk0 + 0) * (16 * PT) + i * PT + k * 2) = (unsigned short)f2bf(qt * f0);
              if (tq > 1) *(LAS unsigned short*)(L + O_QIJ + (blk0 + 1) * (16 * PT) + i * PT + k * 2) = (unsigned short)f2bf(qt * f1);
              if (tq > 2) *(LAS unsigned short*)(L + O_QIJ + (blk0 + 2) * (16 * PT) + i * PT + k * 2) = (unsigned short)f2bf(qt * f2); }
          if (tq == 0) DT[(size_t)u * 128 + ks_] = __expf(Btot); }
        LBAR();
        if (u + F.G < NB * NH * 64) INTRA_LOAD(u + F.G);
        { const LAS v4u* src = (const LAS v4u*)(L + O_QST) + 2 * F.tid; v4u* dst = (v4u*)(QD + (size_t)u * 64 * 128) + 2 * F.tid; const v4u a = src[0], bq = src[1]; dst[0] = a; dst[1] = bq; }
        { f32x4 aU[8];
#pragma unroll
          for (int a = 0; a < 8; ++a) aU[a] = (f32x4){0.f, 0.f, 0.f, 0.f};
#pragma unroll
          for (int ts = 0; ts < 2; ++ts) { const bf16x8 bv = *(const LAS bf16x8*)(L + O_VT + (16 * w + r) * PC + (32 * ts + 8 * q) * 2);
#pragma unroll
              for (int a = 0; a < 8; ++a) { const bf16x8 av = *(const LAS bf16x8*)(L + O_KDT + (16 * a + r) * PC + (32 * ts + 8 * q) * 2); aU[a] = __builtin_amdgcn_mfma_f32_16x16x32_bf16(av, bv, aU[a], 0, 0, 0); } }
#pragma unroll
          for (int ks = 0; ks < 4; ++ks) { const float x8[8] = {aU[2 * ks][0], aU[2 * ks][1], aU[2 * ks][2], aU[2 * ks][3], aU[2 * ks + 1][0], aU[2 * ks + 1][1], aU[2 * ks + 1][2], aU[2 * ks + 1][3]};
              *(v2u*)(UT + ((size_t)u * 128 + 16 * w + r) * 128 + 32 * ks + 8 * q) = f8_pack8(x8); } }
        if (w < 6) {
            const int i = w == 0 ? 0 : (w == 1 ? 1 : (w <= 3 ? 2 : 3)), pr = (w == 3 || w == 5) ? 1 : 0;
            f32x4 pa = (f32x4){0.f, 0.f, 0.f, 0.f}, pb = (f32x4){0.f, 0.f, 0.f, 0.f};
            { const int j = 2 * pr;
#pragma unroll
              for (int ks = 0; ks < 4; ++ks) { const bf16x8 av = *(const LAS bf16x8*)(L + O_KH + (16 * j + r) * PT + (32 * ks + 8 * q) * 2);
                  const bf16x8 bv = *(const LAS bf16x8*)(L + O_QIJ + (i * (i + 1) / 2 + j) * (16 * PT) + r * PT + (32 * ks + 8 * q) * 2);
                  pa = __builtin_amdgcn_mfma_f32_16x16x32_bf16(av, bv, pa, 0, 0, 0); }
              if (j == i) {
#pragma unroll
                  for (int e = 0; e < 4; ++e) pa[e] = (4 * q + e <= r) ? pa[e] : 0.f; } }
            if (2 * pr + 1 <= i) { const int j = 2 * pr + 1;
#pragma unroll
              for (int ks = 0; ks < 4; ++ks) { const bf16x8 av = *(const LAS bf16x8*)(L + O_KH + (16 * j + r) * PT + (32 * ks + 8 * q) * 2);
                  const bf16x8 bv = *(const LAS bf16x8*)(L + O_QIJ + (i * (i + 1) / 2 + j) * (16 * PT) + r * PT + (32 * ks + 8 * q) * 2);
                  pb = __builtin_amdgcn_mfma_f32_16x16x32_bf16(av, bv, pb, 0, 0, 0); }
              if (j == i) {
#pragma unroll
                  for (int e = 0; e < 4; ++e) pb[e] = (4 * q + e <= r) ? pb[e] : 0.f; } }
            *(LAS bf16x8*)(L + O_PA + (w * 64 + F.lane) * 16) = pack8(pa, pb);
        }
        LBAR();
#pragma unroll
        for (int i = 0; i < 4; ++i) {
            f32x4 o = (f32x4){0.f, 0.f, 0.f, 0.f};
#pragma unroll
            for (int pr = 0; pr < 2; ++pr) if (2 * pr <= i) {
                const int c = (i == 0 ? 0 : (i == 1 ? 1 : (i == 2 ? 2 : 4))) + pr;
                const bf16x8 av = *(const LAS bf16x8*)(L + O_PA + (c * 64 + F.lane) * 16);
                const v2u blo = *(const LAS v2u*)(L + O_VT + (16 * w + r) * PC + (32 * pr + 4 * q) * 2), bhi = *(const LAS v2u*)(L + O_VT + (16 * w + r) * PC + (32 * pr + 16 + 4 * q) * 2);
                v4u bw; bw.x = blo.x; bw.y = blo.y; bw.z = bhi.x; bw.w = bhi.y;
                o = __builtin_amdgcn_mfma_f32_16x16x32_bf16(av, __builtin_bit_cast(bf16x8, bw), o, 0, 0, 0); }
            { v2u ob; ob.x = pk2(o[0], o[1]); ob.y = pk2(o[2], o[3]); *(v2u*)(OI + (((size_t)u * 8 + w) * 4 + i) * 256 + F.lane * 4) = ob; }
        }
    }
#undef INTRA_LOAD
    __syncthreads();
}
constexpr size_t WS_HS = WS_XR;
__device__ __forceinline__ void p_hgrn_state(Frame& F) {
    const unsigned char* UT = (const unsigned char*)(F.ws + WS_HUT); const float* DT = (const float*)(F.ws + WS_HDT); unsigned char* HS = (unsigned char*)(F.ws + WS_HS);
    for (int unit = (int)blockIdx.x; unit < NB * NH * 4; unit += F.G) {
        int tid_ = F.tid; OPAQUE(tid_);
        const int bh = unit >> 2, vq = unit & 3, v = 32 * vq + (tid_ >> 4), s8 = 8 * (tid_ & 15);
        float S[8];
#pragma unroll
        for (int e = 0; e < 8; ++e) S[e] = 0.f;
        for (int c0 = 0; c0 < 64; c0 += 8) {
            v2u uu[8]; f32x4 d0[8], d1[8];
#pragma unroll
            for (int i = 0; i < 8; ++i) { const size_t u = (size_t)bh * 64 + c0 + i; uu[i] = *(const v2u*)(UT + (u * 128 + v) * 128 + s8); d0[i] = *(const f32x4*)(DT + u * 128 + s8); d1[i] = *(const f32x4*)(DT + u * 128 + s8 + 4); }
#pragma unroll
            for (int i = 0; i < 8; ++i) { const size_t u = (size_t)bh * 64 + c0 + i;
                *(v2u*)(HS + (u * 128 + v) * 128 + s8) = f8_pack8(S);
                float ux[8]; f8_unpack8(uu[i], ux);
                S[0] = d0[i].x * S[0] + ux[0]; S[1] = d0[i].y * S[1] + ux[1]; S[2] = d0[i].z * S[2] + ux[2]; S[3] = d0[i].w * S[3] + ux[3];
                S[4] = d1[i].x * S[4] + ux[4]; S[5] = d1[i].y * S[5] + ux[5]; S[6] = d1[i].z * S[6] + ux[6]; S[7] = d1[i].w * S[7] + ux[7]; }
        }
    }
}
struct OutPf { v4u q[2], g[2]; v2u s[4], o[4]; };
__device__ __forceinline__ unsigned f8_pack4c(unsigned a, unsigned b) { const float x0 = fminf(fmaxf(bflo(a) * 8.f, -448.f), 448.f), x1 = fminf(fmaxf(bfhi(a) * 8.f, -448.f), 448.f), x2 = fminf(fmaxf(bflo(b) * 8.f, -448.f), 448.f), x3 = fminf(fmaxf(bfhi(b) * 8.f, -448.f), 448.f);
    int p = __builtin_amdgcn_cvt_pk_fp8_f32(x0, x1, 0, false); p = __builtin_amdgcn_cvt_pk_fp8_f32(x2, x3, p, true); return (unsigned)p; }
__device__ __forceinline__ void p_hgrn_out(Frame& F, const Args& A) {
    const bf16* QD = (const bf16*)(F.ws + WS_HQD); const unsigned char* HS = (const unsigned char*)(F.ws + WS_HS); const bf16* OI = (const bf16*)(F.ws + WS_HOI);
    const bf16* Gt = (const bf16*)(F.ws + WS_HG); unsigned char* O = (unsigned char*)(F.ws + WS_HO); const float* normg = A.in[12];
    constexpr int PT = 272, TILE = 64 * PT, O_Q = 0, O_G = 2 * TILE, O_O = 4 * TILE, O_S = 5 * TILE;
    LAS unsigned char* L = F.lds + RING_OFF;
    const int w = F.wave;
    const int NU = NB * NH * 64, nu = (NU - F.vcu + F.G - 1) / F.G;
    const float ng = normg[16 * w + (F.lane & 15)];
    OutPf pa, pb;
#define OUT_T0(i) ((((F.vcu + (i) * F.G) >> 6) >> 4) * SEQ + ((F.vcu + (i) * F.G) & 63) * 64)
#define OUT_H(i) (((F.vcu + (i) * F.G) >> 6) & 15)
#define OUT_LOAD(P, i) do { const size_t u_ = (size_t)(F.vcu + (i) * F.G); const int t0_ = OUT_T0(i), h_ = OUT_H(i); \
        const v4u* q_ = (const v4u*)(QD + (u_ * 64 + row) * 128 + seg * 16); P.q[0] = q_[0]; P.q[1] = q_[1]; \
        const v4u* g_ = (const v4u*)(Gt + (size_t)(t0_ + row) * D + h_ * HD + seg * 16); P.g[0] = g_[0]; P.g[1] = g_[1]; \
        _Pragma("unroll") for (int ti = 0; ti < 4; ++ti) P.o[ti] = *(const v2u*)(OI + ((u_ * 8 + w) * 4 + ti) * 256 + (tid_ & 63) * 4); \
        _Pragma("unroll") for (int ks = 0; ks < 4; ++ks) P.s[ks] = *(const v2u*)(HS + (u_ * 128 + 16 * w + r) * 128 + 32 * ks + 8 * q); } while (0)
#define OUT_STORE(i) do { const LAS v4u* so_ = (const LAS v4u*)(L + O_O + row * PT + seg * 32); const v4u a0_ = so_[0], a1_ = so_[1]; \
        v4u pk_; pk_.x = f8_pack4c(a0_.x, a0_.y); pk_.y = f8_pack4c(a0_.z, a0_.w); pk_.z = f8_pack4c(a1_.x, a1_.y); pk_.w = f8_pack4c(a1_.z, a1_.w); \
        *(v4u*)(O + (size_t)(OUT_T0(i) + row) * D + OUT_H(i) * HD + seg * 16) = pk_; } while (0)
#define OUT_STEP(P, i, par) do { \
        { LAS v4u* dq = (LAS v4u*)(L + O_Q + (par) * TILE + row * PT + seg * 32); dq[0] = P.q[0]; dq[1] = P.q[1]; \
          LAS v4u* dg = (LAS v4u*)(L + O_G + (par) * TILE + row * PT + seg * 32); dg[0] = P.g[0]; dg[1] = P.g[1]; } \
        f32x4 o[4]; bf16x8 sb[4]; \
        _Pragma("unroll") for (int j = 0; j < 4; ++j) { o[j] = (f32x4){bflo(P.o[j].x), bfhi(P.o[j].x), bflo(P.o[j].y), bfhi(P.o[j].y)}; { float sx[8]; f8_unpack8(P.s[j], sx); v4u sw_; sw_.x = pk2(sx[0], sx[1]); sw_.y = pk2(sx[2], sx[3]); sw_.z = pk2(sx[4], sx[5]); sw_.w = pk2(sx[6], sx[7]); sb[j] = __builtin_bit_cast(bf16x8, sw_); } } \
        if ((i) + 2 < nu) OUT_LOAD(P, (i) + 2); \
        LBAR(); \
        if ((i) > 0) OUT_STORE((i) - 1); \
        _Pragma("unroll") for (int ti = 0; ti < 4; ++ti) _Pragma("unroll") for (int ks = 0; ks < 4; ++ks) { \
            const bf16x8 av = *(const LAS bf16x8*)(L + O_Q + (par) * TILE + (16 * ti + r) * PT + (32 * ks + 8 * q) * 2); o[ti] = __builtin_amdgcn_mfma_f32_16x16x32_bf16(av, sb[ks], o[ti], 0, 0, 0); } \
        LAS float* ls = (LAS float*)(L + O_S); \
        _Pragma("unroll") for (int ti = 0; ti < 4; ++ti) _Pragma("unroll") for (int e = 0; e < 4; ++e) { float x = o[ti][e] * o[ti][e]; x += DPP_F(x, 0xB1); x += DPP_F(x, 0x4E); x += DPP_F(x, 0x141); x += DPP_F(x, 0x140); \
                if (r == 0) ls[(16 * ti + 4 * q + e) * 8 + w] = x; } \
        LBAR(); \
        _Pragma("unroll") for (int ti = 0; ti < 4; ++ti) _Pragma("unroll") for (int e = 0; e < 4; ++e) { const int t = 16 * ti + 4 * q + e; const f32x4 p0 = *(const LAS f32x4*)(ls + t * 8), p1 = *(const LAS f32x4*)(ls + t * 8 + 4); \
                const float ms = ((p0.x + p0.y) + (p0.z + p0.w) + (p1.x + p1.y) + (p1.z + p1.w)) * (1.0f / HD); const float rr = __builtin_amdgcn_rsqf(ms + LN_EPS); \
                const float g = bf2f(*(const LAS unsigned short*)(L + O_G + (par) * TILE + t * PT + (16 * w + r) * 2)); \
                *(LAS unsigned short*)(L + O_O + t * PT + (16 * w + r) * 2) = (unsigned short)f2bf(o[ti][e] * rr * ng * g); } \
    } while (0)
#define OUT_IDS() int tid_ = F.tid; OPAQUE(tid_); const int r = tid_ & 15, q = (tid_ >> 4) & 3, row = tid_ >> 3, seg = tid_ & 7
    if (nu > 0) {
        { OUT_IDS(); OUT_LOAD(pa, 0); if (nu > 1) OUT_LOAD(pb, 1); }
        for (int i = 0; i < nu; i += 2) {
            { OUT_IDS(); OUT_STEP(pa, i, 0); }
            if (i + 1 < nu) { OUT_IDS(); OUT_STEP(pb, i + 1, 1); } }
        LBAR();
        { OUT_IDS(); (void)r; (void)q; OUT_STORE(nu - 1); }
        LBAR();
    }
#undef OUT_T0
#undef OUT_H
#undef OUT_LOAD
#undef OUT_STORE
#undef OUT_STEP
#undef OUT_IDS
    __syncthreads();
}

__global__ void __launch_bounds__(NWAVES * 64, 2) mk_fwd(Args args) {
    extern __shared__ __attribute__((aligned(16))) unsigned char lds[];
    Frame F;
    F.lds = (LAS unsigned char*)lds;
    F.tid = threadIdx.x; F.lane = F.tid & 63; F.wave = __builtin_amdgcn_readfirstlane(F.tid >> 6);
    F.G = gridDim.x; { const int bx = blockIdx.x; F.vcu = (F.G % 8 == 0) ? (bx % 8) * (F.G / 8) + bx / 8 : bx; }
    F.ws = args.ws; F.ctl = (unsigned*)(args.ws + WS_CTL);
    const Args& A = args;
    for (int u = F.tid; u < (LDS_BYTES - LDSCTL_OFF) / 4; u += NWAVES * 64) ((LAS unsigned*)(F.lds + LDSCTL_OFF))[u] = 0u;
    __syncthreads();
    XcdBarrier bar; bar.bar = F.ctl + CW_BAR; bar.x = 0; bar.st = nullptr;
    if (N_LAUNCHES == 1) bar = xcd_barrier_post(F.ctl + CW_BAR, (volatile LAS unsigned*)(F.lds + MISC_OFF) + 8);
    const int lo = args.ph_lo, hi = args.ph_hi;
#ifndef PH_MASK
#define PH_MASK 0x3FFFF
#endif
#define IN(k) (((PH_MASK >> (k)) & 1) && lo <= (k) && (k) < hi)
#define SEAM(k) do { if (IN(k) && IN((k) + 1)) xcd_barrier(bar); } while (0)
#ifndef PH_DUP
#define PH_DUP 0
#endif
#define DUPN(k) ((PH_DUP >> (k)) & 1)
#ifndef PH_TIME
#define PH_TIME -1
#endif
    unsigned long long tp0_ = 0ull, tpd_ = 0ull;
#define TBEG(k) do { if (PH_TIME >= 0 && ((PH_TIME >> (k)) & 1)) tp0_ = __builtin_amdgcn_s_memrealtime(); } while (0)
#define TEND(k) do { if (PH_TIME >= 0 && ((PH_TIME >> (k)) & 1)) tpd_ += __builtin_amdgcn_s_memrealtime() - tp0_; } while (0)
#define REP(k, body) { body; if (DUPN(k)) { xcd_barrier(bar); F.refresh(args.ws); body; } }
    LAS unsigned char* ring = F.lds + RING_OFF;

    if (IN(0)) { F.refresh(args.ws); TBEG(0); REP(0, p0_prologue(F, A)) TEND(0); SEAM(0); }
    if (IN(1)) { F.refresh(args.ws); TBEG(1);
        pg8::DenseOrder S; S.init(F.ws + WS_XINB, F.ws + WS_GIN, T, 2 * D, D, F.G, (int)blockIdx.x);
        pg8::EpiGelu E{(bf16*)(F.ws + WS_Z), 2 * D};
        REP(1, (pg8::gemm_phase<pg8::EpiGelu, pg8::DenseOrder, true, true>(ring, D, S, E)))
        TEND(1); SEAM(1);
    }
    if (IN(3)) { F.refresh(args.ws); TBEG(3); REP(3, p_spatial(F, A)) TEND(3); SEAM(3); }
    if (IN(4)) { F.refresh(args.ws); TBEG(4);
        pg8::DenseOrder S; S.init(F.ws + WS_YG, F.ws + WS_GOUT, T, D, D, F.G, (int)blockIdx.x);
        pg8::EpiRes E{(const bf16*)(F.ws + WS_XINB), (bf16*)(F.ws + WS_XR), D, ALPHA, 1.0f};
        pg8::gemm_phase<pg8::EpiRes, pg8::DenseOrder, true, true>(ring, D, S, E);
        TEND(4); SEAM(4);
    }
    if (IN(5)) { F.refresh(args.ws); TBEG(5); p_ln_router(F, A, (const bf16*)(F.ws + WS_XR), A.in[1], A.in[2], (bf16*)(F.ws + WS_XB), F.ws + WS_XQ, 0);
        if (DUPN(5)) { xcd_barrier(bar); if (blockIdx.x == 0 && threadIdx.x < 64) __hip_atomic_store(F.ctl + CW_CNT + threadIdx.x * CNT_STRIDE, 0u, __ATOMIC_RELAXED, __HIP_MEMORY_SCOPE_AGENT); xcd_barrier(bar); F.refresh(args.ws);
            p_ln_router(F, A, (const bf16*)(F.ws + WS_XR), A.in[1], A.in[2], (bf16*)(F.ws + WS_XB), F.ws + WS_XQ, 0); }
        TEND(5); SEAM(5); }
    if (IN(6)) { F.refresh(args.ws); TBEG(6);
        moe_tables(F, 0, 4, true);
        pg8::MoeOrder<true> S{(const LAS int*)(F.lds + LT_UNITS), *(const LAS int*)(F.lds + LT_NUNITS), (const char*)(F.ws + WS_XQ), (const char*)(F.ws + WS_W1), W1_E, D / 2, (const unsigned*)(F.ws + WS_LIST)};
        pg8::EpiMoe1 E{(unsigned char*)(F.ws + WS_HM)};
        int kh_ = D / 2; asm volatile("" : "+s"(kh_));
        REP(6, (pg8::gemm_phase<pg8::EpiMoe1, pg8::MoeOrder<true>, true, true, true>(ring, kh_, S, E)))
        TEND(6); SEAM(6);
    }
    if (IN(7)) { F.refresh(args.ws); TBEG(7);
        moe_tables(F, 0, 8, false);
        pg8::MoeOrder<false> S{(const LAS int*)(F.lds + LT_UNITS), *(const LAS int*)(F.lds + LT_NUNITS), (const char*)(F.ws + WS_HM), (const char*)(F.ws + WS_W2), W2_E, EXD / 2, nullptr};
        pg8::EpiMoe2 E{(unsigned char*)(F.ws + WS_RA), D};
        int kq_ = EXD / 2; asm volatile("" : "+s"(kq_));
        REP(7, (pg8::gemm_phase<pg8::EpiMoe2, pg8::MoeOrder<false>, true, true, true>(ring, kq_, S, E)))
        TEND(7); SEAM(7);
    }
    if (IN(8)) { F.refresh(args.ws); TBEG(8); REP(8, p_combine_ln(F, (const bf16*)(F.ws + WS_XB), A.in[3], A.in[4], nullptr, (bf16*)(F.ws + WS_XB), 0)) TEND(8); SEAM(8); }
    if (IN(9)) { F.refresh(args.ws); TBEG(9);
        pg8::DenseOrder S; S.init(F.ws + WS_XQ, F.ws + WS_HIN, T, 4 * D, D / 2, F.G, (int)blockIdx.x);
        pg8::EpiHgrn E{(bf16*)(F.ws + WS_HQ), (bf16*)(F.ws + WS_HK), (bf16*)(F.ws + WS_HV), (bf16*)(F.ws + WS_HG), (_Float16*)(F.ws + WS_HF), (const float*)(F.ws + WS_LB), D};
        int kh_ = D / 2; asm volatile("" : "+s"(kh_));
        pg8::gemm_phase<pg8::EpiHgrn, pg8::DenseOrder, true, true, true>(ring, kh_, S, E);
        TEND(9); SEAM(9);
    }
    if (IN(10)) { F.refresh(args.ws); TBEG(10); REP(10, p_hgrn_intra(F)) TEND(10); SEAM(10); }
    if (IN(11)) { F.refresh(args.ws); TBEG(11); REP(11, p_hgrn_state(F)) TEND(11); SEAM(11); }
    if (IN(12)) { F.refresh(args.ws); TBEG(12); REP(12, p_hgrn_out(F, A)) TEND(12); SEAM(12); }
    if (IN(13)) { F.refresh(args.ws); TBEG(13);
        pg8::DenseOrder S; S.init(F.ws + WS_HO, F.ws + WS_HOUT, T, D, D / 2, F.G, (int)blockIdx.x);
        pg8::EpiRes E{(const bf16*)(F.ws + WS_XB), (bf16*)(F.ws + WS_XR), D, ALPHA, 1.0f / 4096.0f};
        int kh_ = D / 2; asm volatile("" : "+s"(kh_));
        pg8::gemm_phase<pg8::EpiRes, pg8::DenseOrder, true, true, true>(ring, kh_, S, E);
        TEND(13); SEAM(13);
    }
    if (IN(14)) { F.refresh(args.ws); TBEG(14); p_ln_router(F, A, (const bf16*)(F.ws + WS_XR), A.in[1] + D, A.in[2] + D, (bf16*)(F.ws + WS_XB), F.ws + WS_XQ, 1); TEND(14); SEAM(14); }
    if (IN(15)) { F.refresh(args.ws); TBEG(15);
        moe_tables(F, 1, 4, true);
        pg8::MoeOrder<true> S{(const LAS int*)(F.lds + LT_UNITS), *(const LAS int*)(F.lds + LT_NUNITS), (const char*)(F.ws + WS_XQ), (const char*)(F.ws + WS_W1 + W1_L), W1_E, D / 2, (const unsigned*)(F.ws + WS_LIST)};
        pg8::EpiMoe1 E{(unsigned char*)(F.ws + WS_HM)};
        int kh_ = D / 2; asm volatile("" : "+s"(kh_));
        pg8::gemm_phase<pg8::EpiMoe1, pg8::MoeOrder<true>, true, true, true>(ring, kh_, S, E);
        TEND(15); SEAM(15);
    }
    if (IN(16)) { F.refresh(args.ws); TBEG(16);
        moe_tables(F, 1, 8, false);
        pg8::MoeOrder<false> S{(const LAS int*)(F.lds + LT_UNITS), *(const LAS int*)(F.lds + LT_NUNITS), (const char*)(F.ws + WS_HM), (const char*)(F.ws + WS_W2 + W2_L), W2_E, EXD / 2, nullptr};
        pg8::EpiMoe2 E{(unsigned char*)(F.ws + WS_RA), D};
        int kq_ = EXD / 2; asm volatile("" : "+s"(kq_));
        pg8::gemm_phase<pg8::EpiMoe2, pg8::MoeOrder<false>, true, true, true>(ring, kq_, S, E);
        TEND(16); SEAM(16);
    }
    if (IN(17)) { F.refresh(args.ws); TBEG(17); REP(17, p_combine_ln(F, (const bf16*)(F.ws + WS_XB), A.in[3] + D, A.in[4] + D, A.out, nullptr, 1)) TEND(17); }
    if (PH_TIME >= 0) { const unsigned long long ts_ = __builtin_amdgcn_s_memrealtime(); while (__builtin_amdgcn_s_memrealtime() - ts_ < tpd_) __builtin_amdgcn_s_sleep(8); }
#undef IN
#undef SEAM
}

extern "C" void kernel_launch(void* const* d_in, const int* in_sizes, int n_in, void* d_out, int out_size, void* d_ws, size_t ws_size, hipStream_t stream) {
    static int grid = 0;
    if (grid == 0) {
        if (n_in != 23 || in_sizes[0] != T * D || out_size != T * D || ws_size < WS_END) { fprintf(stderr, "kernel_launch: unexpected shapes (n_in %d, in0 %d, out %d, ws %zu < %zu); nothing launched\n", n_in, n_in > 0 ? in_sizes[0] : -1, out_size, ws_size, (size_t)WS_END); grid = -1; return; }
        int dev = 0, cus = 0, per_cu = 0;
        if (hipGetDevice(&dev) != hipSuccess || hipDeviceGetAttribute(&cus, hipDeviceAttributeMultiprocessorCount, dev) != hipSuccess) { grid = -1; return; }
        if (hipFuncSetAttribute((const void*)mk_fwd, hipFuncAttributeMaxDynamicSharedMemorySize, LDS_BYTES) != hipSuccess) { fprintf(stderr, "kernel_launch: hipFuncSetAttribute failed\n"); grid = -1; return; }
        if (hipOccupancyMaxActiveBlocksPerMultiprocessor(&per_cu, (const void*)mk_fwd, NWAVES * 64, LDS_BYTES) != hipSuccess || per_cu < 1) fprintf(stderr, "kernel_launch: note: occupancy query reports %d\n", per_cu);
        (void)hipGetLastError();
        grid = cus;
    }
    if (grid < 0) return;
    if (hipMemsetAsync((char*)d_ws + WS_CTL, 0, CTL_ZERO_BYTES, stream) != hipSuccess) return;
    Args a{};
    for (int i = 0; i < 23; ++i) a.in[i] = (const float*)d_in[i];
    a.out = (float*)d_out; a.ws = (unsigned char*)d_ws;
    for (int li = 0; li < N_LAUNCHES; ++li) {
        if (N_LAUNCHES == 1) { a.ph_lo = 0; a.ph_hi = N_PHASES; } else { a.ph_lo = li; a.ph_hi = li + 1; }
        hipLaunchKernelGGL(mk_fwd, dim3(grid), dim3(NWAVES * 64), LDS_BYTES, stream, a);
        if (hipPeekAtLastError() != hipSuccess) { fprintf(stderr, "kernel_launch: launch %d failed\n", li); break; }
    }
}
```

```cpp
#include <hip/hip_runtime.h>
#include <cstdio>
#include <cstdint>

#ifndef MK_N_LAUNCHES
#define MK_N_LAUNCHES 1
#endif

namespace pg8 {
#define PG8_LAS __attribute__((address_space(3)))
typedef unsigned short bf16_t;
typedef short bf16x8 __attribute__((ext_vector_type(8)));
typedef float f32x4 __attribute__((ext_vector_type(4)));
typedef float f32x2 __attribute__((ext_vector_type(2)));
typedef unsigned u32x4 __attribute__((ext_vector_type(4)));
constexpr int BM = 256, BK = 64, HALF = 128, HTB = HALF * BK * 2  , STAGE_BYTES = 8 * HTB, NXCD = 8, WGM = 8;

__host__ __device__ __forceinline__ int lds_byte(int r, int c) { const int st = (r >> 4) * 2 + (c >> 5), rr = r & 15, cc = c & 31, ob = rr * 64 + cc * 2; return st * 1024 + (ob ^ (((ob >> 9) & 1) << 5)); }
__host__ __device__ __forceinline__ void stage_rc(int b, int& R, int& C) { const int st = b / 1024, sb = b % 1024, swz = sb ^ (((sb >> 9) & 1) << 5); R = (st >> 1) * 16 + swz / 64; C = (st & 1) * 32 + (swz % 64) / 2; }
__host__ __device__ __forceinline__ int perm32(int rho) { const int n = rho >> 4, i = rho & 15; return 8 * (i >> 2) + 4 * n + (i & 3); }

struct Unit { int pm, pn, e, rows, orow; };

struct DenseOrder {
    static constexpr bool GATHER = false;
    const char* A; const char* Bt; int K, nM, nN, nwg, G, c;
    __device__ void init(const void* A_, const void* Bt_, int M, int N, int K_, int G_, int c_) { A = (const char*)A_; Bt = (const char*)Bt_; K = K_; nM = M / BM; nN = N / BM; nwg = nM * nN; G = G_; c = c_; }
    __device__ bool next(int i, Unit& u) const {
        const long L = (long)i * G + c; if (L >= nwg) return false;
        int wgid = (int)L; { const int q = nwg / NXCD, r = nwg % NXCD, xcd = wgid % NXCD, off = wgid / NXCD; wgid = (xcd < r ? xcd * (q + 1) : r * (q + 1) + (xcd - r) * q) + off; }
        const int nig = WGM * nN, gid = wgid / nig, fm = gid * WGM, gsz = (nM - fm) < WGM ? (nM - fm) : WGM;
        u.pm = fm + ((wgid % nig) % gsz); u.pn = (wgid % nig) / gsz; u.e = 0; u.rows = BM; u.orow = u.pm * BM; return true;
    }
    __device__ __forceinline__ const char* a_ptr(const Unit& u) const { return A + (size_t)u.pm * BM * K * 2; }
    __device__ __forceinline__ const char* b_ptr(const Unit& u) const { return Bt + (size_t)u.pn * BM * K * 2; }
    __device__ __forceinline__ int tok(const Unit&, int) const { return 0; }
};
template <bool GATHER_> struct MoeOrder {
    static constexpr bool GATHER = GATHER_;
    const PG8_LAS int* tab; int n;
    const char* A; const char* Bt; size_t b_estride; int K; const unsigned* list;
    __device__ bool next(int i, Unit& u) const { if (i >= n) return false; const PG8_LAS int* t = tab + 5 * i; u.e = t[0]; u.pm = t[1]; u.pn = t[2]; u.rows = t[3]; u.orow = t[4]; return true; }
    __device__ __forceinline__ const char* a_ptr(const Unit& u) const { return GATHER ? A : A + (size_t)u.orow * K * 2; }
    __device__ __forceinline__ const char* b_ptr(const Unit& u) const { return Bt + (size_t)u.e * b_estride + (size_t)u.pn * BM * K * 2; }
    __device__ __forceinline__ int tok(const Unit& u, int row) const { if (u.e >= 64) return u.pm * BM + row; return row < u.rows ? (int)list[(size_t)u.e * 16384 + u.pm * BM + row] : 0; }
};

__device__ __forceinline__ unsigned cvt_pk_bf16(float lo, float hi) { unsigned r; asm volatile("v_cvt_pk_bf16_f32 %0, %1, %2" : "=v"(r) : "v"(lo), "v"(hi)); return r; }
__device__ __forceinline__ f32x2 gelu_pk(f32x2 v) {
    const f32x2 av = __builtin_elementwise_abs(v), d = av * 0.2316418882f + 1.0f;
    f32x2 t; t.x = __builtin_amdgcn_rcpf(d.x); t.y = __builtin_amdgcn_rcpf(d.y);
    f32x2 q = t * 0.5307027145f + (-0.7265760135f); q = q * t + 0.7107068705f; q = q * t + (-0.142248368f); q = q * t + 0.127414796f; q = q * t;
    const f32x2 s = (v * v) * (-0.72134752044f);
    f32x2 e; e.x = __builtin_amdgcn_exp2f(s.x); e.y = __builtin_amdgcn_exp2f(s.y);
    const f32x2 m = v * (q * e), r = v - m;
    f32x2 o; o.x = v.x < 0.f ? m.x : r.x; o.y = v.y < 0.f ? m.y : r.y; return o;
}
__device__ __forceinline__ float sigmoidf_(float x) { return __builtin_amdgcn_rcpf(1.0f + __expf(-x)); }

struct EpiGelu {
    static constexpr bool PERM = true; static constexpr bool PERM64 = false; static constexpr int NST = 16;
    bf16_t* O; int ldc;
    __device__ __forceinline__ void operator()(const f32x4 (&acc)[2][2][4][2], const Unit& u, int wr, int wc, int fr, int fq) const {
        const int row0 = u.pm * BM + wr * 64 + fr, col0 = u.pn * BM + wc * 32 + 8 * fq;
#pragma unroll
        for (int ai = 0; ai < 2; ++ai)
#pragma unroll
            for (int m = 0; m < 4; ++m) { bf16_t* rowp = O + (size_t)(row0 + ai * HALF + m * 16) * ldc + col0;
#pragma unroll
                for (int bj = 0; bj < 2; ++bj) { const f32x4 v0 = acc[ai][bj][m][0], v1 = acc[ai][bj][m][1];
                    const f32x2 a = gelu_pk((f32x2){v0[0], v0[1]}), b = gelu_pk((f32x2){v0[2], v0[3]}), c = gelu_pk((f32x2){v1[0], v1[1]}), d = gelu_pk((f32x2){v1[2], v1[3]});
                    u32x4 w; w.x = cvt_pk_bf16(a.x, a.y); w.y = cvt_pk_bf16(b.x, b.y); w.z = cvt_pk_bf16(c.x, c.y); w.w = cvt_pk_bf16(d.x, d.y);
                    *(u32x4*)(rowp + bj * HALF) = w; } }
    }
};
struct EpiRes {
    static constexpr bool PERM = true; static constexpr bool PERM64 = false; static constexpr int NST = 16;
    const bf16_t* res; bf16_t* out; int ldc; float alpha; float sc;
    __device__ __forceinline__ void operator()(const f32x4 (&acc)[2][2][4][2], const Unit& u, int wr, int wc, int fr, int fq) const {
        const int row0 = u.pm * BM + wr * 64 + fr, col0 = u.pn * BM + wc * 32 + 8 * fq;
#pragma unroll
        for (int ai = 0; ai < 2; ++ai)
#pragma unroll
            for (int m = 0; m < 4; ++m) { const size_t off = (size_t)(row0 + ai * HALF + m * 16) * ldc + col0;
#pragma unroll
                for (int bj = 0; bj < 2; ++bj) { const u32x4 rr = *(const u32x4*)(res + off + bj * HALF); const f32x4 v0 = acc[ai][bj][m][0] * sc, v1 = acc[ai][bj][m][1] * sc;
                    u32x4 w;
                    w.x = cvt_pk_bf16(alpha * __builtin_bit_cast(float, rr.x << 16) + v0[0], alpha * __builtin_bit_cast(float, rr.x & 0xffff0000u) + v0[1]);
                    w.y = cvt_pk_bf16(alpha * __builtin_bit_cast(float, rr.y << 16) + v0[2], alpha * __builtin_bit_cast(float, rr.y & 0xffff0000u) + v0[3]);
                    w.z = cvt_pk_bf16(alpha * __builtin_bit_cast(float, rr.z << 16) + v1[0], alpha * __builtin_bit_cast(float, rr.z & 0xffff0000u) + v1[1]);
                    w.w = cvt_pk_bf16(alpha * __builtin_bit_cast(float, rr.w << 16) + v1[2], alpha * __builtin_bit_cast(float, rr.w & 0xffff0000u) + v1[3]);
                    *(u32x4*)(out + off + bj * HALF) = w; }
                if (m & 1) asm volatile("" ::: "memory"); }
    }
};
struct EpiHgrn {
    static constexpr bool PERM = true; static constexpr bool PERM64 = false; static constexpr int NST = 16;
    bf16_t* Q; bf16_t* Kk; bf16_t* V; bf16_t* G; _Float16* F; const float* lb; int D;
    __device__ __forceinline__ void operator()(const f32x4 (&acc)[2][2][4][2], const Unit& u, int wr, int wc, int fr, int fq) const {
        const int kind = u.pn / (D / BM);
        const int row0 = u.pm * BM + wr * 64 + fr, col0 = (u.pn % (D / BM)) * BM + wc * 32 + 8 * fq;
        if (kind == 1) {
#pragma unroll
            for (int bj = 0; bj < 2; ++bj) {
                const f32x4 l0 = *(const f32x4*)(lb + col0 + bj * HALF), l1 = *(const f32x4*)(lb + col0 + bj * HALF + 4);
#pragma unroll
                for (int ai = 0; ai < 2; ++ai)
#pragma unroll
                    for (int m = 0; m < 4; ++m) { const size_t off = (size_t)(row0 + ai * HALF + m * 16) * D + col0 + bj * HALF;
                        f32x4 fo[2];
#pragma unroll
                        for (int j = 0; j < 4; ++j) { const float s0 = sigmoidf_(acc[ai][bj][m][0][j] * (1.0f / 8192.0f)), s1 = sigmoidf_(acc[ai][bj][m][1][j] * (1.0f / 8192.0f));
                            fo[0][j] = __logf(l0[j] + (1.0f - l0[j]) * s0); fo[1][j] = __logf(l1[j] + (1.0f - l1[j]) * s1); }
                        { typedef _Float16 h8 __attribute__((ext_vector_type(8))); h8 hv; hv[0] = (_Float16)fo[0][0]; hv[1] = (_Float16)fo[0][1]; hv[2] = (_Float16)fo[0][2]; hv[3] = (_Float16)fo[0][3]; hv[4] = (_Float16)fo[1][0]; hv[5] = (_Float16)fo[1][1]; hv[6] = (_Float16)fo[1][2]; hv[7] = (_Float16)fo[1][3];
                          *(h8*)(F + off) = hv; }
                        asm volatile("" ::: "memory"); } }
        } else {
            bf16_t* O = kind == 0 ? Q : (kind == 2 ? V : G);
            const bool act = kind != 2;
#pragma unroll
            for (int ai = 0; ai < 2; ++ai)
#pragma unroll
                for (int m = 0; m < 4; ++m) { const size_t off = (size_t)(row0 + ai * HALF + m * 16) * D + col0;
#pragma unroll
                    for (int bj = 0; bj < 2; ++bj) { f32x4 o[2];
#pragma unroll
                        for (int n = 0; n < 2; ++n)
#pragma unroll
                            for (int j = 0; j < 4; ++j) { const float x = acc[ai][bj][m][n][j] * (1.0f / 8192.0f); o[n][j] = act ? x * sigmoidf_(x) : x; }
                        u32x4 w; w.x = cvt_pk_bf16(o[0][0], o[0][1]); w.y = cvt_pk_bf16(o[0][2], o[0][3]); w.z = cvt_pk_bf16(o[1][0], o[1][1]); w.w = cvt_pk_bf16(o[1][2], o[1][3]);
                        *(u32x4*)(O + off + bj * HALF) = w; } }
        }
    }
};
struct EpiMoe1 {
    static constexpr bool PERM = true; static constexpr bool PERM64 = false; static constexpr int NST = 8;
    unsigned char* H;
    __device__ __forceinline__ void operator()(const f32x4 (&acc)[2][2][4][2], const Unit& u, int wr, int wc, int fr, int fq) const {
        const int col0 = u.pn * HALF + wc * 32 + 8 * fq;
#pragma unroll
        for (int ai = 0; ai < 2; ++ai)
#pragma unroll
            for (int m = 0; m < 4; ++m) { const int r = ai * HALF + wr * 64 + m * 16 + fr;
                f32x4 o[2];
#pragma unroll
                for (int n = 0; n < 2; ++n)
#pragma unroll
                    for (int j = 0; j < 4; ++j) { const float g = acc[ai][0][m][n][j] * (1.0f / 8192.0f); o[n][j] = g * sigmoidf_(g) * acc[ai][1][m][n][j] * (8.0f / 8192.0f); }
                int lo = __builtin_amdgcn_cvt_pk_fp8_f32(o[0][0], o[0][1], 0, false); lo = __builtin_amdgcn_cvt_pk_fp8_f32(o[0][2], o[0][3], lo, true);
                int hi = __builtin_amdgcn_cvt_pk_fp8_f32(o[1][0], o[1][1], 0, false); hi = __builtin_amdgcn_cvt_pk_fp8_f32(o[1][2], o[1][3], hi, true);
                typedef int i32x2 __attribute__((ext_vector_type(2))); i32x2 w; w.x = lo; w.y = hi;
                if (r < u.rows) *(i32x2*)(H + (size_t)(u.orow + r) * 512 + col0) = w; }
    }
};
struct EpiMoe2 {
    static constexpr bool PERM = true; static constexpr bool PERM64 = true; static constexpr int NST = 8;
    unsigned char* Y; int ldc;
    __device__ __forceinline__ void operator()(const f32x4 (&acc)[2][2][4][2], const Unit& u, int wr, int wc, int fr, int fq) const {
        int col0 = u.pn * BM + wc * 64 + 16 * fq; asm volatile("" : "+v"(col0));
        int rb_ = wr * 64 + fr; asm volatile("" : "+v"(rb_));
        const float sc = 16.0f / 4096.0f;
#pragma unroll
        for (int ai = 0; ai < 2; ++ai)
#pragma unroll
            for (int m = 0; m < 4; ++m) { const int r = ai * HALF + m * 16 + rb_;
                typedef int i32x4 __attribute__((ext_vector_type(4))); i32x4 w;
#pragma unroll
                for (int bj = 0; bj < 2; ++bj)
#pragma unroll
                    for (int n = 0; n < 2; ++n) { const f32x4 v = acc[ai][bj][m][n] * sc;
                        int p_ = __builtin_amdgcn_cvt_pk_fp8_f32(v[0], v[1], 0, false); p_ = __builtin_amdgcn_cvt_pk_fp8_f32(v[2], v[3], p_, true); w[2 * bj + n] = p_; }
                if (r < u.rows) *(i32x4*)(Y + (size_t)(u.orow + r) * ldc + col0) = w; }
    }
};

template <class Epi, class Sched, bool ALIGN_EPI, bool SP2, bool F8 = false>
__device__ __forceinline__ void gemm_phase(PG8_LAS unsigned char* lds, const int K, const Sched& S, const Epi& E) {
    constexpr bool GATHER = Sched::GATHER;
    constexpr bool OVL = SP2 && !GATHER;
    const int tid = threadIdx.x, wid = __builtin_amdgcn_readfirstlane(tid >> 6), lane = tid & 63, wr = wid >> 2, wc = wid & 3, fr = lane & 15, fq = lane >> 4;
    const int nt = K / BK;
    unsigned voffA[2][2], voffB[2];
#pragma unroll
    for (int i = 0; i < 2; ++i) { int R, C; stage_rc(tid * 16 + i * 8192, R, C); const int Rb = Epi::PERM ? ((R & ~31) + perm32(R & 31)) : R;
        const int Rh = Epi::PERM64 ? (64 * (R >> 5) + 16 * ((R & 15) >> 2) + 4 * ((R >> 4) & 1) + (R & 3)) : Rb;
        voffA[0][i] = (unsigned)(R * K + C) * 2u; voffA[1][i] = voffA[0][i]; voffB[i] = (unsigned)(Rh * K + C) * 2u; }
    const size_t kstep = (size_t)(BK * 2);
    const size_t hstep = (size_t)HALF * K * 2;
    const unsigned ldsw = (unsigned)wid * 1024u;
    const int aoff = lds_byte(wr * 64 + fr, fq * 8), boff = lds_byte(wc * 32 + fr, fq * 8);
#define PG8_SA(b, h) (((b) * 2 + (h)) * HTB)
#define PG8_SB(b, h) ((4 + (b) * 2 + (h)) * HTB)
#define PG8_GLDS(gptr, ldsoff) __builtin_amdgcn_global_load_lds((const unsigned*)(gptr), (PG8_LAS unsigned*)(lds + (ldsoff)), 16, 0, 0)
#define PG8_GLDS_S(sbase, voff, ldsoff) do { unsigned keep_; const unsigned la_ = (unsigned)(size_t)(lds + (ldsoff)); const char* sb_ = (sbase); \
        asm volatile("s_nop 4\n\ts_mov_b32 %0, m0\n\ts_mov_b32 m0, %3\n\ts_nop 0\n\tglobal_load_lds_dwordx4 %1, %2\n\ts_mov_b32 m0, %0" : "=&s"(keep_) : "v"(voff), "s"(sb_), "s"(la_) : "memory"); } while (0)
#define PG8_STAGE_B(b, h, kptr) do { _Pragma("unroll") for (int _i = 0; _i < 2; ++_i) PG8_GLDS_S((kptr) + (Epi::PERM64 ? (size_t)(h) * 8 * K * 2 : (size_t)(h) * hstep), voffB[_i], PG8_SB(b, h) + ldsw + _i * 8192); } while (0)
#define PG8_STAGE_A(b, h, kptr) do { _Pragma("unroll") for (int _i = 0; _i < 2; ++_i) { if constexpr (GATHER) PG8_GLDS_S((kptr), voffA[h][_i], PG8_SA(b, h) + ldsw + _i * 8192); else PG8_GLDS_S((kptr) + (size_t)(h) * hstep, voffA[0][_i], PG8_SA(b, h) + ldsw + _i * 8192); } } while (0)
#define PG8_LDA(dst, b, h) do { _Pragma("unroll") for (int m = 0; m < 4; ++m) { dst[m].lo = *(const PG8_LAS i32x4_*)(lds + PG8_SA(b, h) + aoff + m * 2048); dst[m].hi = *(const PG8_LAS i32x4_*)(lds + PG8_SA(b, h) + aoff + m * 2048 + 1024); } } while (0)
#define PG8_LDB(dst, b, h) do { _Pragma("unroll") for (int n = 0; n < 2; ++n) { dst[n].lo = *(const PG8_LAS i32x4_*)(lds + PG8_SB(b, h) + boff + n * 2048); dst[n].hi = *(const PG8_LAS i32x4_*)(lds + PG8_SB(b, h) + boff + n * 2048 + 1024); } } while (0)
#define PG8_MMA(ai, bj, At, Bt) do { __builtin_amdgcn_s_setprio(1); _Pragma("unroll") for (int m = 0; m < 4; ++m) _Pragma("unroll") for (int n = 0; n < 2; ++n) { \
          if constexpr (F8) {   \
              acc[ai][bj][m][n] = __builtin_amdgcn_mfma_scale_f32_16x16x128_f8f6f4(Bt[n], At[m], acc[ai][bj][m][n], 0, 0, 0, 0x7F7F7F7F, 0, 0x7F7F7F7F); } \
          else { acc[ai][bj][m][n] = __builtin_amdgcn_mfma_f32_16x16x32_bf16(__builtin_bit_cast(bf16x8, __builtin_shufflevector(Bt[n], Bt[n], 0, 1, 2, 3)), __builtin_bit_cast(bf16x8, __builtin_shufflevector(At[m], At[m], 0, 1, 2, 3)), acc[ai][bj][m][n], 0, 0, 0); \
                 acc[ai][bj][m][n] = __builtin_amdgcn_mfma_f32_16x16x32_bf16(__builtin_bit_cast(bf16x8, __builtin_shufflevector(Bt[n], Bt[n], 4, 5, 6, 7)), __builtin_bit_cast(bf16x8, __builtin_shufflevector(At[m], At[m], 4, 5, 6, 7)), acc[ai][bj][m][n], 0, 0, 0); } } __builtin_amdgcn_s_setprio(0); } while (0)
#define PG8_WAIT_V(n) asm volatile("s_waitcnt vmcnt(" #n ")" ::: "memory")
#define PG8_WAIT_L(n) asm volatile("s_waitcnt lgkmcnt(" #n ")" ::: "memory")
#define PG8_WAIT_VB(fbi) do { if constexpr (Epi::NST == 8) asm volatile("s_waitcnt vmcnt(16)\n\ts_cmp_lg_u32 %0, 0\n\ts_cbranch_scc1 1f\n\ts_waitcnt vmcnt(8)\n1:" :: "s"(fbi) : "memory", "scc"); \
        else asm volatile("s_waitcnt vmcnt(24)\n\ts_cmp_lg_u32 %0, 0\n\ts_cbranch_scc1 1f\n\ts_waitcnt vmcnt(8)\n1:" :: "s"(fbi) : "memory", "scc"); } while (0)
#define PG8_GLDS_S_COND(skip, sbase, voff, ldsoff) do { unsigned keep_; const unsigned la_ = (unsigned)(size_t)(lds + (ldsoff)); const char* sb_ = (sbase); \
        asm volatile("s_cmp_lg_u32 %4, 0\n\ts_cbranch_scc1 2f\n\ts_nop 4\n\ts_mov_b32 %0, m0\n\ts_mov_b32 m0, %3\n\ts_nop 0\n\tglobal_load_lds_dwordx4 %1, %2\n\ts_mov_b32 m0, %0\n2:" : "=&s"(keep_) : "v"(voff), "s"(sb_), "s"(la_), "s"(skip) : "memory", "scc"); } while (0)
#define PG8_STAGE_A_COND(skip, b, h, kptr) do { _Pragma("unroll") for (int _i = 0; _i < 2; ++_i) { if constexpr (GATHER) PG8_GLDS_S_COND(skip, (kptr), voffA[h][_i], PG8_SA(b, h) + ldsw + _i * 8192); else PG8_GLDS_S_COND(skip, (kptr) + (size_t)(h) * hstep, voffA[0][_i], PG8_SA(b, h) + ldsw + _i * 8192); } } while (0)
#define PG8_BAR __builtin_amdgcn_s_barrier()
#define PG8_SCHED __builtin_amdgcn_sched_barrier(0)
#define PG8_LOAD_OFFS(dst, unit) do { _Pragma("unroll") for (int _i = 0; _i < 2; ++_i) { int R_, C_; stage_rc(tid * 16 + _i * 8192, R_, C_); \
            _Pragma("unroll") for (int _h = 0; _h < 2; ++_h) dst[_h][_i] = (unsigned)S.tok(unit, _h * HALF + R_) * (unsigned)(K * 2) + (unsigned)(C_ * 2); } \
        asm volatile("s_waitcnt vmcnt(0)" ::: "memory"); } while (0)
    Unit cur, nxt; int ui = 0; int bump = 0;
    if (!S.next(0, cur)) return;
    f32x4 acc[2][2][4][2];
#pragma unroll
    for (int a = 0; a < 2; ++a)
#pragma unroll
        for (int b = 0; b < 2; ++b)
#pragma unroll
            for (int m = 0; m < 4; ++m)
#pragma unroll
                for (int n = 0; n < 2; ++n) acc[a][b][m][n] = (f32x4){0.f, 0.f, 0.f, 0.f};
    typedef int i32x8_ __attribute__((ext_vector_type(8))); typedef int i32x4_ __attribute__((ext_vector_type(4)));
    i32x8_ At[4], B0[2], B1[2];
    const char* cA = S.a_ptr(cur); const char* cB = S.b_ptr(cur);
    if constexpr (GATHER) { PG8_LOAD_OFFS(voffA, cur); }
    if constexpr (SP2) {
        PG8_STAGE_B(0, 0, cB); PG8_STAGE_B(0, 1, cB); PG8_STAGE_A(0, 0, cA); PG8_STAGE_A(0, 1, cA);
        if (wr == 1) PG8_BAR;
        PG8_WAIT_V(2); PG8_BAR;
        PG8_STAGE_B(1, 0, cB + kstep); PG8_STAGE_A(1, 0, cA + kstep); PG8_STAGE_B(1, 1, cB + kstep);
        PG8_WAIT_V(6); PG8_BAR;
    } else {
        PG8_STAGE_B(0, 0, cB); PG8_STAGE_A(0, 0, cA); PG8_STAGE_B(0, 1, cB); PG8_STAGE_A(0, 1, cA);
        if (wr == 1) PG8_BAR;
        PG8_WAIT_V(4); PG8_BAR;
        PG8_STAGE_B(1, 0, cB + kstep); PG8_STAGE_A(1, 0, cA + kstep); PG8_STAGE_B(1, 1, cB + kstep);
        PG8_WAIT_V(6); PG8_BAR;
    }
    for (;;) {
        const bool has_next = S.next(ui + 1, nxt);
        const char* nA = has_next ? S.a_ptr(nxt) : cA; const char* nB = has_next ? S.b_ptr(nxt) : cB;
        int tf = 1;
        for (int t = 0; t < nt; t += 2) {
            const bool last = (t == nt - 2);
            const char* a1 = cA + (size_t)(t + 1) * kstep;
            const char* a2 = last ? nA : cA + (size_t)(t + 2) * kstep; const char* b2 = last ? nB : cB + (size_t)(t + 2) * kstep;
            const char* a3 = a2 + kstep; const char* b3 = b2 + kstep;
            if constexpr (SP2) {
            int fb = 0, skipA = 0;
            if constexpr (OVL) { asm volatile("" : "+s"(tf));
                fb = __builtin_amdgcn_readfirstlane(tf & bump); skipA = __builtin_amdgcn_readfirstlane(tf & (ui > 0 ? 1 : 0)); }
            PG8_LDB(B0, 0, 0); PG8_LDB(B1, 0, 1); PG8_SCHED; PG8_LDA(At, 0, 0); if constexpr (OVL) PG8_STAGE_A_COND(skipA, 1, 1, a1); else PG8_STAGE_A(1, 1, a1);
            if constexpr (GATHER) { if (last && has_next) { PG8_LOAD_OFFS(voffA, nxt); } }
            if constexpr (OVL) PG8_WAIT_VB(fb); else PG8_WAIT_V(8); PG8_WAIT_L(0); PG8_BAR; PG8_MMA(0, 0, At, B0); PG8_MMA(0, 1, At, B1); PG8_BAR; PG8_SCHED;
            PG8_LDA(At, 0, 1); PG8_STAGE_B(0, 0, b2); PG8_STAGE_B(0, 1, b2); PG8_STAGE_A(0, 0, a2);
            if constexpr (OVL) PG8_WAIT_VB(fb); else PG8_WAIT_V(8); PG8_WAIT_L(0); PG8_BAR; PG8_MMA(1, 0, At, B0); PG8_MMA(1, 1, At, B1); PG8_BAR; PG8_SCHED;
            PG8_LDB(B0, 1, 0); PG8_LDB(B1, 1, 1); PG8_SCHED; PG8_LDA(At, 1, 0); PG8_STAGE_A(0, 1, a2);
            if constexpr (OVL) PG8_WAIT_VB(fb); else PG8_WAIT_V(8); PG8_WAIT_L(0); PG8_BAR; PG8_MMA(0, 0, At, B0); PG8_MMA(0, 1, At, B1); PG8_BAR; PG8_SCHED;
            PG8_LDA(At, 1, 1); PG8_STAGE_B(1, 0, b3); PG8_STAGE_B(1, 1, b3); PG8_STAGE_A(1, 0, a3);
            PG8_WAIT_V(8); PG8_WAIT_L(0); PG8_BAR; PG8_MMA(1, 0, At, B0); PG8_MMA(1, 1, At, B1); PG8_BAR; PG8_SCHED;
            tf = 0;
            } else {
            PG8_LDB(B0, 0, 0); PG8_SCHED; PG8_LDA(At, 0, 0); PG8_STAGE_A(1, 1, a1);
            if constexpr (GATHER) { if (last && has_next) { PG8_LOAD_OFFS(voffA, nxt); } }
            PG8_WAIT_L(8); PG8_BAR; PG8_WAIT_L(0); PG8_MMA(0, 0, At, B0); PG8_BAR; PG8_SCHED;
            PG8_LDB(B1, 0, 1); PG8_STAGE_B(0, 0, b2);
            PG8_BAR; PG8_WAIT_L(0); PG8_MMA(0, 1, At, B1); PG8_BAR;
            PG8_LDA(At, 0, 1); PG8_STAGE_A(0, 0, a2);
            PG8_BAR; PG8_WAIT_L(0); PG8_MMA(1, 0, At, B0); PG8_BAR; PG8_SCHED;
            PG8_STAGE_B(0, 1, b2);
            PG8_WAIT_V(6); PG8_BAR; PG8_MMA(1, 1, At, B1); PG8_BAR;
            PG8_LDB(B0, 1, 0); PG8_SCHED; PG8_LDA(At, 1, 0); PG8_STAGE_A(0, 1, a2);
            PG8_WAIT_L(8); PG8_BAR; PG8_WAIT_L(0); PG8_MMA(0, 0, At, B0); PG8_BAR; PG8_SCHED;
            PG8_LDB(B1, 1, 1); PG8_STAGE_B(1, 0, b3);
            PG8_BAR; PG8_WAIT_L(0); PG8_MMA(0, 1, At, B1); PG8_BAR;
            PG8_LDA(At, 1, 1); PG8_STAGE_A(1, 0, a3);
            PG8_BAR; PG8_WAIT_L(0); PG8_MMA(1, 0, At, B0); PG8_BAR; PG8_SCHED;
            PG8_STAGE_B(1, 1, b3);
            PG8_WAIT_V(6); PG8_BAR; PG8_MMA(1, 1, At, B1); PG8_BAR;
            }
        }
        if constexpr (ALIGN_EPI) { if (wr == 0) PG8_BAR; }
        if constexpr (OVL) { if (has_next) PG8_STAGE_A(1, 1, nA + kstep); }
        E(acc, cur, wr, wc, fr, fq);
        if (!has_next) break;
        bump = __builtin_amdgcn_readfirstlane((OVL && cur.rows == BM) ? 1 : 0);
#pragma unroll
        for (int a = 0; a < 2; ++a)
#pragma unroll
            for (int b = 0; b < 2; ++b)
#pragma unroll
                for (int m = 0; m < 4; ++m)
#pragma unroll
                    for (int n = 0; n < 2; ++n) acc[a][b][m][n] = (f32x4){0.f, 0.f, 0.f, 0.f};
        cur = nxt; cA = nA; cB = nB; ++ui;
        if constexpr (ALIGN_EPI) { if (wr == 1) PG8_BAR; }
    }
    PG8_WAIT_V(0);
    if constexpr (!ALIGN_EPI) { if (wr == 0) PG8_BAR; }
    PG8_BAR;
#undef PG8_SA
#undef PG8_SB
#undef PG8_GLDS
#undef PG8_GLDS_S
#undef PG8_STAGE_A
#undef PG8_STAGE_B
#undef PG8_LDA
#undef PG8_LDB
#undef PG8_MMA
#undef PG8_WAIT_V
#undef PG8_WAIT_VB
#undef PG8_GLDS_S_COND
#undef PG8_STAGE_A_COND
#undef PG8_WAIT_L
#undef PG8_BAR
#undef PG8_SCHED
#undef PG8_LOAD_OFFS
}
}

constexpr int NWAVES = 8;
constexpr int N_LAUNCHES = MK_N_LAUNCHES;
constexpr int N_PHASES = 18;
constexpr int T = 16384, D = 2048, SEQ = 4096, NB = 4;
constexpr int NE = 64, NEA = 65, TOPK = 8, EXD = 512;
constexpr int NH = 16, HD = 128;
constexpr float LN_EPS = 1e-5f;
constexpr float ALPHA = 1.4142135623730951f;
constexpr float ROUTED_SCALE = 2.5f;
constexpr int NROWS = T * TOPK + T;

constexpr size_t MiB = 1u << 20;
constexpr size_t WS_CTL = 0, CTL_ZERO_BYTES = 1 * MiB;
constexpr size_t WS_LB = 1 * MiB;
constexpr size_t WS_VST = WS_LB + 64 * 1024;
constexpr size_t WS_WSP = 2 * MiB;
constexpr size_t WS_WR = 3 * MiB;
constexpr size_t WS_AES = 4 * MiB;
constexpr size_t WS_AW = 5 * MiB;
constexpr size_t WS_LIST = 6 * MiB;
constexpr size_t WS_GIN = 16 * MiB;
constexpr size_t WS_GOUT = WS_GIN + 16 * MiB;
constexpr size_t WS_HIN = WS_GOUT + 8 * MiB;
constexpr size_t WS_HOUT = WS_HIN + 32 * MiB;
constexpr size_t WS_W1 = WS_HOUT + 8 * MiB;
constexpr size_t W1_E = (size_t)1024 * 2048 * 2, W1_L = NEA * W1_E;
constexpr size_t WS_W2 = WS_W1 + 2 * W1_L;
constexpr size_t W2_E = (size_t)2048 * 512 * 2, W2_L = NEA * W2_E;
constexpr size_t WS_XA = WS_W2 + 2 * W2_L;
constexpr size_t WS_XR = WS_XA + 128 * MiB;
constexpr size_t WS_XB = WS_XR + 128 * MiB;
constexpr size_t WS_HM = WS_XB + 64 * MiB;
constexpr size_t WS_RA = WS_HM + 145 * MiB;
constexpr size_t WS_END = WS_RA + 576 * MiB;
constexpr size_t WS_XINB = WS_RA;
constexpr size_t WS_Z = WS_RA + 64 * MiB;
constexpr size_t WS_YG = WS_RA + 192 * MiB;
constexpr size_t WS_HQ = WS_RA, WS_HK = WS_RA + 64 * MiB, WS_HV = WS_RA + 128 * MiB, WS_HG = WS_RA + 192 * MiB;
constexpr size_t WS_HF = WS_RA + 256 * MiB;
constexpr size_t WS_HO = WS_RA + 384 * MiB;
constexpr size_t WS_HQD = WS_RA + 448 * MiB;
constexpr size_t WS_HDT = WS_RA + 512 * MiB;
constexpr size_t WS_HUT = WS_XA;
constexpr size_t WS_XQ = WS_XA + 64 * MiB;
constexpr size_t WS_HOI = WS_HM;
static_assert((size_t)(NROWS + 256) * 512 * 2 <= 145 * MiB && (size_t)NROWS * D * 2 <= 576 * MiB && WS_END <= 2040 * MiB, "d_ws map");
constexpr int CW_BAR = 4096;
constexpr int CW_CNT = 16384;
constexpr int CNT_STRIDE = 16;

constexpr int RING_OFF = 0, RING_BYTES = 131072;
constexpr int LDSCTL_OFF = RING_BYTES;
constexpr int MISC_OFF = LDSCTL_OFF;
constexpr int LT_RB = LDSCTL_OFF + 256;
constexpr int LT_CNT = LDSCTL_OFF + 576;
constexpr int LT_NUNITS = LDSCTL_OFF + 896;
constexpr int LT_TP = LDSCTL_OFF + 2560;
constexpr int LT_UNITS = LDSCTL_OFF + 1024;
constexpr int LDS_BYTES = 147456;

#define GAS __attribute__((address_space(1)))
#define LAS __attribute__((address_space(3)))
typedef unsigned short bf16;
typedef unsigned v4u __attribute__((ext_vector_type(4)));
typedef unsigned v2u __attribute__((ext_vector_type(2)));
typedef float f32x4 __attribute__((ext_vector_type(4)));
typedef short bf16x8 __attribute__((ext_vector_type(8)));
#define LDS_WAIT() asm volatile("s_waitcnt lgkmcnt(0)" ::: "memory")
#define VM_WAIT() asm volatile("s_waitcnt vmcnt(0)" ::: "memory")
#define LBAR() asm volatile("s_waitcnt lgkmcnt(0)\n\ts_barrier" ::: "memory")
typedef __bf16 bf16x2n_t __attribute__((ext_vector_type(2))); typedef float f32x2n_t __attribute__((ext_vector_type(2)));
__device__ __forceinline__ unsigned pk2(float lo, float hi) { return __builtin_bit_cast(unsigned, __builtin_convertvector((f32x2n_t){lo, hi}, bf16x2n_t)); }
__device__ __forceinline__ unsigned f2bf(float f) { return (unsigned)__builtin_bit_cast(unsigned short, (__bf16)f); }
__device__ __forceinline__ unsigned pk2_sw(float lo, float hi) { const unsigned a = __builtin_bit_cast(unsigned, lo), b = __builtin_bit_cast(unsigned, hi); return ((a + 0x7fffu + ((a >> 16) & 1u)) >> 16) | (((b + 0x7fffu + ((b >> 16) & 1u)) >> 16) << 16); }
__device__ __forceinline__ float bflo(unsigned w) { return __builtin_bit_cast(float, w << 16); }
__device__ __forceinline__ float bfhi(unsigned w) { return __builtin_bit_cast(float, w & 0xffff0000u); }
__device__ __forceinline__ float bf2f(unsigned short h) { return __builtin_bit_cast(float, (unsigned)h << 16); }

#define XB_TMO      128
#define XB_XCNT(j)  (256  + 64 * (j))
#define XB_XSUB(j)  (1280 + 64 * (j))
#define XB_XGEN(j)  (2304 + 64 * (j))
#define XB_TOP      3328
#define XB_TOPGEN   3392
#define XCD_BAR_WORDS 3456
#define XB_SPIN_CAP (1u << 18)
__device__ __forceinline__ unsigned xb_ld(unsigned* p)              { return __hip_atomic_load(p, __ATOMIC_RELAXED, __HIP_MEMORY_SCOPE_AGENT); }
__device__ __forceinline__ unsigned xb_add(unsigned* p, unsigned v) { return __hip_atomic_fetch_add(p, v, __ATOMIC_RELAXED, __HIP_MEMORY_SCOPE_AGENT); }
__device__ __forceinline__ unsigned xb_xcc_id() { return (unsigned)__builtin_amdgcn_s_getreg((3 << 11) | 20) & 0xFu; }
#define XB_SPIN(cond, bar) do { unsigned _sp = 0; while (cond) { __builtin_amdgcn_s_sleep(1); \
    if ((++_sp & 255u) == 0u) { if (xb_ld(&(bar)[XB_TMO])) break; if (_sp > XB_SPIN_CAP) { atomicAdd(&(bar)[XB_TMO], 1u); break; } } } } while (0)
struct XcdBarrier { unsigned* bar; unsigned x; volatile LAS unsigned* st; };
__device__ __forceinline__ XcdBarrier xcd_barrier_post(unsigned* bar, volatile LAS unsigned* st) {
    XcdBarrier b; b.bar = bar; b.x = xb_xcc_id(); b.st = st;
    if (threadIdx.x == 0) (void)xb_add(&bar[XB_XCNT(b.x)], 1u);
    return b;
}
__device__ __forceinline__ void xcd_barrier_complete(unsigned* bar, unsigned x, unsigned& nloc, unsigned& nx) {
    const unsigned G = gridDim.x * gridDim.y * gridDim.z;
    unsigned sum, cnt, mine, sp = 0u;
    for (;;) {
        sum = 0u; cnt = 0u; mine = 0u;
#pragma unroll
        for (unsigned j = 0; j < 16; ++j) { const unsigned c = xb_ld(&bar[XB_XCNT(j)]); sum += c; cnt += (c > 0u) ? 1u : 0u; mine = (j == x) ? c : mine; }
        if (sum == G) break;
        __builtin_amdgcn_s_sleep(1);
        if ((++sp & 255u) == 0u) { if (xb_ld(&bar[XB_TMO])) break; if (sp > XB_SPIN_CAP) { atomicAdd(&bar[XB_TMO], 1u); break; } }
    }
    nloc = mine > 0u ? mine : 1u; nx = cnt > 0u ? cnt : 1u;
}
__device__ __forceinline__ void xcd_barrier(const XcdBarrier& b) {
    asm volatile("s_waitcnt vmcnt(0)" ::: "memory");
    __syncthreads();
    if (threadIdx.x == 0) {
        unsigned* bar = b.bar;
        __builtin_amdgcn_s_waitcnt(0);
        unsigned nloc = b.st[0], nx = b.st[1];
        if (nloc == 0u) { xcd_barrier_complete(bar, b.x, nloc, nx); b.st[0] = nloc; b.st[1] = nx; }
        const unsigned old = xb_add(&bar[XB_XSUB(b.x)], 1u);
        const unsigned gen = old / nloc;
        if (old + 1u == (gen + 1u) * nloc) {
            __builtin_amdgcn_fence(__ATOMIC_RELEASE, "agent");
            asm volatile("s_waitcnt vmcnt(0)" ::: "memory");
            const unsigned og = xb_add(&bar[XB_TOP], 1u);
            const unsigned tg = og / nx;
            if (og + 1u == (tg + 1u) * nx) xb_add(&bar[XB_TOPGEN], 1u);
            else XB_SPIN(xb_ld(&bar[XB_TOPGEN]) == tg, bar);
            __builtin_amdgcn_fence(__ATOMIC_ACQUIRE, "agent");
            xb_add(&bar[XB_XGEN(b.x)], 1u);
            asm volatile("s_waitcnt vmcnt(0)" ::: "memory");
        } else {
            XB_SPIN(xb_ld(&bar[XB_XGEN(b.x)]) == gen, bar);
            __builtin_amdgcn_fence(__ATOMIC_ACQUIRE, "agent");
            asm volatile("s_waitcnt vmcnt(0)" ::: "memory");
        }
    }
    __syncthreads();
}

struct Args { const float* in[23]; float* out; unsigned char* ws; int ph_lo, ph_hi; };
struct Frame {
    LAS unsigned char* lds;
    unsigned* ctl;
    unsigned char* ws;
    int tid, lane, wave, vcu, G;
    __device__ __forceinline__ void refresh(unsigned char* w_) { int t = threadIdx.x; asm volatile("" : "+v"(t)); tid = t; lane = t & 63; wave = __builtin_amdgcn_readfirstlane(t >> 6);
        asm volatile("" : "+s"(w_)); ws = w_; ctl = (unsigned*)(w_ + WS_CTL); }
};
#define DPP_F(v, ctrl) __builtin_bit_cast(float, __builtin_amdgcn_update_dpp(0, __builtin_bit_cast(int, (v)), (ctrl), 0xf, 0xf, true))
__device__ __forceinline__ float wave_sum(float v) {
    v += DPP_F(v, 0xB1); v += DPP_F(v, 0x4E); v += DPP_F(v, 0x141); v += DPP_F(v, 0x140);
    const int iv = __builtin_bit_cast(int, v);
    return (__builtin_bit_cast(float, __builtin_amdgcn_readlane(iv, 0)) + __builtin_bit_cast(float, __builtin_amdgcn_readlane(iv, 16))) + (__builtin_bit_cast(float, __builtin_amdgcn_readlane(iv, 32)) + __builtin_bit_cast(float, __builtin_amdgcn_readlane(iv, 48)));
}
#define OPAQUE(x) asm volatile("" : "+v"(x))

__device__ __forceinline__ void p0_transpose_item(const float* W, int N, int K, bf16* WT, int k0, int n0, int dst_row0, LAS float* scr, int lane) {
#pragma unroll
    for (int i = 0; i < 8; ++i) { const int kk = 8 * i + (lane >> 3), n4 = (lane & 7) * 4; const f32x4 v = *(const f32x4*)(W + (size_t)(k0 + kk) * N + n0 + n4);
        LAS float* d = scr + kk * 33 + n4; d[0] = v.x; d[1] = v.y; d[2] = v.z; d[3] = v.w; }
    LDS_WAIT(); asm volatile("" ::: "memory");
    const int c = lane & 7;
#pragma unroll
    for (int j = 0; j < 4; ++j) { const int n = (lane >> 3) + 8 * j; const LAS float* s = scr + (8 * c) * 33 + n;
        v4u o; o.x = pk2(s[0 * 33], s[1 * 33]); o.y = pk2(s[2 * 33], s[3 * 33]); o.z = pk2(s[4 * 33], s[5 * 33]); o.w = pk2(s[6 * 33], s[7 * 33]);
        *(v4u*)(WT + (size_t)(dst_row0 + n) * K + k0 + 8 * c) = o; }
    LDS_WAIT(); asm volatile("" ::: "memory");
}
struct CvtItem { const float* W; bf16* WT; int N, K, k0, n0, dst0, f8; };
__device__ __forceinline__ CvtItem moe_item(Frame& F, const Args& A, int l, int r) {
    const int e = r / 192, sub = r % 192, part = sub / 64, idx = sub % 64; CvtItem it;
    if (part < 2) {
        it.W = e < NE ? (part == 0 ? A.in[17] : A.in[18]) + (size_t)(l * NE + e) * 2048 * 512 : (part == 0 ? A.in[20] : A.in[21]) + (size_t)l * 2048 * 512;
        const int kb = idx / 4, nb = idx % 4;
        it.WT = (bf16*)(F.ws + WS_W1 + l * W1_L + e * W1_E); it.N = 512; it.K = 2048; it.k0 = 128 * kb; it.n0 = 128 * nb; it.dst0 = nb * 256 + part * 128; it.f8 = 1;
    } else {
        it.W = e < NE ? A.in[19] + (size_t)(l * NE + e) * 512 * 2048 : A.in[22] + (size_t)l * 512 * 2048;
        const int kb = idx / 16, nb = idx % 16;
        it.WT = (bf16*)(F.ws + WS_W2 + l * W2_L + e * W2_E); it.N = 2048; it.K = 512; it.k0 = 128 * kb; it.n0 = 128 * nb; it.dst0 = 128 * nb; it.f8 = 1;
    }
    return it;
}
__device__ __forceinline__ CvtItem cvt_item(Frame& F, const Args& A, int it) {
    constexpr int I0 = 16 * 32, I1 = 16 * 16, I2 = 16 * 64, I3 = 16 * 16;
    int r = it;
    if (r < I0) return CvtItem{A.in[5], (bf16*)(F.ws + WS_GIN), 4096, 2048, 128 * (r / 32), 128 * (r % 32), 128 * (r % 32), 0};
    if ((r -= I0) < I1) return CvtItem{A.in[10], (bf16*)(F.ws + WS_GOUT), 2048, 2048, 128 * (r / 16), 128 * (r % 16), 128 * (r % 16), 1};
    if ((r -= I1) < I2) return CvtItem{A.in[11], (bf16*)(F.ws + WS_HIN), 8192, 2048, 128 * (r / 64), 128 * (r % 64), 128 * (r % 64), 1};
    if ((r -= I2) < I3) return CvtItem{A.in[13], (bf16*)(F.ws + WS_HOUT), 2048, 2048, 128 * (r / 16), 128 * (r % 16), 128 * (r % 16), 1};
    r -= I3; return moe_item(F, A, r / (NEA * 192), r % (NEA * 192));
}
__device__ __forceinline__ void p0_prologue(Frame& F, const Args& A) {
    constexpr int NTILES = 16 * 32 + 16 * 16 + 16 * 64 + 16 * 16 + 2 * NEA * 192;
    LAS unsigned* img = (LAS unsigned*)(F.lds + RING_OFF);
    f32x4 ra0[4], rb0[4], ra1[4], rb1[4];
#define CVT_LOAD(c, ra, rb) do { int t_ = F.tid; OPAQUE(t_); const int kp_ = t_ >> 5, n4_ = t_ & 31; const float* src_ = (c).W + (size_t)((c).k0 + 2 * kp_) * (c).N + (c).n0 + 4 * n4_; \
        _Pragma("unroll") for (int i = 0; i < 4; ++i) { ra[i] = *(const f32x4*)(src_ + (size_t)(32 * i) * (c).N); rb[i] = *(const f32x4*)(src_ + (size_t)(32 * i + 1) * (c).N); } } while (0)
#define CVT_PUT(c, ra, rb, par) do { int t_ = F.tid; OPAQUE(t_); const int kp = t_ >> 5, n4 = t_ & 31; LAS unsigned* ib = img + (par) * 8192; \
          if ((c).f8) {        \
              LAS unsigned short* ih = (LAS unsigned short*)ib; \
              _Pragma("unroll") for (int i = 0; i < 4; ++i) { const int kd = (kp >> 1) + 8 * i, pos = (((kd >> 2) ^ ((n4 >> 2) & 7)) << 2) + ((kd & 3) ^ (n4 & 3)); \
                  _Pragma("unroll") for (int j = 0; j < 4; ++j) ih[((4 * n4 + j) * 32 + pos) * 2 + (kp & 1)] = (unsigned short)__builtin_amdgcn_cvt_pk_fp8_f32(ra[i][j] * 512.0f, rb[i][j] * 512.0f, 0, false); } \
          } else { \
          _Pragma("unroll") for (int i = 0; i < 4; ++i) { const int kd = kp + 16 * i, pos = (((kd >> 2) ^ (n4 & 7)) << 2) + ((kd & 3) ^ ((n4 >> 3) & 3)); \
              _Pragma("unroll") for (int j = 0; j < 4; ++j) ib[(4 * n4 + j) * 64 + pos] = pk2(ra[i][j], rb[i][j]); } } } while (0)
#define CVT_OUT(prev, par) do { int t_ = F.tid; OPAQUE(t_); const LAS unsigned* ib = img + (par) * 8192; \
          if ((prev).f8) { \
              _Pragma("unroll") for (int m = 0; m < 2; ++m) { const int c = t_ + 512 * m, n = c >> 3, kc = c & 7, s01 = (n >> 2) & 3; \
                  const v4u x = *(const LAS v4u*)(ib + n * 32 + ((kc ^ ((n >> 4) & 7)) << 2)); \
                  v4u y; y.x = (s01 & 1) ? x.y : x.x; y.y = (s01 & 1) ? x.x : x.y; y.z = (s01 & 1) ? x.w : x.z; y.w = (s01 & 1) ? x.z : x.w; \
                  v4u z; z.x = (s01 & 2) ? y.z : y.x; z.y = (s01 & 2) ? y.w : y.y; z.z = (s01 & 2) ? y.x : y.z; z.w = (s01 & 2) ? y.y : y.w; \
                  *(v4u*)((unsigned char*)(prev).WT + (size_t)((prev).dst0 + n) * (prev).K + (prev).k0 + 16 * kc) = z; } \
          } else { \
          _Pragma("unroll") for (int m = 0; m < 4; ++m) { const int c = t_ + 512 * m, n = c >> 4, kc = c & 15, s01 = (n >> 5) & 3; \
              const v4u x = *(const LAS v4u*)(ib + n * 64 + ((kc ^ ((n >> 2) & 7)) << 2)); \
              v4u y; y.x = (s01 & 1) ? x.y : x.x; y.y = (s01 & 1) ? x.x : x.y; y.z = (s01 & 1) ? x.w : x.z; y.w = (s01 & 1) ? x.z : x.w; \
              v4u z; z.x = (s01 & 2) ? y.z : y.x; z.y = (s01 & 2) ? y.w : y.y; z.z = (s01 & 2) ? y.x : y.z; z.w = (s01 & 2) ? y.y : y.w; \
              *(v4u*)((prev).WT + (size_t)((prev).dst0 + n) * (prev).K + (prev).k0 + 8 * kc) = z; } } } while (0)
    int itA = F.vcu, itB = F.vcu + F.G;
    CvtItem curA = cvt_item(F, A, itA < NTILES ? itA : 0), curB = cvt_item(F, A, itB < NTILES ? itB : 0);
    if (itA < NTILES) CVT_LOAD(curA, ra0, rb0);
    if (itB < NTILES) CVT_LOAD(curB, ra1, rb1);
    while (itA < NTILES) {
        { CVT_PUT(curA, ra0, rb0, 0); const CvtItem prev = curA; itA += 2 * F.G;
          if (itA < NTILES) { curA = cvt_item(F, A, itA); CVT_LOAD(curA, ra0, rb0); }
          LBAR(); CVT_OUT(prev, 0); }
        if (itB >= NTILES) break;
        { CVT_PUT(curB, ra1, rb1, 1); const CvtItem prev = curB; itB += 2 * F.G;
          if (itB < NTILES) { curB = cvt_item(F, A, itB); CVT_LOAD(curB, ra1, rb1); }
          LBAR(); CVT_OUT(prev, 1); }
    }
#undef CVT_LOAD
#undef CVT_PUT
#undef CVT_OUT
    LBAR();
    const size_t gt = (size_t)F.vcu * (NWAVES * 64) + F.tid, NT = (size_t)F.G * NWAVES * 64;
    { const f32x4* x4 = (const f32x4*)A.in[0]; v4u* o = (v4u*)(F.ws + WS_XINB);
      for (size_t i = gt; i < (size_t)T * D / 8; i += NT) { const f32x4 a = x4[2 * i], b = x4[2 * i + 1]; v4u w; w.x = pk2(a.x, a.y); w.y = pk2(a.z, a.w); w.z = pk2(b.x, b.y); w.w = pk2(b.z, b.w); o[i] = w; } }
    { float* lb = (float*)(F.ws + WS_LB); const float* hb = A.in[14];
      for (size_t i = gt; i < (size_t)D; i += NT) { const float a = hb[i], b = hb[D + i]; lb[i] = 1.0f / (1.0f + __expf(a - b)); } }
    { bf16* wo = (bf16*)(F.ws + WS_WSP); const float* wi = A.in[8];
      for (size_t i = gt; i < (size_t)NH * 128 * 128; i += NT) { const int ii = (int)((i >> 7) & 127), jj = (int)(i & 127); const float v = ((ii >> 6) >= (jj >> 6)) ? wi[i] : 0.0f; wo[i] = (bf16)f2bf(v); } }
    { bf16* wr = (bf16*)(F.ws + WS_WR); const float* wi = A.in[15];
      for (size_t i = gt; i < (size_t)2 * NE * D; i += NT) { const int l = (int)(i / (NE * D)), n = (int)((i / D) % NE), k = (int)(i % D);
          const float w = wi[(size_t)l * D * NE + (size_t)k * NE + n]; const unsigned hi = f2bf(w); const float lo = w - bf2f((unsigned short)hi);
          wr[((size_t)(l * 2 + 0) * NE + n) * D + k] = (bf16)hi; wr[((size_t)(l * 2 + 1) * NE + n) * D + k] = (bf16)f2bf(lo); } }
}

__device__ __forceinline__ void p_vstats(Frame& F) {
    const int gw = F.vcu * NWAVES + F.wave, NGW = F.G * NWAVES;
    const bf16* Z = (const bf16*)(F.ws + WS_Z); float* vst = (float*)(F.ws + WS_VST);
    for (int t = gw; t < T; t += NGW) {
        const v4u* p = (const v4u*)(Z + (size_t)t * 4096 + 2048) + F.lane;
        float v[32]; float s = 0.f;
#pragma unroll
        for (int j = 0; j < 4; ++j) { const v4u w = p[64 * j];
            v[8 * j + 0] = bflo(w.x); v[8 * j + 1] = bfhi(w.x); v[8 * j + 2] = bflo(w.y); v[8 * j + 3] = bfhi(w.y); v[8 * j + 4] = bflo(w.z); v[8 * j + 5] = bfhi(w.z); v[8 * j + 6] = bflo(w.w); v[8 * j + 7] = bfhi(w.w); }
#pragma unroll
        for (int i = 0; i < 32; ++i) s += v[i];
        const float mean = wave_sum(s) * (1.0f / 2048.0f); float q = 0.f;
#pragma unroll
        for (int i = 0; i < 32; ++i) { const float d = v[i] - mean; q += d * d; }
        const float rstd = __builtin_amdgcn_rsqf(wave_sum(q) * (1.0f / 2048.0f) + LN_EPS);
        if (F.lane == 0) { vst[2 * t] = mean; vst[2 * t + 1] = rstd; }
    }
}

__device__ __forceinline__ void p_spatial(Frame& F, const Args& A) {
    constexpr int PITCH = 272;
    const bf16* Z = (const bf16*)(F.ws + WS_Z); const bf16* WSP = (const bf16*)(F.ws + WS_WSP); unsigned char* YG = (unsigned char*)(F.ws + WS_YG);
    const float* vg = A.in[6]; const float* vb = A.in[7]; const float* bsp = A.in[9];
    LAS unsigned char* img = F.lds + RING_OFF;
    const int r = F.lane & 15, q = F.lane >> 4, w = F.wave;
    LAS float* vst = (LAS float*)(img + 36864);
    for (int unit2 = F.vcu; unit2 < (T / 128) * 2; unit2 += F.G) {
        const int n = unit2 >> 1, t0 = n * 128;
        v4u rawn[4];
#define SP_RAW(hh) do { int t_ = F.tid; OPAQUE(t_); _Pragma("unroll") for (int it = 0; it < 4; ++it) { const int idx = t_ + 512 * it, j = idx & 127, c8 = idx >> 7; rawn[it] = *(const v4u*)(Z + (size_t)(t0 + j) * 4096 + 2048 + (hh) * 128 + c8 * 8); } } while (0)
        SP_RAW(8 * (unit2 & 1));
        __syncthreads();
#pragma unroll 1
        for (int i0 = 0; i0 < 16; i0 += 4) {
            v4u rw[4][4];
#pragma unroll
            for (int i = 0; i < 4; ++i) { const v4u* p = (const v4u*)(Z + (size_t)(t0 + 16 * w + i0 + i) * 4096 + 2048) + F.lane;
#pragma unroll
                for (int jj = 0; jj < 4; ++jj) rw[i][jj] = p[64 * jj]; }
#pragma unroll
            for (int i = 0; i < 4; ++i) { const int row = 16 * w + i0 + i;
                float v[32]; float sm = 0.f;
#pragma unroll
                for (int jj = 0; jj < 4; ++jj) { const v4u ww = rw[i][jj];
                    v[8 * jj + 0] = bflo(ww.x); v[8 * jj + 1] = bfhi(ww.x); v[8 * jj + 2] = bflo(ww.y); v[8 * jj + 3] = bfhi(ww.y); v[8 * jj + 4] = bflo(ww.z); v[8 * jj + 5] = bfhi(ww.z); v[8 * jj + 6] = bflo(ww.w); v[8 * jj + 7] = bfhi(ww.w); }
#pragma unroll
                for (int e = 0; e < 32; ++e) sm += v[e];
                const float mean_ = wave_sum(sm) * (1.0f / 2048.0f); float qq = 0.f;
#pragma unroll
                for (int e = 0; e < 32; ++e) { const float d = v[e] - mean_; qq += d * d; }
                const float rstd_ = __builtin_amdgcn_rsqf(wave_sum(qq) * (1.0f / 2048.0f) + LN_EPS);
                if (F.lane == 0) { vst[2 * row] = mean_; vst[2 * row + 1] = rstd_; } } }
        for (int hI = 0; hI < 8; ++hI) {
        const int h = 8 * (unit2 & 1) + hI;
        __syncthreads();
        { int t_ = F.tid; OPAQUE(t_);
#pragma unroll
        for (int it = 0; it < 4; ++it) { const int idx = t_ + 512 * it, j = idx & 127, c8 = idx >> 7;
            const v4u raw = rawn[it];
            const float mean = vst[2 * j], rstd = vst[2 * j + 1];
            const f32x4 g0 = *(const f32x4*)(vg + h * 128 + c8 * 8), g1 = *(const f32x4*)(vg + h * 128 + c8 * 8 + 4), b0 = *(const f32x4*)(vb + h * 128 + c8 * 8), b1 = *(const f32x4*)(vb + h * 128 + c8 * 8 + 4);
            float x[8] = {bflo(raw.x), bfhi(raw.x), bflo(raw.y), bfhi(raw.y), bflo(raw.z), bfhi(raw.z), bflo(raw.w), bfhi(raw.w)};
            const float gg[8] = {g0.x, g0.y, g0.z, g0.w, g1.x, g1.y, g1.z, g1.w}, bb[8] = {b0.x, b0.y, b0.z, b0.w, b1.x, b1.y, b1.z, b1.w};
#pragma unroll
            for (int i = 0; i < 8; ++i) { const float y = (x[i] - mean) * rstd * gg[i] + bb[i]; const int c = c8 * 8 + i, p = (c & 0x43) | (((c >> 2) & 3) << 4) | (((c >> 4) & 3) << 2);
                *(LAS unsigned short*)(img + p * PITCH + j * 2) = (unsigned short)f2bf(y); } } }
        if (hI + 1 < 8) SP_RAW(h + 1);
        const int tok = t0 + 16 * w + r; const float bias = bsp[h * 128 + 16 * w + r];
        v4u ug[4];
#pragma unroll
        for (int G2 = 0; G2 < 2; ++G2) { ug[2 * G2] = *(const v4u*)(Z + (size_t)tok * 4096 + h * 128 + 64 * G2 + 16 * q); ug[2 * G2 + 1] = *(const v4u*)(Z + (size_t)tok * 4096 + h * 128 + 64 * G2 + 16 * q + 8); }
        bf16x8 bw[4];
#pragma unroll
        for (int ks = 0; ks < 4; ++ks) bw[ks] = *(const bf16x8*)(WSP + ((size_t)h * 128 + 16 * w + r) * 128 + 32 * ks + 8 * q);
        __syncthreads();
        f32x4 acc[8];
#pragma unroll
        for (int ct = 0; ct < 8; ++ct) acc[ct] = (f32x4){0.f, 0.f, 0.f, 0.f};
#pragma unroll
        for (int ct = 0; ct < 8; ++ct)
#pragma unroll
            for (int ks = 0; ks < 4; ++ks) { const bf16x8 a = *(const LAS bf16x8*)(img + (16 * ct + r) * PITCH + (32 * ks + 8 * q) * 2);
                acc[ct] = __builtin_amdgcn_mfma_f32_16x16x32_bf16(a, bw[ks], acc[ct], 0, 0, 0); }
#pragma unroll
        for (int G2 = 0; G2 < 2; ++G2) { const int col = h * 128 + 64 * G2 + 16 * q;
            const unsigned uw[8] = {ug[2 * G2].x, ug[2 * G2].y, ug[2 * G2].z, ug[2 * G2].w, ug[2 * G2 + 1].x, ug[2 * G2 + 1].y, ug[2 * G2 + 1].z, ug[2 * G2 + 1].w};
            v4u o;
#pragma unroll
            for (int c4 = 0; c4 < 4; ++c4) { const f32x4 a = acc[4 * G2 + c4];
                const float y0 = fminf(fmaxf((a[0] + bias) * bflo(uw[2 * c4]) * 8.f, -448.f), 448.f), y1 = fminf(fmaxf((a[1] + bias) * bfhi(uw[2 * c4]) * 8.f, -448.f), 448.f);
                const float y2 = fminf(fmaxf((a[2] + bias) * bflo(uw[2 * c4 + 1]) * 8.f, -448.f), 448.f), y3 = fminf(fmaxf((a[3] + bias) * bfhi(uw[2 * c4 + 1]) * 8.f, -448.f), 448.f);
                int p_ = __builtin_amdgcn_cvt_pk_fp8_f32(y0, y1, 0, false); p_ = __builtin_amdgcn_cvt_pk_fp8_f32(y2, y3, p_, true); o[c4] = (unsigned)p_; }
            *(v4u*)(YG + (size_t)tok * D + col) = o; }
        }
#undef SP_RAW
    }
    __syncthreads();
}

__device__ __forceinline__ float grp8_max(float v) { v = fmaxf(v, DPP_F(v, 0xB1)); v = fmaxf(v, DPP_F(v, 0x4E)); v = fmaxf(v, DPP_F(v, 0x141)); return v; }
__device__ __forceinline__ float wave_max(float v) {
    v = fmaxf(v, DPP_F(v, 0xB1)); v = fmaxf(v, DPP_F(v, 0x4E)); v = fmaxf(v, DPP_F(v, 0x141)); v = fmaxf(v, DPP_F(v, 0x140));
    const int iv = __builtin_bit_cast(int, v);
    return fmaxf(fmaxf(__builtin_bit_cast(float, __builtin_amdgcn_readlane(iv, 0)), __builtin_bit_cast(float, __builtin_amdgcn_readlane(iv, 16))), fmaxf(__builtin_bit_cast(float, __builtin_amdgcn_readlane(iv, 32)), __builtin_bit_cast(float, __builtin_amdgcn_readlane(iv, 48))));
}
__device__ __forceinline__ void p_ln_router(Frame& F, const Args& A, const bf16* rin, const float* lg, const float* lbias, bf16* xb, unsigned char* xq, int layer) {
    const bf16* WRh = (const bf16*)(F.ws + WS_WR) + (size_t)(layer * 2 + 0) * NE * D; const bf16* WRl = (const bf16*)(F.ws + WS_WR) + (size_t)(layer * 2 + 1) * NE * D;
    const float* ebias = A.in[16] + layer * NE;
    unsigned* cnt = F.ctl + CW_CNT + layer * NE * CNT_STRIDE;
    unsigned* list = (unsigned*)(F.ws + WS_LIST); unsigned* aes = (unsigned*)(F.ws + WS_AES); float* aw = (float*)(F.ws + WS_AW);
    LAS float* PL = (LAS float*)(F.lds + RING_OFF);
    LAS float* Lst = PL + 8 * 32 * 65;
    LAS float* Lgb = Lst + 64 * 16;
    LAS int* Lh = (LAS int*)(Lgb + 2 * D);
    LAS int* Lrec = Lh + 128;
    LAS float* Lrw = (LAS float*)(Lrec + 512);
    const int w = F.wave;
    if (F.tid < 64) Lh[F.tid] = 0;
    int itl = 0, tile0 = 0;
#define LNR_FLUSH() do { __syncthreads(); \
        if (F.tid < 64) { const int c_ = Lh[F.tid]; Lh[64 + F.tid] = c_ ? (int)__hip_atomic_fetch_add(cnt + F.tid * CNT_STRIDE, (unsigned)c_, __ATOMIC_RELAXED, __HIP_MEMORY_SCOPE_AGENT) : 0; Lh[F.tid] = 0; } \
        __syncthreads(); \
        for (int i_ = F.tid; i_ < itl * 256; i_ += NWAVES * 64) { const int rc_ = Lrec[i_], me_ = rc_ & 255, slot_ = Lh[64 + me_] + (rc_ >> 8); \
            const int token_ = (tile0 + (i_ >> 8)) * 32 + ((i_ >> 3) & 31); \
            list[(size_t)me_ * 16384 + slot_] = (unsigned)token_; aes[(size_t)token_ * 8 + (i_ & 7)] = ((unsigned)me_ << 16) | (unsigned)slot_; aw[(size_t)token_ * 8 + (i_ & 7)] = Lrw[i_]; } \
        itl = 0; } while (0)
    for (int i = F.tid; i < D / 4; i += NWAVES * 64) { ((LAS f32x4*)Lgb)[i] = ((const f32x4*)lg)[i]; ((LAS f32x4*)(Lgb + D))[i] = ((const f32x4*)lbias)[i]; }
    for (int tile = F.vcu; tile < T / 64; tile += F.G) {
        int t_ = F.tid; OPAQUE(t_);
        const int ln = t_ & 63, r = t_ & 15, q = (t_ >> 4) & 3, cw = 256 * w + 8 * q; const size_t wro = (size_t)r * D + cw;
        float mean[4], rstd[4];
#pragma unroll
        for (int hf = 0; hf < 2; ++hf) {
            v4u vr[2][8];
#pragma unroll
            for (int mt = 0; mt < 2; ++mt) { const bf16* rp = rin + (size_t)(tile * 64 + 32 * hf + 16 * mt + r) * D + cw;
#pragma unroll
                for (int j = 0; j < 8; ++j) vr[mt][j] = *(const v4u*)(rp + 32 * j); }
#pragma unroll
            for (int mt = 0; mt < 2; ++mt) { float s = 0.f, ss = 0.f;
#pragma unroll
                for (int j = 0; j < 8; ++j) { const v4u x = vr[mt][j]; const float x0 = bflo(x.x), x1 = bfhi(x.x), x2 = bflo(x.y), x3 = bfhi(x.y), x4 = bflo(x.z), x5 = bfhi(x.z), x6 = bflo(x.w), x7 = bfhi(x.w);
                    s += (x0 + x1) + (x2 + x3) + (x4 + x5) + (x6 + x7); ss += (x0 * x0 + x1 * x1) + (x2 * x2 + x3 * x3) + (x4 * x4 + x5 * x5) + (x6 * x6 + x7 * x7); }
                s += __shfl_xor(s, 16); s += __shfl_xor(s, 32); ss += __shfl_xor(ss, 16); ss += __shfl_xor(ss, 32);
                if (q == 0) { Lst[((32 * hf + 16 * mt + r) * 8 + w) * 2] = s; Lst[((32 * hf + 16 * mt + r) * 8 + w) * 2 + 1] = ss; } }
            asm volatile("" ::: "memory"); }
        __syncthreads();
#pragma unroll
        for (int mt = 0; mt < 4; ++mt) { const LAS float* lp = Lst + (16 * mt + r) * 16;
            const f32x4 p0 = *(const LAS f32x4*)(lp), p1 = *(const LAS f32x4*)(lp + 4), p2 = *(const LAS f32x4*)(lp + 8), p3 = *(const LAS f32x4*)(lp + 12);
            const float st = (p0.x + p0.z) + (p1.x + p1.z) + (p2.x + p2.z) + (p3.x + p3.z), sq = (p0.y + p0.w) + (p1.y + p1.w) + (p2.y + p2.w) + (p3.y + p3.w);
            mean[mt] = st * (1.0f / D); const float var = fmaxf(sq * (1.0f / D) - mean[mt] * mean[mt], 0.f); rstd[mt] = __builtin_amdgcn_rsqf(var + LN_EPS); }
        f32x4 acc[4][4];
#pragma unroll
        for (int mt = 0; mt < 4; ++mt)
#pragma unroll
            for (int nt = 0; nt < 4; ++nt) acc[mt][nt] = (f32x4){0.f, 0.f, 0.f, 0.f};
#pragma unroll
        for (int j = 0; j < 8; ++j) { const int c0 = cw + 32 * j;
            const f32x4 g0 = *(const LAS f32x4*)(Lgb + c0), g1 = *(const LAS f32x4*)(Lgb + c0 + 4), b0 = *(const LAS f32x4*)(Lgb + D + c0), b1 = *(const LAS f32x4*)(Lgb + D + c0 + 4);
            bf16x8 ah[4], al[4];
#pragma unroll
            for (int mt = 0; mt < 4; ++mt) { const v4u x = *(const v4u*)(rin + (size_t)(tile * 64 + 16 * mt + r) * D + c0);
                const f32x4 xa = (f32x4){bflo(x.x), bfhi(x.x), bflo(x.y), bfhi(x.y)}, xc = (f32x4){bflo(x.z), bfhi(x.z), bflo(x.w), bfhi(x.w)};
                const f32x4 y0 = (xa - mean[mt]) * rstd[mt] * g0 + b0, y1 = (xc - mean[mt]) * rstd[mt] * g1 + b1;
                v4u hv, lv;
                hv.x = pk2(y0.x, y0.y); hv.y = pk2(y0.z, y0.w); hv.z = pk2(y1.x, y1.y); hv.w = pk2(y1.z, y1.w);
                lv.x = pk2(y0.x - bflo(hv.x), y0.y - bfhi(hv.x)); lv.y = pk2(y0.z - bflo(hv.y), y0.w - bfhi(hv.y)); lv.z = pk2(y1.x - bflo(hv.z), y1.y - bfhi(hv.z)); lv.w = pk2(y1.z - bflo(hv.w), y1.w - bfhi(hv.w));
                *(v4u*)(xb + (size_t)(tile * 64 + 16 * mt + r) * D + c0) = hv;
                { const f32x4 z0 = y0 * 16.0f, z1 = y1 * 16.0f; int lo_ = __builtin_amdgcn_cvt_pk_fp8_f32(z0.x, z0.y, 0, false); lo_ = __builtin_amdgcn_cvt_pk_fp8_f32(z0.z, z0.w, lo_, true);
                  int hi_ = __builtin_amdgcn_cvt_pk_fp8_f32(z1.x, z1.y, 0, false); hi_ = __builtin_amdgcn_cvt_pk_fp8_f32(z1.z, z1.w, hi_, true);
                  v2u q8; q8.x = (unsigned)lo_; q8.y = (unsigned)hi_; *(v2u*)(xq + (size_t)(tile * 64 + 16 * mt + r) * D + c0) = q8; }
                ah[mt] = __builtin_bit_cast(bf16x8, hv); al[mt] = __builtin_bit_cast(bf16x8, lv); }
#pragma unroll
            for (int nt = 0; nt < 4; ++nt) { const bf16x8 bh = *(const bf16x8*)(WRh + wro + (size_t)(16 * nt) * D + 32 * j), bl = *(const bf16x8*)(WRl + wro + (size_t)(16 * nt) * D + 32 * j);
#pragma unroll
                for (int mt = 0; mt < 4; ++mt) {
                    acc[mt][nt] = __builtin_amdgcn_mfma_f32_16x16x32_bf16(ah[mt], bh, acc[mt][nt], 0, 0, 0);
                    acc[mt][nt] = __builtin_amdgcn_mfma_f32_16x16x32_bf16(al[mt], bh, acc[mt][nt], 0, 0, 0);
                    acc[mt][nt] = __builtin_amdgcn_mfma_f32_16x16x32_bf16(ah[mt], bl, acc[mt][nt], 0, 0, 0); } }
            asm volatile("" ::: "memory"); }
#pragma unroll
        for (int hf = 0; hf < 2; ++hf) {
            if (hf) __syncthreads();
#pragma unroll
            for (int mt = 0; mt < 2; ++mt)
#pragma unroll
                for (int nt = 0; nt < 4; ++nt)
#pragma unroll
                    for (int i = 0; i < 4; ++i) PL[(w * 32 + 16 * mt + 4 * q + i) * 65 + 16 * nt + r] = acc[2 * hf + mt][nt][i];
            __syncthreads();
#pragma unroll 1
            for (int tt = 0; tt < 4; ++tt) {
                const int tk = 4 * w + tt, g = ln >> 3;
                float lgt = 0.f;
#pragma unroll
                for (int w2 = 0; w2 < 8; ++w2) lgt += PL[(w2 * 32 + tk) * 65 + ln];
                const float sg = 1.0f / (1.0f + __expf(-lgt)), c = sg + ebias[ln];
                const float m1 = grp8_max(c);
                const unsigned long long bm = __ballot(c == m1);
                const unsigned gm = (unsigned)(bm >> (8 * g)) & 0xffu;
                const int first = __builtin_ctz(gm | 0x100u);
                const float m2 = grp8_max(((ln & 7) == first) ? -INFINITY : c);
                const float gs = m1 + m2;
                unsigned selg = 0u;
#pragma unroll
                for (int k = 0; k < 4; ++k) { const float v = ((selg >> g) & 1u) ? -INFINITY : gs; const float best = wave_max(v); const unsigned long long b2 = __ballot(v == best); selg |= 1u << (__builtin_ctzll(b2 | (1ull << 63)) >> 3); }
                float cc = ((selg >> g) & 1u) ? c : -INFINITY;
                int me = 0; float mw = 0.f, ssum = 0.f;
#pragma unroll
                for (int k = 0; k < 8; ++k) { const float best = wave_max(cc); const unsigned long long b3 = __ballot(cc == best); const int es = __builtin_ctzll(b3 | (1ull << 63));
                    const float swk = __builtin_bit_cast(float, __builtin_amdgcn_readlane(__builtin_bit_cast(int, sg), es)); ssum += swk;
                    if (ln == k) { me = es; mw = swk; } if (ln == es) cc = -INFINITY; }
                if (ln < 8) { const int lr = __hip_atomic_fetch_add(Lh + me, 1, __ATOMIC_RELAXED, __HIP_MEMORY_SCOPE_WORKGROUP);
                    Lrec[(itl * 32 + tk) * 8 + ln] = me | (lr << 8); Lrw[(itl * 32 + tk) * 8 + ln] = mw * (ROUTED_SCALE / ssum); }
            }
            if (itl == 0) tile0 = tile * 2;
            ++itl;
        }
        LNR_FLUSH();
    }
#undef LNR_FLUSH
    __syncthreads();
}

__device__ __forceinline__ void moe_tables(Frame& F, int layer, int NPN, bool fresh) {
    LAS int* lc = (LAS int*)(F.lds + LT_CNT); LAS int* rb = (LAS int*)(F.lds + LT_RB); LAS int* tp = (LAS int*)(F.lds + LT_TP); LAS int* tab = (LAS int*)(F.lds + LT_UNITS); LAS int* nun = (LAS int*)(F.lds + LT_NUNITS);
    const unsigned* cnt = F.ctl + CW_CNT + layer * NE * CNT_STRIDE;
    __syncthreads();
    if (fresh || MK_N_LAUNCHES != 1) {
    if (F.tid < NEA) lc[F.tid] = F.tid < NE ? (int)__hip_atomic_load(cnt + F.tid * CNT_STRIDE, __ATOMIC_RELAXED, __HIP_MEMORY_SCOPE_AGENT) : T;
    __syncthreads();
    if (F.tid <= NEA) { int run = 0, tiles = 0; for (int e = 0; e < F.tid; ++e) { const int c = lc[e]; run += c; tiles += (c + 255) >> 8; } rb[F.tid] = run; tp[F.tid] = tiles; }
    __syncthreads();
    }
    if (NPN > 0 && F.tid < 64) {
        const int total = tp[NEA] * NPN, qq = total / 8, rr = total % 8, i = F.tid;
        const long L = (long)i * F.G + (int)blockIdx.x;
        if (L < total) {
            const int xcd = (int)(L % 8), off = (int)(L / 8);
            const int up = (xcd < rr ? xcd * (qq + 1) : rr * (qq + 1) + (xcd - rr) * qq) + off;
            const int rt = up / NPN, pn = up % NPN;
            int lo = 0, hi = NEA;
            while (hi - lo > 1) { const int mid = (lo + hi) >> 1; if (tp[mid] <= rt) lo = mid; else hi = mid; }
            const int e = lo, mt = rt - tp[e], c = lc[e];
            tab[5 * i + 0] = e; tab[5 * i + 1] = mt; tab[5 * i + 2] = pn; tab[5 * i + 3] = (c - mt * 256) < 256 ? (c - mt * 256) : 256; tab[5 * i + 4] = rb[e] + mt * 256;
        }
        if (i == 0) { const long rem = (long)total - (int)blockIdx.x; int n = rem > 0 ? (int)((rem + F.G - 1) / F.G) : 0; nun[0] = n < 64 ? n : 64; }
    }
    if (NPN == 0 && F.tid == 0) nun[0] = 0;
    __syncthreads();
}

__device__ __forceinline__ void p_combine_ln(Frame& F, const bf16* xres, const float* lg, const float* lbias, float* of, bf16* ob, int layer) {
    moe_tables(F, layer, 0, false);
    const LAS int* rb = (const LAS int*)(F.lds + LT_RB);
    const int gw = F.vcu * NWAVES + F.wave, NGW = F.G * NWAVES;
    const unsigned char* Y = (const unsigned char*)(F.ws + WS_RA); const unsigned* aes = (const unsigned*)(F.ws + WS_AES); const float* aw = (const float*)(F.ws + WS_AW);
    for (int t = gw; t < T; t += NGW) {
        int ln = F.lane; OPAQUE(ln);
        unsigned es = 0u; float wv = 0.f;
        if (F.lane < 8) { es = aes[(size_t)t * 8 + F.lane]; wv = aw[(size_t)t * 8 + F.lane]; }
        int rowk[9]; float wk[9];
#pragma unroll
        for (int k = 0; k < 8; ++k) { const unsigned x = (unsigned)__shfl((int)es, k); wk[k] = __shfl(wv, k); rowk[k] = rb[x >> 16] + (int)(x & 0xffffu); }
#pragma unroll
        for (int k = 0; k < 8; ++k) wk[k] *= (1.0f / 16.0f);
        rowk[8] = T * TOPK + t; wk[8] = 1.0f / 16.0f;
        float v[32];
#pragma unroll
        for (int jj = 0; jj < 4; ++jj) { const int c0 = 512 * jj + 8 * ln;
            const v4u a = *(const v4u*)(xres + (size_t)t * D + c0);
            v[8 * jj + 0] = ALPHA * bflo(a.x); v[8 * jj + 1] = ALPHA * bfhi(a.x); v[8 * jj + 2] = ALPHA * bflo(a.y); v[8 * jj + 3] = ALPHA * bfhi(a.y); v[8 * jj + 4] = ALPHA * bflo(a.z); v[8 * jj + 5] = ALPHA * bfhi(a.z); v[8 * jj + 6] = ALPHA * bflo(a.w); v[8 * jj + 7] = ALPHA * bfhi(a.w); }
#pragma unroll
        for (int k = 0; k < 9; ++k) { const unsigned char* yr = Y + (size_t)rowk[k] * D + 8 * ln; const float w = wk[k];
#pragma unroll
            for (int jj = 0; jj < 4; ++jj) { const v2u p = *(const v2u*)(yr + 512 * jj);
                typedef float f32x2_ __attribute__((ext_vector_type(2)));
                const f32x2_ a0 = __builtin_amdgcn_cvt_pk_f32_fp8((int)p.x, false), a1 = __builtin_amdgcn_cvt_pk_f32_fp8((int)p.x, true), a2 = __builtin_amdgcn_cvt_pk_f32_fp8((int)p.y, false), a3 = __builtin_amdgcn_cvt_pk_f32_fp8((int)p.y, true);
                v[8 * jj + 0] += w * a0.x; v[8 * jj + 1] += w * a0.y; v[8 * jj + 2] += w * a1.x; v[8 * jj + 3] += w * a1.y; v[8 * jj + 4] += w * a2.x; v[8 * jj + 5] += w * a2.y; v[8 * jj + 6] += w * a3.x; v[8 * jj + 7] += w * a3.y; }
            if ((k % 3) == 2) asm volatile("" ::: "memory"); }
        float s = 0.f;
#pragma unroll
        for (int i = 0; i < 32; ++i) s += v[i];
        const float mean = wave_sum(s) * (1.0f / D); float qv = 0.f;
#pragma unroll
        for (int i = 0; i < 32; ++i) { const float d = v[i] - mean; qv += d * d; }
        const float rstd = __builtin_amdgcn_rsqf(wave_sum(qv) * (1.0f / D) + LN_EPS);
#pragma unroll
        for (int jj = 0; jj < 4; ++jj) { const int c0 = 512 * jj + 8 * ln;
            const f32x4 g0 = *(const f32x4*)(lg + c0), g1 = *(const f32x4*)(lg + c0 + 4), b0 = *(const f32x4*)(lbias + c0), b1 = *(const f32x4*)(lbias + c0 + 4);
            f32x4 y0, y1;
            y0.x = (v[8 * jj + 0] - mean) * rstd * g0.x + b0.x; y0.y = (v[8 * jj + 1] - mean) * rstd * g0.y + b0.y; y0.z = (v[8 * jj + 2] - mean) * rstd * g0.z + b0.z; y0.w = (v[8 * jj + 3] - mean) * rstd * g0.w + b0.w;
            y1.x = (v[8 * jj + 4] - mean) * rstd * g1.x + b1.x; y1.y = (v[8 * jj + 5] - mean) * rstd * g1.y + b1.y; y1.z = (v[8 * jj + 6] - mean) * rstd * g1.z + b1.z; y1.w = (v[8 * jj + 7] - mean) * rstd * g1.w + b1.w;
            if (of) { *(f32x4*)(of + (size_t)t * D + c0) = y0; *(f32x4*)(of + (size_t)t * D + c0 + 4) = y1; }
            if (ob) { v4u w; w.x = pk2_sw(y0.x, y0.y); w.y = pk2_sw(y0.z, y0.w); w.z = pk2_sw(y1.x, y1.y); w.w = pk2_sw(y1.z, y1.w); *(v4u*)(ob + (size_t)t * D + c0) = w;
                      const f32x4 z0 = y0 * 16.0f, z1 = y1 * 16.0f; int lo_ = __builtin_amdgcn_cvt_pk_fp8_f32(z0.x, z0.y, 0, false); lo_ = __builtin_amdgcn_cvt_pk_fp8_f32(z0.z, z0.w, lo_, true);
                      int hi_ = __builtin_amdgcn_cvt_pk_fp8_f32(z1.x, z1.y, 0, false); hi_ = __builtin_amdgcn_cvt_pk_fp8_f32(z1.z, z1.w, hi_, true);
                      v2u q8; q8.x = (unsigned)lo_; q8.y = (unsigned)hi_; *(v2u*)(F.ws + WS_XQ + (size_t)t * D + c0) = q8; } }
    }
}

typedef float f32x2_t __attribute__((ext_vector_type(2)));
__device__ __forceinline__ v2u f8_pack8(const float (&x)[8]) { v2u r; int lo = __builtin_amdgcn_cvt_pk_fp8_f32(x[0] * 8.f, x[1] * 8.f, 0, false); lo = __builtin_amdgcn_cvt_pk_fp8_f32(x[2] * 8.f, x[3] * 8.f, lo, true);
    int hi = __builtin_amdgcn_cvt_pk_fp8_f32(x[4] * 8.f, x[5] * 8.f, 0, false); hi = __builtin_amdgcn_cvt_pk_fp8_f32(x[6] * 8.f, x[7] * 8.f, hi, true); r.x = (unsigned)lo; r.y = (unsigned)hi; return r; }
__device__ __forceinline__ void f8_unpack8(v2u p, float (&x)[8]) { const f32x2_t a0 = __builtin_amdgcn_cvt_pk_f32_fp8((int)p.x, false), a1 = __builtin_amdgcn_cvt_pk_f32_fp8((int)p.x, true), a2 = __builtin_amdgcn_cvt_pk_f32_fp8((int)p.y, false), a3 = __builtin_amdgcn_cvt_pk_f32_fp8((int)p.y, true);
    x[0] = a0.x * 0.125f; x[1] = a0.y * 0.125f; x[2] = a1.x * 0.125f; x[3] = a1.y * 0.125f; x[4] = a2.x * 0.125f; x[5] = a2.y * 0.125f; x[6] = a3.x * 0.125f; x[7] = a3.y * 0.125f; }
__device__ __forceinline__ int kslot(int k) { const int kk = k & 31; return (k & ~31) + 8 * ((kk & 15) >> 2) + 4 * (kk >> 4) + (kk & 3); }
__device__ __forceinline__ bf16x8 pack8(const f32x4& a, const f32x4& b) { v4u w; w.x = pk2(a[0], a[1]); w.y = pk2(a[2], a[3]); w.z = pk2(b[0], b[1]); w.w = pk2(b[2], b[3]); return __builtin_bit_cast(bf16x8, w); }
__device__ __forceinline__ void p_hgrn_intra(Frame& F) {
    const bf16* Q = (const bf16*)(F.ws + WS_HQ); const bf16* Kk = (const bf16*)(F.ws + WS_HK); const bf16* V = (const bf16*)(F.ws + WS_HV); const _Float16* LF = (const _Float16*)(F.ws + WS_HF);
    bf16* QD = (bf16*)(F.ws + WS_HQD); unsigned char* UT = (unsigned char*)(F.ws + WS_HUT); bf16* OI = (bf16*)(F.ws + WS_HOI); float* DT = (float*)(F.ws + WS_HDT);
    LAS unsigned char* L = F.lds + RING_OFF;
    constexpr int O_KDT = 0, O_VT = 18432, O_KH = 36864, O_QIJ = 54272, O_QST = 97792, O_GT = 114176, O_PA = 116736  , PC = 144, PT = 272;
    const int k = F.tid & 127, tq = __builtin_amdgcn_readfirstlane(F.tid >> 7), r = F.lane & 15, q = F.lane >> 4, w = F.wave;
    const int ks_ = kslot(k);
    float plf[16]; unsigned short pq[16], pv[16];
#define INTRA_LOAD(uu) do { const int bh_ = (uu) >> 6, c_ = (uu) & 63; const size_t base_ = (size_t)((bh_ >> 4) * SEQ + c_ * 64 + 16 * tq) * D + (bh_ & 15) * HD + k; \
        _Pragma("unroll") for (int i = 0; i < 16; ++i) { plf[i] = (float)LF[base_ + (size_t)i * D]; pq[i] = Q[base_ + (size_t)i * D]; pv[i] = V[base_ + (size_t)i * D]; } } while (0)
    if (F.vcu < NB * NH * 64) INTRA_LOAD(F.vcu);
    for (int u = F.vcu; u < NB * NH * 64; u += F.G) {
        float Bl[16], qv[16], kv[16]; unsigned vv[8]; float run = 0.f;
#pragma unroll
        for (int i = 0; i < 16; ++i) { run += plf[i]; Bl[i] = run; qv[i] = bf2f(pq[i]); kv[i] = 1.0f - __expf(plf[i]); }
#pragma unroll
        for (int i = 0; i < 8; ++i) vv[i] = (unsigned)pv[2 * i] | ((unsigned)pv[2 * i + 1] << 16);
        LBAR();
        ((LAS float*)(L + O_GT))[tq * 128 + k] = run;
        LBAR();
        const float g0 = ((LAS float*)(L + O_GT))[k], g1 = ((LAS float*)(L + O_GT))[128 + k], g2 = ((LAS float*)(L + O_GT))[256 + k], g3 = ((LAS float*)(L + O_GT))[384 + k];
        const float Rq = (tq > 0 ? g0 : 0.f) + (tq > 1 ? g1 : 0.f) + (tq > 2 ? g2 : 0.f), Btot = (g0 + g1) + (g2 + g3);
        { unsigned kd[8];
#pragma unroll
          for (int i = 0; i < 8; ++i) kd[i] = pk2(kv[2 * i] * __expf(Btot - Rq - Bl[2 * i]), kv[2 * i + 1] * __expf(Btot - Rq - Bl[2 * i + 1]));
          LAS v4u* pk_ = (LAS v4u*)(L + O_KDT + k * PC + 32 * tq); v4u a; a.x = kd[0]; a.y = kd[1]; a.z = kd[2]; a.w = kd[3]; pk_[0] = a; a.x = kd[4]; a.y = kd[5]; a.z = kd[6]; a.w = kd[7]; pk_[1] = a;
          LAS v4u* pv_ = (LAS v4u*)(L + O_VT + k * PC + 32 * tq); a.x = vv[0]; a.y = vv[1]; a.z = vv[2]; a.w = vv[3]; pv_[0] = a; a.x = vv[4]; a.y = vv[5]; a.z = vv[6]; a.w = vv[7]; pv_[1] = a; }
        { const float eR = __expf(Rq);
          const float f0 = __expf(Rq), f1 = __expf(Rq - g0), f2 = __expf(Rq - g0 - g1);
#pragma unroll
          for (int i = 0; i < 16; ++i) { const float eb = __expf(Bl[i]), qt = qv[i] * eb, kh = kv[i] * __expf(fminf(-Bl[i], 80.f));
              *(LAS unsigned short*)(L + O_KH + (16 * tq + i) * PT + k * 2) = (unsigned short)f2bf(kh);
              *(LAS unsigned short*)(L + O_QST + (16 * tq + i) * 256 + ks_ * 2) = (unsigned short)f2bf(qt * eR);
              const int blk0 = tq * (tq + 1) / 2;
              *(LAS unsigned short*)(L + O_QIJ + (blk0 + tq) * (16 * PT) + i * PT + k * 2) = (unsigned short)f2bf(qt);
              if (tq > 0) *(LAS unsigned short*)(L + O_QIJ + (blk0 + 0) * (16 * PT) + i * PT + k * 2) = (unsigned short)f2bf(qt * f0);
              if (tq > 1) *(LAS unsigned short*)(L + O_QIJ + (blk0 + 1) * (16 * PT) + i * PT + k * 2) = (unsigned short)f2bf(qt * f1);
              if (tq > 2) *(LAS unsigned short*)(L + O_QIJ + (blk0 + 2) * (16 * PT) + i * PT + k * 2) = (unsigned short)f2bf(qt * f2); }
          if (tq == 0) DT[(size_t)u * 128 + ks_] = __expf(Btot); }
        LBAR();
        if (u + F.G < NB * NH * 64) INTRA_LOAD(u + F.G);
        { const LAS v4u* src = (const LAS v4u*)(L + O_QST) + 2 * F.tid; v4u* dst = (v4u*)(QD + (size_t)u * 64 * 128) + 2 * F.tid; const v4u a = src[0], bq = src[1]; dst[0] = a; dst[1] = bq; }
        { f32x4 aU[8];
#pragma unroll
          for (int a = 0; a < 8; ++a) aU[a] = (f32x4){0.f, 0.f, 0.f, 0.f};
#pragma unroll
          for (int ts = 0; ts < 2; ++ts) { const bf16x8 bv = *(const LAS bf16x8*)(L + O_VT + (16 * w + r) * PC + (32 * ts + 8 * q) * 2);
#pragma unroll
              for (int a = 0; a < 8; ++a) { const bf16x8 av = *(const LAS bf16x8*)(L + O_KDT + (16 * a + r) * PC + (32 * ts + 8 * q) * 2); aU[a] = __builtin_amdgcn_mfma_f32_16x16x32_bf16(av, bv, aU[a], 0, 0, 0); } }
#pragma unroll
          for (int ks = 0; ks < 4; ++ks) { const float x8[8] = {aU[2 * ks][0], aU[2 * ks][1], aU[2 * ks][2], aU[2 * ks][3], aU[2 * ks + 1][0], aU[2 * ks + 1][1], aU[2 * ks + 1][2], aU[2 * ks + 1][3]};
              *(v2u*)(UT + ((size_t)u * 128 + 16 * w + r) * 128 + 32 * ks + 8 * q) = f8_pack8(x8); } }
        if (w < 6) {
            const int i = w == 0 ? 0 : (w == 1 ? 1 : (w <= 3 ? 2 : 3)), pr = (w == 3 || w == 5) ? 1 : 0;
            f32x4 pa = (f32x4){0.f, 0.f, 0.f, 0.f}, pb = (f32x4){0.f, 0.f, 0.f, 0.f};
            { const int j = 2 * pr;
#pragma unroll
              for (int ks = 0; ks < 4; ++ks) { const bf16x8 av = *(const LAS bf16x8*)(L + O_KH + (16 * j + r) * PT + (32 * ks + 8 * q) * 2);
                  const bf16x8 bv = *(const LAS bf16x8*)(L + O_QIJ + (i * (i + 1) / 2 + j) * (16 * PT) + r * PT + (32 * ks + 8 * q) * 2);
                  pa = __builtin_amdgcn_mfma_f32_16x16x32_bf16(av, bv, pa, 0, 0, 0); }
              if (j == i) {
#pragma unroll
                  for (int e = 0; e < 4; ++e) pa[e] = (4 * q + e <= r) ? pa[e] : 0.f; } }
            if (2 * pr + 1 <= i) { const int j = 2 * pr + 1;
#pragma unroll
              for (int ks = 0; ks < 4; ++ks) { const bf16x8 av = *(const LAS bf16x8*)(L + O_KH + (16 * j + r) * PT + (32 * ks + 8 * q) * 2);
                  const bf16x8 bv = *(const LAS bf16x8*)(L + O_QIJ + (i * (i + 1) / 2 + j) * (16 * PT) + r * PT + (32 * ks + 8 * q) * 2);
                  pb = __builtin_amdgcn_mfma_f32_16x16x32_bf16(av, bv, pb, 0, 0, 0); }
              if (j == i) {
#pragma unroll
                  for (int e = 0; e < 4; ++e) pb[e] = (4 * q + e <= r) ? pb[e] : 0.f; } }
            *(LAS bf16x8*)(L + O_PA + (w * 64 + F.lane) * 16) = pack8(pa, pb);
        }
        LBAR();
#pragma unroll
        for (int i = 0; i < 4; ++i) {
            f32x4 o = (f32x4){0.f, 0.f, 0.f, 0.f};
#pragma unroll
            for (int pr = 0; pr < 2; ++pr) if (2 * pr <= i) {
                const int c = (i == 0 ? 0 : (i == 1 ? 1 : (i == 2 ? 2 : 4))) + pr;
                const bf16x8 av = *(const LAS bf16x8*)(L + O_PA + (c * 64 + F.lane) * 16);
                const v2u blo = *(const LAS v2u*)(L + O_VT + (16 * w + r) * PC + (32 * pr + 4 * q) * 2), bhi = *(const LAS v2u*)(L + O_VT + (16 * w + r) * PC + (32 * pr + 16 + 4 * q) * 2);
                v4u bw; bw.x = blo.x; bw.y = blo.y; bw.z = bhi.x; bw.w = bhi.y;
                o = __builtin_amdgcn_mfma_f32_16x16x32_bf16(av, __builtin_bit_cast(bf16x8, bw), o, 0, 0, 0); }
            { v2u ob; ob.x = pk2(o[0], o[1]); ob.y = pk2(o[2], o[3]); *(v2u*)(OI + (((size_t)u * 8 + w) * 4 + i) * 256 + F.lane * 4) = ob; }
        }
    }
#undef INTRA_LOAD
    __syncthreads();
}
constexpr size_t WS_HS = WS_XR;
__device__ __forceinline__ void p_hgrn_state(Frame& F) {
    const unsigned char* UT = (const unsigned char*)(F.ws + WS_HUT); const float* DT = (const float*)(F.ws + WS_HDT); unsigned char* HS = (unsigned char*)(F.ws + WS_HS);
    for (int unit = (int)blockIdx.x; unit < NB * NH * 4; unit += F.G) {
        int tid_ = F.tid; OPAQUE(tid_);
        const int bh = unit >> 2, vq = unit & 3, v = 32 * vq + (tid_ >> 4), s8 = 8 * (tid_ & 15);
        float S[8];
#pragma unroll
        for (int e = 0; e < 8; ++e) S[e] = 0.f;
        for (int c0 = 0; c0 < 64; c0 += 8) {
            v2u uu[8]; f32x4 d0[8], d1[8];
#pragma unroll
            for (int i = 0; i < 8; ++i) { const size_t u = (size_t)bh * 64 + c0 + i; uu[i] = *(const v2u*)(UT + (u * 128 + v) * 128 + s8); d0[i] = *(const f32x4*)(DT + u * 128 + s8); d1[i] = *(const f32x4*)(DT + u * 128 + s8 + 4); }
#pragma unroll
            for (int i = 0; i < 8; ++i) { const size_t u = (size_t)bh * 64 + c0 + i;
                *(v2u*)(HS + (u * 128 + v) * 128 + s8) = f8_pack8(S);
                float ux[8]; f8_unpack8(uu[i], ux);
                S[0] = d0[i].x * S[0] + ux[0]; S[1] = d0[i].y * S[1] + ux[1]; S[2] = d0[i].z * S[2] + ux[2]; S[3] = d0[i].w * S[3] + ux[3];
                S[4] = d1[i].x * S[4] + ux[4]; S[5] = d1[i].y * S[5] + ux[5]; S[6] = d1[i].z * S[6] + ux[6]; S[7] = d1[i].w * S[7] + ux[7]; }
        }
    }
}
struct OutPf { v4u q[2], g[2]; v2u s[4], o[4]; };
__device__ __forceinline__ unsigned f8_pack4c(unsigned a, unsigned b) { const float x0 = fminf(fmaxf(bflo(a) * 8.f, -448.f), 448.f), x1 = fminf(fmaxf(bfhi(a) * 8.f, -448.f), 448.f), x2 = fminf(fmaxf(bflo(b) * 8.f, -448.f), 448.f), x3 = fminf(fmaxf(bfhi(b) * 8.f, -448.f), 448.f);
    int p = __builtin_amdgcn_cvt_pk_fp8_f32(x0, x1, 0, false); p = __builtin_amdgcn_cvt_pk_fp8_f32(x2, x3, p, true); return (unsigned)p; }
__device__ __forceinline__ void p_hgrn_out(Frame& F, const Args& A) {
    const bf16* QD = (const bf16*)(F.ws + WS_HQD); const unsigned char* HS = (const unsigned char*)(F.ws + WS_HS); const bf16* OI = (const bf16*)(F.ws + WS_HOI);
    const bf16* Gt = (const bf16*)(F.ws + WS_HG); unsigned char* O = (unsigned char*)(F.ws + WS_HO); const float* normg = A.in[12];
    constexpr int PT = 272, TILE = 64 * PT, O_Q = 0, O_G = 2 * TILE, O_O = 4 * TILE, O_S = 5 * TILE;
    LAS unsigned char* L = F.lds + RING_OFF;
    const int w = F.wave;
    const int NU = NB * NH * 64, nu = (NU - F.vcu + F.G - 1) / F.G;
    const float ng = normg[16 * w + (F.lane & 15)];
    OutPf pa, pb;
#define OUT_T0(i) ((((F.vcu + (i) * F.G) >> 6) >> 4) * SEQ + ((F.vcu + (i) * F.G) & 63) * 64)
#define OUT_H(i) (((F.vcu + (i) * F.G) >> 6) & 15)
#define OUT_LOAD(P, i) do { const size_t u_ = (size_t)(F.vcu + (i) * F.G); const int t0_ = OUT_T0(i), h_ = OUT_H(i); \
        const v4u* q_ = (const v4u*)(QD + (u_ * 64 + row) * 128 + seg * 16); P.q[0] = q_[0]; P.q[1] = q_[1]; \
        const v4u* g_ = (const v4u*)(Gt + (size_t)(t0_ + row) * D + h_ * HD + seg * 16); P.g[0] = g_[0]; P.g[1] = g_[1]; \
        _Pragma("unroll") for (int ti = 0; ti < 4; ++ti) P.o[ti] = *(const v2u*)(OI + ((u_ * 8 + w) * 4 + ti) * 256 + (tid_ & 63) * 4); \
        _Pragma("unroll") for (int ks = 0; ks < 4; ++ks) P.s[ks] = *(const v2u*)(HS + (u_ * 128 + 16 * w + r) * 128 + 32 * ks + 8 * q); } while (0)
#define OUT_STORE(i) do { const LAS v4u* so_ = (const LAS v4u*)(L + O_O + row * PT + seg * 32); const v4u a0_ = so_[0], a1_ = so_[1]; \
        v4u pk_; pk_.x = f8_pack4c(a0_.x, a0_.y); pk_.y = f8_pack4c(a0_.z, a0_.w); pk_.z = f8_pack4c(a1_.x, a1_.y); pk_.w = f8_pack4c(a1_.z, a1_.w); \
        *(v4u*)(O + (size_t)(OUT_T0(i) + row) * D + OUT_H(i) * HD + seg * 16) = pk_; } while (0)
#define OUT_STEP(P, i, par) do { \
        { LAS v4u* dq = (LAS v4u*)(L + O_Q + (par) * TILE + row * PT + seg * 32); dq[0] = P.q[0]; dq[1] = P.q[1]; \
          LAS v4u* dg = (LAS v4u*)(L + O_G + (par) * TILE + row * PT + seg * 32); dg[0] = P.g[0]; dg[1] = P.g[1]; } \
        f32x4 o[4]; bf16x8 sb[4]; \
        _Pragma("unroll") for (int j = 0; j < 4; ++j) { o[j] = (f32x4){bflo(P.o[j].x), bfhi(P.o[j].x), bflo(P.o[j].y), bfhi(P.o[j].y)}; { float sx[8]; f8_unpack8(P.s[j], sx); v4u sw_; sw_.x = pk2(sx[0], sx[1]); sw_.y = pk2(sx[2], sx[3]); sw_.z = pk2(sx[4], sx[5]); sw_.w = pk2(sx[6], sx[7]); sb[j] = __builtin_bit_cast(bf16x8, sw_); } } \
        if ((i) + 2 < nu) OUT_LOAD(P, (i) + 2); \
        LBAR(); \
        if ((i) > 0) OUT_STORE((i) - 1); \
        _Pragma("unroll") for (int ti = 0; ti < 4; ++ti) _Pragma("unroll") for (int ks = 0; ks < 4; ++ks) { \
            const bf16x8 av = *(const LAS bf16x8*)(L + O_Q + (par) * TILE + (16 * ti + r) * PT + (32 * ks + 8 * q) * 2); o[ti] = __builtin_amdgcn_mfma_f32_16x16x32_bf16(av, sb[ks], o[ti], 0, 0, 0); } \
        LAS float* ls = (LAS float*)(L + O_S); \
        _Pragma("unroll") for (int ti = 0; ti < 4; ++ti) _Pragma("unroll") for (int e = 0; e < 4; ++e) { float x = o[ti][e] * o[ti][e]; x += DPP_F(x, 0xB1); x += DPP_F(x, 0x4E); x += DPP_F(x, 0x141); x += DPP_F(x, 0x140); \
                if (r == 0) ls[(16 * ti + 4 * q + e) * 8 + w] = x; } \
        LBAR(); \
        _Pragma("unroll") for (int ti = 0; ti < 4; ++ti) _Pragma("unroll") for (int e = 0; e < 4; ++e) { const int t = 16 * ti + 4 * q + e; const f32x4 p0 = *(const LAS f32x4*)(ls + t * 8), p1 = *(const LAS f32x4*)(ls + t * 8 + 4); \
                const float ms = ((p0.x + p0.y) + (p0.z + p0.w) + (p1.x + p1.y) + (p1.z + p1.w)) * (1.0f / HD); const float rr = __builtin_amdgcn_rsqf(ms + LN_EPS); \
                const float g = bf2f(*(const LAS unsigned short*)(L + O_G + (par) * TILE + t * PT + (16 * w + r) * 2)); \
                *(LAS unsigned short*)(L + O_O + t * PT + (16 * w + r) * 2) = (unsigned short)f2bf(o[ti][e] * rr * ng * g); } \
    } while (0)
#define OUT_IDS() int tid_ = F.tid; OPAQUE(tid_); const int r = tid_ & 15, q = (tid_ >> 4) & 3, row = tid_ >> 3, seg = tid_ & 7
    if (nu > 0) {
        { OUT_IDS(); OUT_LOAD(pa, 0); if (nu > 1) OUT_LOAD(pb, 1); }
        for (int i = 0; i < nu; i += 2) {
            { OUT_IDS(); OUT_STEP(pa, i, 0); }
            if (i + 1 < nu) { OUT_IDS(); OUT_STEP(pb, i + 1, 1); } }
        LBAR();
        { OUT_IDS(); (void)r; (void)q; OUT_STORE(nu - 1); }
        LBAR();
    }
#undef OUT_T0
#undef OUT_H
#undef OUT_LOAD
#undef OUT_STORE
#undef OUT_STEP
#undef OUT_IDS
    __syncthreads();
}

__global__ void __launch_bounds__(NWAVES * 64, 2) mk_fwd(Args args) {
    extern __shared__ __attribute__((aligned(16))) unsigned char lds[];
    Frame F;
    F.lds = (LAS unsigned char*)lds;
    F.tid = threadIdx.x; F.lane = F.tid & 63; F.wave = __builtin_amdgcn_readfirstlane(F.tid >> 6);
    F.G = gridDim.x; { const int bx = blockIdx.x; F.vcu = (F.G % 8 == 0) ? (bx % 8) * (F.G / 8) + bx / 8 : bx; }
    F.ws = args.ws; F.ctl = (unsigned*)(args.ws + WS_CTL);
    const Args& A = args;
    for (int u = F.tid; u < (LDS_BYTES - LDSCTL_OFF) / 4; u += NWAVES * 64) ((LAS unsigned*)(F.lds + LDSCTL_OFF))[u] = 0u;
    __syncthreads();
    XcdBarrier bar; bar.bar = F.ctl + CW_BAR; bar.x = 0; bar.st = nullptr;
    if (N_LAUNCHES == 1) bar = xcd_barrier_post(F.ctl + CW_BAR, (volatile LAS unsigned*)(F.lds + MISC_OFF) + 8);
    const int lo = args.ph_lo, hi = args.ph_hi;
#ifndef PH_MASK
#define PH_MASK 0x3FFFF
#endif
#define IN(k) (((PH_MASK >> (k)) & 1) && lo <= (k) && (k) < hi)
#define SEAM(k) do { if (IN(k) && IN((k) + 1)) xcd_barrier(bar); } while (0)
#ifndef PH_DUP
#define PH_DUP 0
#endif
#define DUPN(k) ((PH_DUP >> (k)) & 1)
#ifndef PH_TIME
#define PH_TIME -1
#endif
    unsigned long long tp0_ = 0ull, tpd_ = 0ull;
#define TBEG(k) do { if (PH_TIME >= 0 && ((PH_TIME >> (k)) & 1)) tp0_ = __builtin_amdgcn_s_memrealtime(); } while (0)
#define TEND(k) do { if (PH_TIME >= 0 && ((PH_TIME >> (k)) & 1)) tpd_ += __builtin_amdgcn_s_memrealtime() - tp0_; } while (0)
#define REP(k, body) { body; if (DUPN(k)) { xcd_barrier(bar); F.refresh(args.ws); body; } }
    LAS unsigned char* ring = F.lds + RING_OFF;

    if (IN(0)) { F.refresh(args.ws); TBEG(0); REP(0, p0_prologue(F, A)) TEND(0); SEAM(0); }
    if (IN(1)) { F.refresh(args.ws); TBEG(1);
        pg8::DenseOrder S; S.init(F.ws + WS_XINB, F.ws + WS_GIN, T, 2 * D, D, F.G, (int)blockIdx.x);
        pg8::EpiGelu E{(bf16*)(F.ws + WS_Z), 2 * D};
        REP(1, (pg8::gemm_phase<pg8::EpiGelu, pg8::DenseOrder, true, true>(ring, D, S, E)))
        TEND(1); SEAM(1);
    }
    if (IN(3)) { F.refresh(args.ws); TBEG(3); REP(3, p_spatial(F, A)) TEND(3); SEAM(3); }
    if (IN(4)) { F.refresh(args.ws); TBEG(4);
        pg8::DenseOrder S; S.init(F.ws + WS_YG, F.ws + WS_GOUT, T, D, D / 2, F.G, (int)blockIdx.x);
        pg8::EpiRes E{(const bf16*)(F.ws + WS_XINB), (bf16*)(F.ws + WS_XR), D, ALPHA, 1.0f / 4096.0f};
        int kh_ = D / 2; asm volatile("" : "+s"(kh_));
        pg8::gemm_phase<pg8::EpiRes, pg8::DenseOrder, true, true, true>(ring, kh_, S, E);
        TEND(4); SEAM(4);
    }
    if (IN(5)) { F.refresh(args.ws); TBEG(5); p_ln_router(F, A, (const bf16*)(F.ws + WS_XR), A.in[1], A.in[2], (bf16*)(F.ws + WS_XB), F.ws + WS_XQ, 0);
        if (DUPN(5)) { xcd_barrier(bar); if (blockIdx.x == 0 && threadIdx.x < 64) __hip_atomic_store(F.ctl + CW_CNT + threadIdx.x * CNT_STRIDE, 0u, __ATOMIC_RELAXED, __HIP_MEMORY_SCOPE_AGENT); xcd_barrier(bar); F.refresh(args.ws);
            p_ln_router(F, A, (const bf16*)(F.ws + WS_XR), A.in[1], A.in[2], (bf16*)(F.ws + WS_XB), F.ws + WS_XQ, 0); }
        TEND(5); SEAM(5); }
    if (IN(6)) { F.refresh(args.ws); TBEG(6);
        moe_tables(F, 0, 4, true);
        pg8::MoeOrder<true> S{(const LAS int*)(F.lds + LT_UNITS), *(const LAS int*)(F.lds + LT_NUNITS), (const char*)(F.ws + WS_XQ), (const char*)(F.ws + WS_W1), W1_E, D / 2, (const unsigned*)(F.ws + WS_LIST)};
        pg8::EpiMoe1 E{(unsigned char*)(F.ws + WS_HM)};
        int kh_ = D / 2; asm volatile("" : "+s"(kh_));
        REP(6, (pg8::gemm_phase<pg8::EpiMoe1, pg8::MoeOrder<true>, true, true, true>(ring, kh_, S, E)))
        TEND(6); SEAM(6);
    }
    if (IN(7)) { F.refresh(args.ws); TBEG(7);
        moe_tables(F, 0, 8, false);
        pg8::MoeOrder<false> S{(const LAS int*)(F.lds + LT_UNITS), *(const LAS int*)(F.lds + LT_NUNITS), (const char*)(F.ws + WS_HM), (const char*)(F.ws + WS_W2), W2_E, EXD / 2, nullptr};
        pg8::EpiMoe2 E{(unsigned char*)(F.ws + WS_RA), D};
        int kq_ = EXD / 2; asm volatile("" : "+s"(kq_));
        REP(7, (pg8::gemm_phase<pg8::EpiMoe2, pg8::MoeOrder<false>, true, true, true>(ring, kq_, S, E)))
        TEND(7); SEAM(7);
    }
    if (IN(8)) { F.refresh(args.ws); TBEG(8); REP(8, p_combine_ln(F, (const bf16*)(F.ws + WS_XB), A.in[3], A.in[4], nullptr, (bf16*)(F.ws + WS_XB), 0)) TEND(8); SEAM(8); }
    if (IN(9)) { F.refresh(args.ws); TBEG(9);
        pg8::DenseOrder S; S.init(F.ws + WS_XQ, F.ws + WS_HIN, T, 4 * D, D / 2, F.G, (int)blockIdx.x);
        pg8::EpiHgrn E{(bf16*)(F.ws + WS_HQ), (bf16*)(F.ws + WS_HK), (bf16*)(F.ws + WS_HV), (bf16*)(F.ws + WS_HG), (_Float16*)(F.ws + WS_HF), (const float*)(F.ws + WS_LB), D};
        int kh_ = D / 2; asm volatile("" : "+s"(kh_));
        pg8::gemm_phase<pg8::EpiHgrn, pg8::DenseOrder, true, true, true>(ring, kh_, S, E);
        TEND(9); SEAM(9);
    }
    if (IN(10)) { F.refresh(args.ws); TBEG(10); REP(10, p_hgrn_intra(F)) TEND(10); SEAM(10); }
    if (IN(11)) { F.refresh(args.ws); TBEG(11); REP(11, p_hgrn_state(F)) TEND(11); SEAM(11); }
    if (IN(12)) { F.refresh(args.ws); TBEG(12); REP(12, p_hgrn_out(F, A)) TEND(12); SEAM(12); }
    if (IN(13)) { F.refresh(args.ws); TBEG(13);
        pg8::DenseOrder S; S.init(F.ws + WS_HO, F.ws + WS_HOUT, T, D, D / 2, F.G, (int)blockIdx.x);
        pg8::EpiRes E{(const bf16*)(F.ws + WS_XB), (bf16*)(F.ws + WS_XR), D, ALPHA, 1.0f / 4096.0f};
        int kh_ = D / 2; asm volatile("" : "+s"(kh_));
        pg8::gemm_phase<pg8::EpiRes, pg8::DenseOrder, true, true, true>(ring, kh_, S, E);
        TEND(13); SEAM(13);
    }
    if (IN(14)) { F.refresh(args.ws); TBEG(14); p_ln_router(F, A, (const bf16*)(F.ws + WS_XR), A.in[1] + D, A.in[2] + D, (bf16*)(F.ws + WS_XB), F.ws + WS_XQ, 1); TEND(14); SEAM(14); }
    if (IN(15)) { F.refresh(args.ws); TBEG(15);
        moe_tables(F, 1, 4, true);
        pg8::MoeOrder<true> S{(const LAS int*)(F.lds + LT_UNITS), *(const LAS int*)(F.lds + LT_NUNITS), (const char*)(F.ws + WS_XQ), (const char*)(F.ws + WS_W1 + W1_L), W1_E, D / 2, (const unsigned*)(F.ws + WS_LIST)};
        pg8::EpiMoe1 E{(unsigned char*)(F.ws + WS_HM)};
        int kh_ = D / 2; asm volatile("" : "+s"(kh_));
        pg8::gemm_phase<pg8::EpiMoe1, pg8::MoeOrder<true>, true, true, true>(ring, kh_, S, E);
        TEND(15); SEAM(15);
    }
    if (IN(16)) { F.refresh(args.ws); TBEG(16);
        moe_tables(F, 1, 8, false);
        pg8::MoeOrder<false> S{(const LAS int*)(F.lds + LT_UNITS), *(const LAS int*)(F.lds + LT_NUNITS), (const char*)(F.ws + WS_HM), (const char*)(F.ws + WS_W2 + W2_L), W2_E, EXD / 2, nullptr};
        pg8::EpiMoe2 E{(unsigned char*)(F.ws + WS_RA), D};
        int kq_ = EXD / 2; asm volatile("" : "+s"(kq_));
        pg8::gemm_phase<pg8::EpiMoe2, pg8::MoeOrder<false>, true, true, true>(ring, kq_, S, E);
        TEND(16); SEAM(16);
    }
    if (IN(17)) { F.refresh(args.ws); TBEG(17); REP(17, p_combine_ln(F, (const bf16*)(F.ws + WS_XB), A.in[3] + D, A.in[4] + D, A.out, nullptr, 1)) TEND(17); }
    if (PH_TIME >= 0) { const unsigned long long ts_ = __builtin_amdgcn_s_memrealtime(); while (__builtin_amdgcn_s_memrealtime() - ts_ < tpd_) __builtin_amdgcn_s_sleep(8); }
#undef IN
#undef SEAM
}

extern "C" void kernel_launch(void* const* d_in, const int* in_sizes, int n_in, void* d_out, int out_size, void* d_ws, size_t ws_size, hipStream_t stream) {
    static int grid = 0;
    if (grid == 0) {
        if (n_in != 23 || in_sizes[0] != T * D || out_size != T * D || ws_size < WS_END) { fprintf(stderr, "kernel_launch: unexpected shapes (n_in %d, in0 %d, out %d, ws %zu < %zu); nothing launched\n", n_in, n_in > 0 ? in_sizes[0] : -1, out_size, ws_size, (size_t)WS_END); grid = -1; return; }
        int dev = 0, cus = 0, per_cu = 0;
        if (hipGetDevice(&dev) != hipSuccess || hipDeviceGetAttribute(&cus, hipDeviceAttributeMultiprocessorCount, dev) != hipSuccess) { grid = -1; return; }
        if (hipFuncSetAttribute((const void*)mk_fwd, hipFuncAttributeMaxDynamicSharedMemorySize, LDS_BYTES) != hipSuccess) { fprintf(stderr, "kernel_launch: hipFuncSetAttribute failed\n"); grid = -1; return; }
        if (hipOccupancyMaxActiveBlocksPerMultiprocessor(&per_cu, (const void*)mk_fwd, NWAVES * 64, LDS_BYTES) != hipSuccess || per_cu < 1) fprintf(stderr, "kernel_launch: note: occupancy query reports %d\n", per_cu);
        (void)hipGetLastError();
        grid = cus;
    }
    if (grid < 0) return;
    if (hipMemsetAsync((char*)d_ws + WS_CTL, 0, CTL_ZERO_BYTES, stream) != hipSuccess) return;
    Args a{};
    for (int i = 0; i < 23; ++i) a.in[i] = (const float*)d_in[i];
    a.out = (float*)d_out; a.ws = (unsigned char*)d_ws;
    for (int li = 0; li < N_LAUNCHES; ++li) {
        if (N_LAUNCHES == 1) { a.ph_lo = 0; a.ph_hi = N_PHASES; } else { a.ph_lo = li; a.ph_hi = li + 1; }
        hipLaunchKernelGGL(mk_fwd, dim3(grid), dim3(NWAVES * 64), LDS_BYTES, stream, a);
        if (hipPeekAtLastError() != hipSuccess) { fprintf(stderr, "kernel_launch: launch %d failed\n", li); break; }
    }
}
```
